# Optimizing an MI355X kernel written in HIP

```python
import jax, jax.numpy as jnp
from jax import lax
import numpy as np

D_MODEL = 1024
BATCH = 4
SEQ = 8192
DEPTH = 2

GRID_W = 64
CTX_LEN = 256
N_EVEN = (DEPTH + 1) // 2
N_ODD = DEPTH // 2

HEAD_DIM = 64
ATT_HEADS = D_MODEL // (2 * HEAD_DIM)
KV_HEADS = ATT_HEADS // 4
Q_DIM = ATT_HEADS * HEAD_DIM
KV_DIM = KV_HEADS * HEAD_DIM
ATT_COLS = Q_DIM + 2 * KV_DIM
WINDOW = 128
BLOCK = 128
SPAN = BLOCK + 2 * WINDOW
AXIS_DIM = HEAD_DIM // 2
ROPE_BASE = 10000.0

RWKV_N = 64
RWKV_HEADS = D_MODEL // (2 * RWKV_N)
RWKV_DIM = RWKV_HEADS * RWKV_N
DECAY_LORA = 64
ICLR_LORA = 64
GATE_LORA = 128
RWKV_COLS = 3 * RWKV_DIM + DECAY_LORA + ICLR_LORA + GATE_LORA
RWKV_SPLITS = [RWKV_DIM, 2 * RWKV_DIM, 3 * RWKV_DIM,
               3 * RWKV_DIM + DECAY_LORA, 3 * RWKV_DIM + DECAY_LORA + ICLR_LORA]
IN_COLS = ATT_COLS + RWKV_COLS

FOURIER_GROUPS = 4

D_FF = 4 * D_MODEL
N_MOD = 6
NORM_EPS = 1e-6
GN_EPS = 64e-5
NEG_INF = -1e30

kernel_name = "hybrid_swa_rwkv7_fnet_dit"


def rmsnorm(z, g):
    zf = z.astype(jnp.float32)
    zf = zf * lax.rsqrt(jnp.mean(zf * zf, axis=-1, keepdims=True) + NORM_EPS)
    return zf.astype(z.dtype) * g


def modulate(h, shift, scale):
    return h * (1 + scale) + shift


def axial_angles(T):
    rows = T // GRID_W
    row = jnp.broadcast_to(jnp.arange(rows, dtype=jnp.float32)[:, None], (rows, GRID_W)).reshape(T)
    col = jnp.broadcast_to(jnp.arange(GRID_W, dtype=jnp.float32)[None, :], (rows, GRID_W)).reshape(T)
    inv = ROPE_BASE ** (-jnp.arange(0, AXIS_DIM, 2, dtype=jnp.float32) / AXIS_DIM)
    return row[:, None] * inv, col[:, None] * inv


def rope_half(x, ang):
    cos = jnp.cos(ang)[None, :, None, :].astype(x.dtype)
    sin = jnp.sin(ang)[None, :, None, :].astype(x.dtype)
    x1, x2 = x[..., :AXIS_DIM // 2], x[..., AXIS_DIM // 2:]
    return jnp.concatenate([x1 * cos - x2 * sin, x1 * sin + x2 * cos], axis=-1)


def axial_rope(x, ang_r, ang_c):
    return jnp.concatenate([rope_half(x[..., :AXIS_DIM], ang_r),
                            rope_half(x[..., AXIS_DIM:], ang_c)], axis=-1)


def window_attention(q, k, v, kc, vc, sink):
    B, T = q.shape[0], q.shape[1]
    C = kc.shape[1]
    G = ATT_HEADS // KV_HEADS
    nb = T // BLOCK
    scale = HEAD_DIM ** -0.5
    qb = jnp.moveaxis(q.reshape(B, nb, BLOCK, KV_HEADS, G, HEAD_DIM), 1, 0)
    pad = ((0, 0), (WINDOW, WINDOW), (0, 0), (0, 0))
    kp = jnp.pad(k, pad)
    vp = jnp.pad(v, pad)
    sink_logit = jnp.broadcast_to(sink.astype(jnp.float32).reshape(1, KV_HEADS, G, 1, 1),
                                  (B, KV_HEADS, G, BLOCK, 1))
    offs_q = jnp.arange(BLOCK)
    offs_k = jnp.arange(SPAN) - WINDOW

    def one_block(args):
        i, qi = args
        start = i * BLOCK
        ki = lax.dynamic_slice_in_dim(kp, start, SPAN, axis=1)
        vi = lax.dynamic_slice_in_dim(vp, start, SPAN, axis=1)
        qpos = start + offs_q
        kpos = start + offs_k
        valid = ((jnp.abs(kpos[None, :] - qpos[:, None]) <= WINDOW)
                 & (kpos >= 0)[None, :] & (kpos < T)[None, :])
        s_loc = jnp.einsum('bqhgd,bkhd->bhgqk', qi, ki).astype(jnp.float32) * scale
        s_loc = jnp.where(valid, s_loc, NEG_INF)
        s_ctx = jnp.einsum('bqhgd,bkhd->bhgqk', qi, kc).astype(jnp.float32) * scale
        p = jax.nn.softmax(jnp.concatenate([s_loc, s_ctx, sink_logit], axis=-1), axis=-1).astype(vi.dtype)
        return (jnp.einsum('bhgqk,bkhd->bqhgd', p[..., :SPAN], vi)
                + jnp.einsum('bhgqk,bkhd->bqhgd', p[..., SPAN:SPAN + C], vc))

    out = lax.map(one_block, (jnp.arange(nb), qb))
    return jnp.moveaxis(out, 0, 1).reshape(B, T, Q_DIM)


def context_attention(qc, kc, vc, sink):
    B, C = qc.shape[0], qc.shape[1]
    G = ATT_HEADS // KV_HEADS
    qg = qc.reshape(B, C, KV_HEADS, G, HEAD_DIM)
    s = jnp.einsum('bqhgd,bkhd->bhgqk', qg, kc).astype(jnp.float32) * HEAD_DIM ** -0.5
    sink_logit = jnp.broadcast_to(sink.astype(jnp.float32).reshape(1, KV_HEADS, G, 1, 1),
                                  (B, KV_HEADS, G, C, 1))
    p = jax.nn.softmax(jnp.concatenate([s, sink_logit], axis=-1), axis=-1)[..., :C].astype(vc.dtype)
    return jnp.einsum('bhgqk,bkhd->bqhgd', p, vc).reshape(B, C, Q_DIM)


def centred_shift(z, mu_prev, mu_next):
    prev = jnp.pad(z, ((0, 0), (1, 0), (0, 0)))[:, :-1]
    nxt = jnp.pad(z, ((0, 0), (0, 1), (0, 0)))[:, 1:]
    return z + mu_prev * (prev - z) + mu_next * (nxt - z)


def rwkv_prep(zb, w0, w2, a0, a2, k_k, k_a):
    zb = zb.astype(jnp.float32)
    B, L = zb.shape[0], zb.shape[1]
    r, k, v, wl, al, gl = jnp.split(zb, RWKV_SPLITS, axis=-1)
    heads = lambda t: t.reshape(B, L, RWKV_HEADS, RWKV_N)
    kk = heads(k * k_k)
    kk = kk * lax.rsqrt(jnp.sum(kk * kk, axis=-1, keepdims=True) + 1e-12)
    dirs = []
    for d in range(2):
        w_log = -jax.nn.softplus(-(w0[d] + jnp.tanh(wl) @ w2[d])) - 0.5
        decay = jnp.exp(-jnp.exp(w_log))
        a = jax.nn.sigmoid(a0[d] + al @ a2[d])
        kd = k * (1 + (a - 1) * k_a)
        dirs.append((heads(decay), heads(kd), heads(a)))
    return heads(r), heads(k), heads(v), kk, dirs, gl


def rwkv_scan(state0, r, decay, k, v, kk, a, reverse):
    def step(S, inp):
        r_t, w_t, k_t, v_t, kk_t, a_t = inp
        s_kk = jnp.einsum('bhvk,bhk->bhv', S, kk_t)
        S = (S * w_t[:, :, None, :]
             - s_kk[..., None] * (kk_t * a_t)[:, :, None, :]
             + v_t[..., None] * k_t[:, :, None, :])
        return S, jnp.einsum('bhvk,bhk->bhv', S, r_t)
    xs = tuple(jnp.moveaxis(t, 1, 0) for t in (r, decay, k, v, kk, a))
    state, ys = lax.scan(step, state0, xs, reverse=reverse)
    return state, jnp.moveaxis(ys, 0, 1)


def rwkv_readout(y, r, k, v, gl, g2, r_k, lnx_g, lnx_b):
    B, L = y.shape[0], y.shape[1]
    mean = jnp.mean(y, axis=-1, keepdims=True)
    var = jnp.mean(jnp.square(y - mean), axis=-1, keepdims=True)
    yn = ((y - mean) * lax.rsqrt(var + GN_EPS)).reshape(B, L, RWKV_DIM) * lnx_g + lnx_b
    bonus = (jnp.sum(r * k * r_k, axis=-1, keepdims=True) * v).reshape(B, L, RWKV_DIM)
    g = jax.nn.sigmoid(gl) @ g2
    return (yn + bonus) * g


def rwkv_mixer(zb, zbc, w0, w2, a0, a2, g2, k_k, k_a, r_k, lnx_g, lnx_b, need_ctx):
    rc, kc, vc, kkc, dirs_c, glc = rwkv_prep(zbc, w0, w2, a0, a2, k_k, k_a)
    r, k, v, kk, dirs, gl = rwkv_prep(zb, w0, w2, a0, a2, k_k, k_a)
    B = zb.shape[0]
    s0 = jnp.zeros((B, RWKV_HEADS, RWKV_N, RWKV_N), jnp.float32)
    y = 0.0
    yc = 0.0
    for d, rev in ((0, False), (1, True)):
        dec_c, kd_c, a_c = dirs_c[d]
        s_ctx, yc_d = rwkv_scan(s0, rc, dec_c, kd_c, vc, kkc, a_c, rev)
        dec, kd, a = dirs[d]
        _, y_d = rwkv_scan(s_ctx, r, dec, kd, v, kk, a, rev)
        y = y + y_d
        yc = yc + yc_d
    out = rwkv_readout(y, r, k, v, gl, g2, r_k, lnx_g, lnx_b)
    out_c = rwkv_readout(yc, rc, kc, vc, glc, g2, r_k, lnx_g, lnx_b) if need_ctx else None
    return out, out_c


def hybrid_ab_mixer(h, hc, w_in, w_out, sink, mu_prev, mu_next, w0, w2, a0, a2, g2,
                    k_k, k_a, r_k, lnx_g, lnx_b, ang_r, ang_c, need_ctx):
    B, T = h.shape[0], h.shape[1]
    C = hc.shape[1]
    z = h @ w_in
    zc = hc @ w_in
    q = axial_rope(z[..., :Q_DIM].reshape(B, T, ATT_HEADS, HEAD_DIM), ang_r, ang_c)
    k = axial_rope(z[..., Q_DIM:Q_DIM + KV_DIM].reshape(B, T, KV_HEADS, HEAD_DIM), ang_r, ang_c)
    v = z[..., Q_DIM + KV_DIM:ATT_COLS].reshape(B, T, KV_HEADS, HEAD_DIM)
    qc = zc[..., :Q_DIM].reshape(B, C, ATT_HEADS, HEAD_DIM)
    kc = zc[..., Q_DIM:Q_DIM + KV_DIM].reshape(B, C, KV_HEADS, HEAD_DIM)
    vc = zc[..., Q_DIM + KV_DIM:ATT_COLS].reshape(B, C, KV_HEADS, HEAD_DIM)
    att = window_attention(q, k, v, kc, vc, sink)
    rw, rwc = rwkv_mixer(centred_shift(z[..., ATT_COLS:], mu_prev, mu_next),
                         centred_shift(zc[..., ATT_COLS:], mu_prev, mu_next),
                         w0, w2, a0, a2, g2, k_k, k_a, r_k, lnx_g, lnx_b, need_ctx)
    out = jnp.concatenate([att, rw.astype(att.dtype)], axis=-1) @ w_out
    if need_ctx:
        att_c = context_attention(qc, kc, vc, sink)
        out_c = jnp.concatenate([att_c, rwc.astype(att_c.dtype)], axis=-1) @ w_out
    else:
        out_c = None
    return out, out_c


def fourier_mixer(h, w_out):
    B, L, D = h.shape
    hg = h.astype(jnp.float32).reshape(B, L, FOURIER_GROUPS, D // FOURIER_GROUPS)
    f = jnp.fft.fft2(hg, axes=(1, 3), norm="ortho").real
    return f.reshape(B, L, D).astype(h.dtype) @ w_out


def channel_mlp(h, w1, w2):
    return jnp.square(jax.nn.relu(h @ w1)) @ w2


def setup_inputs(seed: int = 0) -> dict:
    key = jax.random.key(seed)
    ks = iter(jax.random.split(key, 40))
    nrm = lambda shape, s: jax.random.normal(next(ks), shape, jnp.float32) * s
    uni = lambda shape: jax.random.uniform(next(ks), shape, jnp.float32, 0.0, 0.6)
    D = D_MODEL
    return {
        "x": nrm((BATCH, SEQ, D), 1.0),
        "c": nrm((BATCH, D), 1.0),
        "ctx": nrm((BATCH, CTX_LEN, D), 1.0),
        "c_ctx": nrm((D,), 1.0),
        "ada_w": nrm((DEPTH, D, N_MOD * D), 0.5 * D ** -0.5),
        "ada_b": nrm((DEPTH, N_MOD * D), 0.01),
        "norm1_g": 1.0 + nrm((DEPTH, D), 0.02),
        "norm2_g": 1.0 + nrm((DEPTH, D), 0.02),
        "mix_w_in": nrm((N_EVEN, D, IN_COLS), D ** -0.5),
        "mix_w_out": nrm((N_EVEN, Q_DIM + RWKV_DIM, D), (Q_DIM + RWKV_DIM) ** -0.5),
        "attn_sink": nrm((N_EVEN, ATT_HEADS), 0.5),
        "shift_mu_prev": uni((N_EVEN, RWKV_COLS)),
        "shift_mu_next": uni((N_EVEN, RWKV_COLS)),
        "decay_w0": nrm((N_EVEN, 2, RWKV_DIM), 0.5),
        "decay_w2": nrm((N_EVEN, 2, DECAY_LORA, RWKV_DIM), 0.1),
        "iclr_a0": nrm((N_EVEN, 2, RWKV_DIM), 0.5),
        "iclr_a2": nrm((N_EVEN, 2, ICLR_LORA, RWKV_DIM), 0.1),
        "gate_g2": nrm((N_EVEN, GATE_LORA, RWKV_DIM), GATE_LORA ** -0.5),
        "key_kk": 0.85 + nrm((N_EVEN, RWKV_DIM), 0.05),
        "key_ka": 1.0 + nrm((N_EVEN, RWKV_DIM), 0.05),
        "bonus_rk": nrm((N_EVEN, RWKV_HEADS, RWKV_N), 0.1),
        "lnx_g": 1.0 + nrm((N_EVEN, RWKV_DIM), 0.02),
        "lnx_b": nrm((N_EVEN, RWKV_DIM), 0.01),
        "fourier_w_out": nrm((N_ODD, D, D), D ** -0.5),
        "mlp_w1": nrm((DEPTH, D, D_FF), D ** -0.5),
        "mlp_w2": nrm((DEPTH, D_FF, D), D_FF ** -0.5),
        "final_g": 1.0 + nrm((D,), 0.02),
    }


def reference(x, c, ctx, c_ctx, ada_w, ada_b, norm1_g, norm2_g, mix_w_in, mix_w_out,
              attn_sink, shift_mu_prev, shift_mu_next, decay_w0, decay_w2, iclr_a0, iclr_a2,
              gate_g2, key_kk, key_ka, bonus_rk, lnx_g, lnx_b, fourier_w_out, mlp_w1, mlp_w2,
              final_g):
    T = x.shape[1]
    ang_r, ang_c = axial_angles(T)
    s_lat = jax.nn.silu(c)
    s_ctx = jax.nn.silu(c_ctx)
    for i in range(DEPTH):
        need_ctx = i < DEPTH - 1
        even = i % 2 == 0
        j = i // 2
        mod = (s_lat @ ada_w[i] + ada_b[i])[:, None, :]
        sh1, sc1, gt1, sh2, sc2, gt2 = jnp.split(mod, N_MOD, axis=-1)
        h = modulate(rmsnorm(x, norm1_g[i]), sh1, sc1)
        if even or need_ctx:
            mod_c = (s_ctx @ ada_w[i] + ada_b[i])[None, None, :]
            csh1, csc1, cgt1, csh2, csc2, cgt2 = jnp.split(mod_c, N_MOD, axis=-1)
            hc = modulate(rmsnorm(ctx, norm1_g[i]), csh1, csc1)
        if even:
            y, yc = hybrid_ab_mixer(h, hc, mix_w_in[j], mix_w_out[j], attn_sink[j],
                                    shift_mu_prev[j], shift_mu_next[j], decay_w0[j], decay_w2[j],
                                    iclr_a0[j], iclr_a2[j], gate_g2[j], key_kk[j], key_ka[j],
                                    bonus_rk[j], lnx_g[j], lnx_b[j], ang_r, ang_c, need_ctx)
        else:
            y = fourier_mixer(h, fourier_w_out[j])
            yc = fourier_mixer(hc, fourier_w_out[j]) if need_ctx else None
        x = x + gt1 * y
        x = x + gt2 * channel_mlp(modulate(rmsnorm(x, norm2_g[i]), sh2, sc2), mlp_w1[i], mlp_w2[i])
        if need_ctx:
            ctx = ctx + cgt1 * yc
            ctx = ctx + cgt2 * channel_mlp(modulate(rmsnorm(ctx, norm2_g[i]), csh2, csc2),
                                           mlp_w1[i], mlp_w2[i])
    return rmsnorm(x, final_g)
```

```cpp
#include <hip/hip_runtime.h>
#include <hip/hip_cooperative_groups.h>
#include <cstdio>
#include <cstdint>
namespace cg = cooperative_groups;
namespace pg8 {
#define PG8_LAS __attribute__((address_space(3)))
typedef unsigned short bf16_t;
typedef short bf16x8 __attribute__((ext_vector_type(8)));
typedef float f32x4 __attribute__((ext_vector_type(4)));
typedef unsigned u32x4 __attribute__((ext_vector_type(4)));
constexpr int BM = 256, BK = 64, HALF = 128, HTB = HALF * BK * 2  , STAGE_BYTES = 8 * HTB, NXCD = 8, WGM = 8;

__host__ __device__ __forceinline__ int lds_byte(int r, int c) { const int st = (r >> 4) * 2 + (c >> 5), rr = r & 15, cc = c & 31, ob = rr * 64 + cc * 2; return st * 1024 + (ob ^ (((ob >> 9) & 1) << 5)); }
__host__ __device__ __forceinline__ void stage_rc(int b, int& R, int& C) { const int st = b / 1024, sb = b % 1024, swz = sb ^ (((sb >> 9) & 1) << 5); R = (st >> 1) * 16 + swz / 64; C = (st & 1) * 32 + (swz % 64) / 2; }
__host__ __device__ __forceinline__ int perm32(int rho) { const int n = rho >> 4, i = rho & 15; return 8 * (i >> 2) + 4 * n + (i & 3); }

struct Unit { int pm, pn; };
struct Gemm { const bf16_t* A; const bf16_t* Bt; int M, N, K; };

struct StaticOrder {
    int nM, nN, nwg, G, c;
    __host__ __device__ void init(int M, int N, int G_, int c_) { nM = M / BM; nN = N / BM; nwg = nM * nN; G = G_; c = c_; }
    __host__ __device__ bool next(int i, Unit& u) const {
        const long L = (long)i * G + c; if (L >= nwg) return false;
        int wgid = (int)L; { const int q = nwg / NXCD, r = nwg % NXCD, xcd = wgid % NXCD, off = wgid / NXCD; wgid = (xcd < r ? xcd * (q + 1) : r * (q + 1) + (xcd - r) * q) + off; }
        const int nig = WGM * nN, gid = wgid / nig, fm = gid * WGM, gsz = (nM - fm) < WGM ? (nM - fm) : WGM;
        u.pm = fm + ((wgid % nig) % gsz); u.pn = (wgid % nig) / gsz; return true;
    }
    __device__ __forceinline__ void a_ready(const Unit&) const {}
    __device__ __forceinline__ void done(const Unit&) const {}
};

__device__ __forceinline__ unsigned cvt_pk_bf16(float lo, float hi) { unsigned r; asm volatile("v_cvt_pk_bf16_f32 %0, %1, %2" : "=v"(r) : "v"(lo), "v"(hi)); return r; }
typedef float f32x2 __attribute__((ext_vector_type(2)));
__device__ __forceinline__ f32x2 gelu_pk(f32x2 v) {
    const f32x2 av = __builtin_elementwise_abs(v), d = av * 0.2316418882f + 1.0f;
    f32x2 t; t.x = __builtin_amdgcn_rcpf(d.x); t.y = __builtin_amdgcn_rcpf(d.y);
    f32x2 q = t * 0.5307027145f + (-0.7265760135f); q = q * t + 0.7107068705f; q = q * t + (-0.142248368f); q = q * t + 0.127414796f; q = q * t;
    const f32x2 s = (v * v) * (-0.72134752044f);
    f32x2 e; e.x = __builtin_amdgcn_exp2f(s.x); e.y = __builtin_amdgcn_exp2f(s.y);
    const f32x2 m = v * (q * e), r = v - m;
    f32x2 o; o.x = v.x < 0.f ? m.x : r.x; o.y = v.y < 0.f ? m.y : r.y; return o;
}

template <int ACT  > struct EpiBf16 {
    static constexpr bool PERM = true, AFTER_DRAIN = false; static_assert(ACT == 0 || ACT == 1, "EpiBf16: ACT is 0 (none) or 1 (gelu_pk)");
    bf16_t* O; int ldc; const float* bias; int split_cols; size_t split_stride; float scale0;
    __device__ __forceinline__ void operator()(const f32x4 (&acc)[2][2][4][2], const Unit& u, int wr, int wc, int fr, int fq) const {
        const int row0 = u.pm * BM + wr * 64 + fr; int colt = u.pn * BM; bf16_t* base = O;
        float sc = 1.f; if (split_cols) { const int t = colt / split_cols; base += (size_t)t * split_stride; colt -= t * split_cols; if (t == 0) sc = scale0; }
        const int col0 = colt + wc * 32 + 8 * fq, bcol0 = u.pn * BM + wc * 32 + 8 * fq;
        f32x4 bv[2][2];
#pragma unroll
        for (int bj = 0; bj < 2; ++bj)
#pragma unroll
            for (int n = 0; n < 2; ++n) bv[bj][n] = bias ? *(const f32x4*)(bias + bcol0 + bj * HALF + 4 * n) : (f32x4){0.f, 0.f, 0.f, 0.f};
#pragma unroll
        for (int ai = 0; ai < 2; ++ai)
#pragma unroll
            for (int m = 0; m < 4; ++m) { bf16_t* rowp = base + (size_t)(row0 + ai * HALF + m * 16) * ldc + col0;
#pragma unroll
                for (int bj = 0; bj < 2; ++bj) { f32x4 v0 = acc[ai][bj][m][0] + bv[bj][0], v1 = acc[ai][bj][m][1] + bv[bj][1];
                    if (ACT == 1) { f32x2 a = gelu_pk((f32x2){v0[0], v0[1]}), b = gelu_pk((f32x2){v0[2], v0[3]}), c = gelu_pk((f32x2){v1[0], v1[1]}), d = gelu_pk((f32x2){v1[2], v1[3]});
                        v0 = (f32x4){a.x, a.y, b.x, b.y}; v1 = (f32x4){c.x, c.y, d.x, d.y}; }
                    v0 = v0 * sc; v1 = v1 * sc; u32x4 w; w.x = cvt_pk_bf16(v0[0], v0[1]); w.y = cvt_pk_bf16(v0[2], v0[3]); w.z = cvt_pk_bf16(v1[0], v1[1]); w.w = cvt_pk_bf16(v1[2], v1[3]);
                    *(u32x4*)(rowp + bj * HALF) = w; } }
    }
};
typedef float f32x2e __attribute__((ext_vector_type(2)));
struct EpiInProj {
    static constexpr bool PERM = true, AFTER_DRAIN = false;
    bf16_t* QKV; bf16_t* ZR; const float* rope;
    __device__ __forceinline__ void operator()(const f32x4 (&acc)[2][2][4][2], const Unit& u, int wr, int wc, int fr, int fq) const {
        const int row0 = u.pm * BM + wr * 64 + fr; const int colt = u.pn * BM;
        if (colt >= 768) {
#pragma unroll
            for (int ai = 0; ai < 2; ++ai)
#pragma unroll
                for (int m = 0; m < 4; ++m) { bf16_t* rowp = ZR + (size_t)(row0 + ai * HALF + m * 16) * 1792 + (colt - 768) + wc * 32 + 8 * fq;
#pragma unroll
                    for (int bj = 0; bj < 2; ++bj) { const f32x4 v0 = acc[ai][bj][m][0], v1 = acc[ai][bj][m][1];
                        u32x4 w; w.x = cvt_pk_bf16(v0[0], v0[1]); w.y = cvt_pk_bf16(v0[2], v0[3]); w.z = cvt_pk_bf16(v1[0], v1[1]); w.w = cvt_pk_bf16(v1[2], v1[3]);
                        *(u32x4*)(rowp + bj * HALF) = w; } }
            return;
        }
        const bool latent = u.pm < 128;
        const int axis = wc & 1;
        const float sgn = (fq < 2) ? -1.f : 1.f;
#pragma unroll
        for (int ai = 0; ai < 2; ++ai)
#pragma unroll
            for (int m = 0; m < 4; ++m) {
                const int row = row0 + ai * HALF + m * 16; const int t = row & 8191; const int pos = axis ? (t & 63) : (t >> 6);
                f32x4 cs[4];
                if (latent) {
#pragma unroll
                    for (int i = 0; i < 4; ++i) cs[i] = *(const f32x4*)(rope + (size_t)(pos * 16 + 8 * (fq & 1) + 2 * i) * 2);
                }
                bf16_t* rowp = QKV + (size_t)row * 768 + colt + wc * 32 + 8 * fq;
#pragma unroll
                for (int bj = 0; bj < 2; ++bj) {
                    const int colb = colt + bj * HALF;
                    const bool is_v = (colb == 640), is_q = (colb < 512);
                    f32x4 v0 = acc[ai][bj][m][0], v1 = acc[ai][bj][m][1];
                    if (latent && !is_v) {
                        f32x4 o0, o1;
#pragma unroll
                        for (int e = 0; e < 4; ++e) { o0[e] = __shfl_xor(v0[e], 32); o1[e] = __shfl_xor(v1[e], 32); }
                        v0[0] = v0[0] * cs[0][0] + sgn * o0[0] * cs[0][1]; v0[1] = v0[1] * cs[0][2] + sgn * o0[1] * cs[0][3];
                        v0[2] = v0[2] * cs[1][0] + sgn * o0[2] * cs[1][1]; v0[3] = v0[3] * cs[1][2] + sgn * o0[3] * cs[1][3];
                        v1[0] = v1[0] * cs[2][0] + sgn * o1[0] * cs[2][1]; v1[1] = v1[1] * cs[2][2] + sgn * o1[1] * cs[2][3];
                        v1[2] = v1[2] * cs[3][0] + sgn * o1[2] * cs[3][1]; v1[3] = v1[3] * cs[3][2] + sgn * o1[3] * cs[3][3];
                    }
                    if (is_q) { v0 = v0 * 0.18033688011112042f; v1 = v1 * 0.18033688011112042f; }
                    u32x4 w; w.x = cvt_pk_bf16(v0[0], v0[1]); w.y = cvt_pk_bf16(v0[2], v0[3]); w.z = cvt_pk_bf16(v1[0], v1[1]); w.w = cvt_pk_bf16(v1[2], v1[3]);
                    *(u32x4*)(rowp + bj * HALF) = w;
                }
            }
    }
};
struct EpiResidual {
    static constexpr bool PERM = false, AFTER_DRAIN = false;
    const float* base; float* out; const float* gate; int gate_stride;
    __device__ __forceinline__ void operator()(const f32x4 (&acc)[2][2][4][2], const Unit& u, int wr, int wc, int fr, int fq) const {
        const int row0 = u.pm * BM + wr * 64 + fr; const int col0 = u.pn * BM + wc * 32 + 4 * fq;
        const float* gp = gate + (size_t)(u.pm >> 5) * gate_stride + col0;
        f32x4 gv[2][2];
#pragma unroll
        for (int bj = 0; bj < 2; ++bj)
#pragma unroll
            for (int n = 0; n < 2; ++n) gv[bj][n] = *(const f32x4*)(gp + bj * HALF + n * 16);
#pragma unroll
        for (int ai = 0; ai < 2; ++ai)
#pragma unroll
            for (int m = 0; m < 4; ++m) { const size_t off = (size_t)(row0 + ai * HALF + m * 16) * 1024 + col0;
#pragma unroll
                for (int bj = 0; bj < 2; ++bj)
#pragma unroll
                    for (int n = 0; n < 2; ++n) { const f32x4 bs = *(const f32x4*)(base + off + bj * HALF + n * 16);
                        *(f32x4*)(out + off + bj * HALF + n * 16) = bs + gv[bj][n] * acc[ai][bj][m][n]; } }
    }
};
template <int ACT> struct EpiStore {
    static constexpr bool PERM = true, AFTER_DRAIN = false;
    bf16_t* O; int ldc;
    __device__ __forceinline__ void operator()(const f32x4 (&acc)[2][2][4][2], const Unit& u, int wr, int wc, int fr, int fq) const {
        const int row0 = u.pm * BM + wr * 64 + fr; const int col0 = u.pn * BM + wc * 32 + 8 * fq;
#pragma unroll
        for (int ai = 0; ai < 2; ++ai)
#pragma unroll
            for (int m = 0; m < 4; ++m) { bf16_t* rowp = O + (size_t)(row0 + ai * HALF + m * 16) * ldc + col0;
#pragma unroll
                for (int bj = 0; bj < 2; ++bj) { f32x4 v0 = acc[ai][bj][m][0], v1 = acc[ai][bj][m][1];
                    if (ACT == 2) {
#pragma unroll
                        for (int e = 0; e < 4; ++e) { const float a = fmaxf(v0[e], 0.f), b = fmaxf(v1[e], 0.f); v0[e] = a * a; v1[e] = b * b; }
                    }
                    u32x4 w; w.x = cvt_pk_bf16(v0[0], v0[1]); w.y = cvt_pk_bf16(v0[2], v0[3]); w.z = cvt_pk_bf16(v1[0], v1[1]); w.w = cvt_pk_bf16(v1[2], v1[3]);
                    *(u32x4*)(rowp + bj * HALF) = w; } }
    }
};
template <class Epi, class Sched, bool ALIGN_EPI = false, bool SP2 = false>
__device__ __forceinline__ void gemm_phase(PG8_LAS unsigned char* lds, const Gemm g, const Sched& S, const Epi& E) {
    const int tid = threadIdx.x, wid = __builtin_amdgcn_readfirstlane(tid >> 6), lane = tid & 63, wr = wid >> 2, wc = wid & 3, fr = lane & 15, fq = lane >> 4;
    int K_ = g.K; asm volatile("" : "+s"(K_)); const int K = K_, nt = K / BK;
    unsigned voffA[2], voffB[2];
#pragma unroll
    for (int i = 0; i < 2; ++i) { int R, C; stage_rc(tid * 16 + i * 8192, R, C); const int Rb = Epi::PERM ? ((R & ~31) + perm32(R & 31)) : R;
        voffA[i] = (unsigned)(R * K + C) * 2u; voffB[i] = (unsigned)(Rb * K + C) * 2u; }
    const size_t kstep = (size_t)(BK * 2);
    const size_t hstep = (size_t)HALF * K * 2;
    const size_t tstep = 2 * hstep;
    const unsigned ldsw = (unsigned)wid * 1024u;
    const int aoff = lds_byte(wr * 64 + fr, fq * 8), boff = lds_byte(wc * 32 + fr, fq * 8);
#define PG8_SA(b, h) (((b) * 2 + (h)) * HTB)
#define PG8_SB(b, h) ((4 + (b) * 2 + (h)) * HTB)
#define PG8_STAGE(bufoff, gbase, voff) do { _Pragma("unroll") for (int _i = 0; _i < 2; ++_i) \
        __builtin_amdgcn_global_load_lds((const unsigned*)((const char*)(gbase) + (voff)[_i]), (PG8_LAS unsigned*)(lds + (bufoff) + ldsw + _i * 8192), 16, 0, 0); } while (0)
#define PG8_LDA(dst, b, h) do { _Pragma("unroll") for (int m = 0; m < 4; ++m) _Pragma("unroll") for (int k = 0; k < 2; ++k) dst[m][k] = *(const PG8_LAS bf16x8*)(lds + PG8_SA(b, h) + aoff + m * 2048 + k * 1024); } while (0)
#define PG8_LDB(dst, b, h) do { _Pragma("unroll") for (int n = 0; n < 2; ++n) _Pragma("unroll") for (int k = 0; k < 2; ++k) dst[n][k] = *(const PG8_LAS bf16x8*)(lds + PG8_SB(b, h) + boff + n * 2048 + k * 1024); } while (0)
#define PG8_MMA(ai, bj, At, Bt) do { __builtin_amdgcn_s_setprio(1); _Pragma("unroll") for (int m = 0; m < 4; ++m) _Pragma("unroll") for (int n = 0; n < 2; ++n) _Pragma("unroll") for (int k = 0; k < 2; ++k) \
        acc[ai][bj][m][n] = __builtin_amdgcn_mfma_f32_16x16x32_bf16(Bt[n][k], At[m][k], acc[ai][bj][m][n], 0, 0, 0); __builtin_amdgcn_s_setprio(0); } while (0)
#define PG8_WAIT_V(n) asm volatile("s_waitcnt vmcnt(" #n ")" ::: "memory")
#define PG8_WAIT_L(n) asm volatile("s_waitcnt lgkmcnt(" #n ")" ::: "memory")
#define PG8_BAR __builtin_amdgcn_s_barrier()
#define PG8_SCHED __builtin_amdgcn_sched_barrier(0)
    Unit cur, nxt; int ui = 0;
    if (!S.next(0, cur)) return;
    f32x4 acc[2][2][4][2];
#pragma unroll
    for (int a = 0; a < 2; ++a)
#pragma unroll
        for (int b = 0; b < 2; ++b)
#pragma unroll
            for (int m = 0; m < 4; ++m)
#pragma unroll
                for (int n = 0; n < 2; ++n) acc[a][b][m][n] = (f32x4){0.f, 0.f, 0.f, 0.f};
    bf16x8 At[4][2], B0[2][2], B1[2][2];
    const char* cA = (const char*)g.A + (size_t)cur.pm * tstep; const char* cB = (const char*)g.Bt + (size_t)cur.pn * tstep;
    S.a_ready(cur);
    if constexpr (SP2) {
        PG8_STAGE(PG8_SB(0, 0), cB, voffB); PG8_STAGE(PG8_SB(0, 1), cB + hstep, voffB); PG8_STAGE(PG8_SA(0, 0), cA, voffA); PG8_STAGE(PG8_SA(0, 1), cA + hstep, voffA);
        if (wr == 1) PG8_BAR;
        PG8_WAIT_V(2); PG8_BAR;
        PG8_STAGE(PG8_SB(1, 0), cB + kstep, voffB); PG8_STAGE(PG8_SA(1, 0), cA + kstep, voffA); PG8_STAGE(PG8_SB(1, 1), cB + hstep + kstep, voffB);
        PG8_WAIT_V(6); PG8_BAR;
    } else {
        PG8_STAGE(PG8_SB(0, 0), cB, voffB); PG8_STAGE(PG8_SA(0, 0), cA, voffA); PG8_STAGE(PG8_SB(0, 1), cB + hstep, voffB); PG8_STAGE(PG8_SA(0, 1), cA + hstep, voffA);
        if (wr == 1) PG8_BAR;
        PG8_WAIT_V(4); PG8_BAR;
        PG8_STAGE(PG8_SB(1, 0), cB + kstep, voffB); PG8_STAGE(PG8_SA(1, 0), cA + kstep, voffA); PG8_STAGE(PG8_SB(1, 1), cB + hstep + kstep, voffB);
        PG8_WAIT_V(6); PG8_BAR;
    }
    for (;;) {
        const bool has_next = S.next(ui + 1, nxt);
        const char* nA = has_next ? (const char*)g.A + (size_t)nxt.pm * tstep : cA; const char* nB = has_next ? (const char*)g.Bt + (size_t)nxt.pn * tstep : cB;
        for (int t = 0; t < nt; t += 2) {
            const bool last = (t == nt - 2);
            const char* a1 = cA + (size_t)(t + 1) * kstep;
            const char* a2 = last ? nA : cA + (size_t)(t + 2) * kstep; const char* b2 = last ? nB : cB + (size_t)(t + 2) * kstep;
            const char* a3 = a2 + kstep; const char* b3 = b2 + kstep;
            if (last && has_next) S.a_ready(nxt);
            if constexpr (SP2) {
            PG8_LDB(B0, 0, 0); PG8_LDB(B1, 0, 1); PG8_SCHED; PG8_LDA(At, 0, 0); PG8_STAGE(PG8_SA(1, 1), a1 + hstep, voffA);
            PG8_WAIT_V(8); PG8_WAIT_L(0); PG8_BAR; PG8_MMA(0, 0, At, B0); PG8_MMA(0, 1, At, B1); PG8_BAR; PG8_SCHED;
            PG8_LDA(At, 0, 1); PG8_STAGE(PG8_SB(0, 0), b2, voffB); PG8_STAGE(PG8_SB(0, 1), b2 + hstep, voffB); PG8_STAGE(PG8_SA(0, 0), a2, voffA);
            PG8_WAIT_V(8); PG8_WAIT_L(0); PG8_BAR; PG8_MMA(1, 0, At, B0); PG8_MMA(1, 1, At, B1); PG8_BAR; PG8_SCHED;
            PG8_LDB(B0, 1, 0); PG8_LDB(B1, 1, 1); PG8_SCHED; PG8_LDA(At, 1, 0); PG8_STAGE(PG8_SA(0, 1), a2 + hstep, voffA);
            PG8_WAIT_V(8); PG8_WAIT_L(0); PG8_BAR; PG8_MMA(0, 0, At, B0); PG8_MMA(0, 1, At, B1); PG8_BAR; PG8_SCHED;
            PG8_LDA(At, 1, 1); PG8_STAGE(PG8_SB(1, 0), b3, voffB); PG8_STAGE(PG8_SB(1, 1), b3 + hstep, voffB); PG8_STAGE(PG8_SA(1, 0), a3, voffA);
            PG8_WAIT_V(8); PG8_WAIT_L(0); PG8_BAR; PG8_MMA(1, 0, At, B0); PG8_MMA(1, 1, At, B1); PG8_BAR; PG8_SCHED;
            } else {
            PG8_LDB(B0, 0, 0); PG8_SCHED; PG8_LDA(At, 0, 0); PG8_STAGE(PG8_SA(1, 1), a1 + hstep, voffA);
            PG8_WAIT_L(8); PG8_BAR; PG8_WAIT_L(0); PG8_MMA(0, 0, At, B0); PG8_BAR; PG8_SCHED;
            PG8_LDB(B1, 0, 1); PG8_STAGE(PG8_SB(0, 0), b2, voffB);
            PG8_BAR; PG8_WAIT_L(0); PG8_MMA(0, 1, At, B1); PG8_BAR;
            PG8_LDA(At, 0, 1); PG8_STAGE(PG8_SA(0, 0), a2, voffA);
            PG8_BAR; PG8_WAIT_L(0); PG8_MMA(1, 0, At, B0); PG8_BAR; PG8_SCHED;
            PG8_STAGE(PG8_SB(0, 1), b2 + hstep, voffB);
            PG8_WAIT_V(6); PG8_BAR; PG8_MMA(1, 1, At, B1); PG8_BAR;
            PG8_LDB(B0, 1, 0); PG8_SCHED; PG8_LDA(At, 1, 0); PG8_STAGE(PG8_SA(0, 1), a2 + hstep, voffA);
            PG8_WAIT_L(8); PG8_BAR; PG8_WAIT_L(0); PG8_MMA(0, 0, At, B0); PG8_BAR; PG8_SCHED;
            PG8_LDB(B1, 1, 1); PG8_STAGE(PG8_SB(1, 0), b3, voffB);
            PG8_BAR; PG8_WAIT_L(0); PG8_MMA(0, 1, At, B1); PG8_BAR;
            PG8_LDA(At, 1, 1); PG8_STAGE(PG8_SA(1, 0), a3, voffA);
            PG8_BAR; PG8_WAIT_L(0); PG8_MMA(1, 0, At, B0); PG8_BAR; PG8_SCHED;
            PG8_STAGE(PG8_SB(1, 1), b3 + hstep, voffB);
            PG8_WAIT_V(6); PG8_BAR; PG8_MMA(1, 1, At, B1); PG8_BAR;
            }
        }
        if constexpr (ALIGN_EPI) { if (wr == 0) PG8_BAR; }
        if constexpr (!Epi::AFTER_DRAIN) { E(acc, cur, wr, wc, fr, fq); S.done(cur); }
        if (!has_next) break;
#pragma unroll
        for (int a = 0; a < 2; ++a)
#pragma unroll
            for (int b = 0; b < 2; ++b)
#pragma unroll
                for (int m = 0; m < 4; ++m)
#pragma unroll
                    for (int n = 0; n < 2; ++n) acc[a][b][m][n] = (f32x4){0.f, 0.f, 0.f, 0.f};
        cur = nxt; cA = nA; cB = nB; ++ui;
        if constexpr (ALIGN_EPI) { if (wr == 1) PG8_BAR; }
    }
    PG8_WAIT_V(0);
    if constexpr (!ALIGN_EPI) { if (wr == 0) PG8_BAR; }
    PG8_BAR;
    if constexpr (Epi::AFTER_DRAIN) { E.fused(acc, cur, wr, wc, fr, fq, lds, wid, lane); S.done(cur); }
#undef PG8_SA
#undef PG8_SB
#undef PG8_STAGE
#undef PG8_LDA
#undef PG8_LDB
#undef PG8_MMA
#undef PG8_WAIT_V
#undef PG8_WAIT_L
#undef PG8_BAR
#undef PG8_SCHED
}
}
constexpr int NWAVES = 8;
constexpr int BATCH = 4, SEQ = 8192, DM = 1024, CTXL = 256, FF = 4096;
constexpr int ML = BATCH * SEQ;
constexpr int MC = BATCH * CTXL;
constexpr int MALL = ML + MC;
constexpr int INCOLS = 2560, RWC = 1792;
constexpr float NORM_EPS = 1e-6f, GN_EPS = 64e-5f;
#ifndef MK_N_LAUNCHES
#define MK_N_LAUNCHES 19
#endif
constexpr int N_PHASES = 19;

constexpr size_t MiB = 1u << 20;
constexpr size_t WS_MOD = 0;
constexpr size_t WS_ROPE = 256 * 1024;
constexpr size_t WS_TW = 320 * 1024;
constexpr size_t WS_DFTC = 384 * 1024;
constexpr size_t WS_W2A = 640 * 1024;
constexpr size_t WS_W2B = 704 * 1024;
constexpr size_t WS_LW2 = 768 * 1024;
constexpr size_t WS_LA2 = 896 * 1024;
constexpr size_t WS_LG2 = 1024 * 1024;
constexpr size_t WS_INVN = 1280 * 1024;
constexpr size_t WS_WIN = 3 * MiB, WS_WOUT = 8 * MiB, WS_WF = 10 * MiB, WS_W1 = 12 * MiB  , WS_W2 = 28 * MiB  ;
constexpr size_t WS_XN = 44 * MiB;
constexpr size_t WS_AD = 44 * MiB;
constexpr size_t WS_QKV = 110 * MiB;
constexpr size_t WS_ZR = 160 * MiB;
constexpr size_t WS_ATTRW = 276 * MiB;
constexpr size_t WS_ZS = 340 * MiB;
constexpr size_t WS_LW = 439 * MiB;
constexpr size_t WS_H = 160 * MiB;
constexpr size_t WS_G1 = 160 * MiB;
constexpr size_t WS_Y1 = 288 * MiB;
constexpr size_t WS_F1 = 416 * MiB;
constexpr size_t WS_END = 512 * MiB;
constexpr size_t DO_Y = 0, DO_G = 64 * MiB;

constexpr int RING_BYTES = 131072;
constexpr int LDS_BYTES = 147456;

#define GAS __attribute__((address_space(1)))
#define LAS __attribute__((address_space(3)))
typedef unsigned short bf16;
typedef unsigned v4u __attribute__((ext_vector_type(4)));
typedef unsigned v2u __attribute__((ext_vector_type(2)));
typedef float f32x4 __attribute__((ext_vector_type(4)));
typedef float f32x16 __attribute__((ext_vector_type(16)));
typedef short bf16x8 __attribute__((ext_vector_type(8)));
typedef short s16x4 __attribute__((ext_vector_type(4)));
#define LDS_WAIT() asm volatile("s_waitcnt lgkmcnt(0)" ::: "memory")
__device__ __forceinline__ unsigned f2bf(float f) { unsigned u = __builtin_bit_cast(unsigned, f); return (u + 0x7fffu + ((u >> 16) & 1u)) >> 16; }
__device__ __forceinline__ unsigned pk2(float lo, float hi) { return f2bf(lo) | (f2bf(hi) << 16); }
__device__ __forceinline__ float bf_lo(unsigned u) { return __builtin_bit_cast(float, u << 16); }
__device__ __forceinline__ float bf_hi(unsigned u) { return __builtin_bit_cast(float, u & 0xffff0000u); }
__device__ __forceinline__ float bf1(bf16 u) { return __builtin_bit_cast(float, (unsigned)u << 16); }
__device__ __forceinline__ float wave_sum(float v) {
#pragma unroll
    for (int o = 1; o < 64; o <<= 1) v += __shfl_xor(v, o);
    return v;
}
template <int CTRL> __device__ __forceinline__ float dppf(float x) { return __builtin_bit_cast(float, __builtin_amdgcn_mov_dpp(__builtin_bit_cast(int, x), CTRL, 0xf, 0xf, true)); }
__device__ __forceinline__ float sum8(float x) { x += dppf<0xB1>(x); x += dppf<0x4E>(x); x += dppf<0x141>(x); return x; }
__device__ __forceinline__ float sigmoidf_(float x) { return 1.f / (1.f + __expf(-x)); }

struct Frame {
    LAS unsigned char* lds;
    int tid, lane, wave, vcu, G;
    unsigned char* ws; float* out;
};
struct Args { const float* in[27]; float* out; unsigned char* ws; int ph_lo, ph_hi; };
enum { I_X = 0, I_C, I_CTX, I_CCTX, I_ADAW, I_ADAB, I_N1G, I_N2G, I_WIN, I_WOUT, I_SINK, I_MUP, I_MUN, I_DW0, I_DW2, I_IA0, I_IA2, I_GG2, I_KK, I_KA, I_RK, I_LNG, I_LNB, I_FW, I_W1, I_W2, I_FING };

__device__ __forceinline__ void p0_transpose_item(const float* W, int K, int N, bf16* WT, LAS float* scr, int item, int lane, float scale) {
    const int nblk = N / 32, kb = item / nblk, nb = item % nblk, k0 = 64 * kb, n0 = 32 * nb;
#pragma unroll 8
    for (int i = 0; i < 32; ++i) { const int kk = 2 * i + (lane >> 5); scr[kk * 33 + (lane & 31)] = W[(size_t)(k0 + kk) * N + n0 + (lane & 31)] * scale; }
    LDS_WAIT(); asm volatile("" ::: "memory");
    const int c = lane & 7;
#pragma unroll
    for (int j = 0; j < 4; ++j) { const int n = (lane >> 3) + 8 * j; const LAS float* s = scr + (8 * c) * 33 + n;
        v4u o; o.x = pk2(s[0 * 33], s[1 * 33]); o.y = pk2(s[2 * 33], s[3 * 33]); o.z = pk2(s[4 * 33], s[5 * 33]); o.w = pk2(s[6 * 33], s[7 * 33]);
        *(GAS v4u*)(WT + (size_t)(n0 + n) * K + k0 + 8 * c) = o; }
    LDS_WAIT(); asm volatile("" ::: "memory");
}
__device__ __forceinline__ void p0_prologue(Frame& F, const Args& A_) {
    LAS float* scr = (LAS float*)(F.lds + F.wave * 16384);
    const int gw = F.vcu * NWAVES + F.wave, NGW = F.G * NWAVES;
    constexpr int I_IN = 16 * 80, I_O = 16 * 32, I_U = 16 * 128, I_D = 64 * 32;
    constexpr int I_LW = 2 * 16, I_LG = 2 * 16;
    constexpr int NITEMS = I_IN + 2 * I_O + 2 * I_U + 2 * I_D + 2 * I_LW + I_LG;
    for (int it = gw; it < NITEMS; it += NGW) {
        int r = it;
        if (r < I_IN) { p0_transpose_item(A_.in[I_WIN], 1024, INCOLS, (bf16*)(F.ws + WS_WIN), scr, r, F.lane, 1.f); continue; } r -= I_IN;
        if (r < I_O) { p0_transpose_item(A_.in[I_WOUT], 1024, 1024, (bf16*)(F.ws + WS_WOUT), scr, r, F.lane, 1.f); continue; } r -= I_O;
        if (r < I_O) { p0_transpose_item(A_.in[I_FW], 1024, 1024, (bf16*)(F.ws + WS_WF), scr, r, F.lane, 1.f); continue; } r -= I_O;
        if (r < 2 * I_U) { const int l = r / I_U; p0_transpose_item(A_.in[I_W1] + (size_t)l * 1024 * FF, 1024, FF, (bf16*)(F.ws + WS_W1) + (size_t)l * 1024 * FF, scr, r % I_U, F.lane, 1.f); continue; } r -= 2 * I_U;
        if (r < 2 * I_D) { const int l = r / I_D; p0_transpose_item(A_.in[I_W2] + (size_t)l * 1024 * FF, FF, 1024, (bf16*)(F.ws + WS_W2) + (size_t)l * 1024 * FF, scr, r % I_D, F.lane, 1.f); continue; } r -= 2 * I_D;
        if (r < I_LW) { const int d = r / 16; p0_transpose_item(A_.in[I_DW2] + (size_t)d * 64 * 512, 64, 512, (bf16*)(F.ws + WS_LW2) + (size_t)d * 512 * 64, scr, r % 16, F.lane, 1.f); continue; } r -= I_LW;
        if (r < I_LW) { const int d = r / 16; p0_transpose_item(A_.in[I_IA2] + (size_t)d * 64 * 512, 64, 512, (bf16*)(F.ws + WS_LA2) + (size_t)d * 512 * 64, scr, r % 16, F.lane, 1.f); continue; } r -= I_LW;
        p0_transpose_item(A_.in[I_GG2], 128, 512, (bf16*)(F.ws + WS_LG2), scr, r, F.lane, 1.f);
    }
    const int gt = F.vcu * 512 + F.tid, NGT = F.G * 512;
    const float TWO_PI = 6.283185307179586f;
    for (int i = gt; i < 128 * 16; i += NGT) {
        const int pos = i >> 4, j = i & 15; const float inv = exp2f(-(float)j * (13.287712379549449f / 16.f));
        const float ang = (float)pos * inv; const float rev = ang * 0.15915494309189535f;
        float* o = (float*)(F.ws + WS_ROPE) + 2 * i; o[0] = __builtin_amdgcn_cosf(rev - floorf(rev)); o[1] = __builtin_amdgcn_sinf(rev - floorf(rev));
    }
    for (int i = gt; i < 8192; i += NGT) { const float rev = (float)i * (1.f / 8192.f); float* o = (float*)(F.ws + WS_TW) + 2 * i; o[0] = __builtin_amdgcn_cosf(rev); o[1] = __builtin_amdgcn_sinf(rev); }
    for (int i = gt; i < 512 * 256; i += NGT) {
        const int j = i >> 8, c = i & 255; const int ph = (c * (j & 255)) & 255; const float rev = (float)ph * (1.f / 256.f);
        const float v = (j < 256) ? __builtin_amdgcn_cosf(rev) : -__builtin_amdgcn_sinf(rev);
        ((bf16*)(F.ws + WS_DFTC))[i] = (bf16)f2bf(v * 0.0625f);
    }
    for (int i = gt; i < 128 * 128; i += NGT) {
        const int o = i >> 7, k = i & 127; const int pp = o >> 6, l1p = o & 63, p = k >> 6, l1 = k & 63; const float rev = (float)((l1 * l1p) & 63) * (1.f / 64.f);
        const float cs = __builtin_amdgcn_cosf(rev), sn = __builtin_amdgcn_sinf(rev);
        const float v = (pp == 0) ? (p == 0 ? cs : sn) : (p == 0 ? -sn : cs);
        ((bf16*)(F.ws + WS_W2A))[i] = (bf16)f2bf(v * 0.125f);
    }
    for (int i = gt; i < 128 * 256; i += NGT) {
        const int o = i >> 8, k = i & 255; const int p = k >> 7, l2 = k & 127; const float rev = (float)((l2 * o) & 127) * (1.f / 128.f);
        const float v = (p == 0) ? __builtin_amdgcn_cosf(rev) : __builtin_amdgcn_sinf(rev);
        ((bf16*)(F.ws + WS_W2B))[i] = (bf16)f2bf(v * 0.08838834764831845f);
    }
    {
        LAS float* sl = (LAS float*)(F.lds + 0);
        __syncthreads();
        for (int i = F.tid; i < 5 * 1024; i += 512) { const int r = i >> 10, k = i & 1023; const float cv = (r < 4) ? A_.in[I_C][r * 1024 + k] : A_.in[I_CCTX][k]; sl[i] = cv * sigmoidf_(cv); }
        __syncthreads();
        LAS float* red = (LAS float*)(F.lds + 32768);
        for (int item = F.vcu; item < 2 * 96; item += F.G) {
            const int layer = item / 96, n0 = (item % 96) * 64;
            const float* W = A_.in[I_ADAW] + (size_t)layer * 1024 * 6144 + n0 + F.lane;
            float a0 = 0.f, a1 = 0.f, a2 = 0.f, a3 = 0.f, a4 = 0.f;
            const int k0 = F.wave * 128;
#pragma unroll 8
            for (int k = k0; k < k0 + 128; ++k) { const float w = W[(size_t)k * 6144]; a0 += sl[k] * w; a1 += sl[1024 + k] * w; a2 += sl[2048 + k] * w; a3 += sl[3072 + k] * w; a4 += sl[4096 + k] * w; }
            red[(F.wave * 5 + 0) * 64 + F.lane] = a0; red[(F.wave * 5 + 1) * 64 + F.lane] = a1; red[(F.wave * 5 + 2) * 64 + F.lane] = a2; red[(F.wave * 5 + 3) * 64 + F.lane] = a3; red[(F.wave * 5 + 4) * 64 + F.lane] = a4;
            __syncthreads();
            if (F.tid < 320) { const int r = F.tid >> 6, l = F.tid & 63; float s = 0.f;
#pragma unroll
                for (int w = 0; w < 8; ++w) s += red[(w * 5 + r) * 64 + l];
                ((float*)(F.ws + WS_MOD))[(size_t)(layer * 5 + r) * 6144 + n0 + l] = s + A_.in[I_ADAB][layer * 6144 + n0 + l]; }
            __syncthreads();
        }
    }
}

__device__ __forceinline__ void norm_phase(Frame& F, const float* xl, const float* xc, int nrows, const float* g, const float* modl  , int sh_off, bf16* dst) {
    const int gw = F.vcu * NWAVES + F.wave, NGW = F.G * NWAVES;
    for (int m = gw; m < nrows; m += NGW) {
        const float* xrow = (m < ML) ? xl + (size_t)m * DM : xc + (size_t)(m - ML) * DM;
        const int r = (m < ML) ? (m >> 13) : 4;
        const float* sh = modl + (size_t)r * 6144 + sh_off; const float* sc = sh + 1024;
        const GAS f32x4* xr = (const GAS f32x4*)xrow + F.lane;
        f32x4 v[4]; float s = 0.f;
#pragma unroll
        for (int j = 0; j < 4; ++j) { v[j] = xr[64 * j]; s += (v[j].x * v[j].x + v[j].y * v[j].y) + (v[j].z * v[j].z + v[j].w * v[j].w); }
        const float rstd = 1.f / sqrtf(wave_sum(s) * (1.f / DM) + NORM_EPS);
        GAS unsigned long long* o8 = (GAS unsigned long long*)(dst + (size_t)m * DM) + F.lane;
#pragma unroll
        for (int j = 0; j < 4; ++j) { const int c = 4 * F.lane + 256 * j;
            const f32x4 gg = *(const f32x4*)(g + c), a = *(const f32x4*)(sc + c), b = *(const f32x4*)(sh + c);
            const f32x4 o = (v[j] * rstd * gg) * (a + 1.f) + b;
            o8[64 * j] = (unsigned long long)pk2(o.x, o.y) | ((unsigned long long)pk2(o.z, o.w) << 32); }
    }
}
__device__ __forceinline__ void final_norm_phase(Frame& F, float* x, const float* g) {
    const int gw = F.vcu * NWAVES + F.wave, NGW = F.G * NWAVES;
    for (int m = gw; m < ML; m += NGW) {
        GAS f32x4* xr = (GAS f32x4*)(x + (size_t)m * DM) + F.lane;
        f32x4 v[4]; float s = 0.f;
#pragma unroll
        for (int j = 0; j < 4; ++j) { v[j] = xr[64 * j]; s += (v[j].x * v[j].x + v[j].y * v[j].y) + (v[j].z * v[j].z + v[j].w * v[j].w); }
        const float rstd = 1.f / sqrtf(wave_sum(s) * (1.f / DM) + NORM_EPS);
#pragma unroll
        for (int j = 0; j < 4; ++j) { const f32x4 gg = *(const f32x4*)(g + 4 * F.lane + 256 * j); xr[64 * j] = v[j] * rstd * gg; }
    }
}
__device__ __forceinline__ f32x16 mfma32(bf16x8 a, bf16x8 b, f32x16 c) { return __builtin_amdgcn_mfma_f32_32x32x16_bf16(a, b, c, 0, 0, 0); }
__device__ __forceinline__ s16x4 tr_read(const LAS unsigned char* p) { return __builtin_bit_cast(s16x4, __builtin_amdgcn_ds_read_tr16_b64_v4i16((LAS s16x4*)p)); }
__device__ __forceinline__ bf16x8 cat4(s16x4 lo, s16x4 hi) { return (bf16x8){lo[0], lo[1], lo[2], lo[3], hi[0], hi[1], hi[2], hi[3]}; }
__device__ __forceinline__ bf16x8 pack8(const f32x16& p, int b) {
    v4u w; w.x = pk2(p[b + 0], p[b + 1]); w.y = pk2(p[b + 2], p[b + 3]); w.z = pk2(p[b + 4], p[b + 5]); w.w = pk2(p[b + 6], p[b + 7]);
    return __builtin_bit_cast(bf16x8, w);
}
constexpr int KP = 144;
__device__ __forceinline__ void attn_phase(Frame& F, const Args& A_) {
    const bf16* QKV = (const bf16*)(F.ws + WS_QKV); bf16* O = (bf16*)(F.ws + WS_ATTRW);
    LAS unsigned char* Ks = F.lds; LAS unsigned char* Vs = F.lds + 64 * KP;
    const int lane = F.lane, r32 = lane & 31, hi = lane >> 5;
    const int g = F.wave & 3, half = F.wave >> 2;
    for (int unit = F.vcu; unit < 1024; unit += F.G) {
        const int b = unit >> 8, kvh = (unit >> 7) & 1, qb = unit & 127, s0 = qb * 64;
        const int head = kvh * 4 + g; const int tq = s0 + half * 32 + r32;
        const bf16* qrow = QKV + (size_t)(b * SEQ + tq) * 768 + head * 64;
        bf16x8 qf[4];
#pragma unroll
        for (int s = 0; s < 4; ++s) qf[s] = *(const bf16x8*)(qrow + 16 * s + 8 * hi);
        float m = A_.in[I_SINK][head] * 1.4426950408889634f, l = (hi == 0) ? 1.f : 0.f;
        f32x16 o0 = {}, o1 = {};
        for (int tile = 0; tile < 9; ++tile) {
            int krow0, ks = 0; const bool local = tile >= 4;
            if (!local) krow0 = ML + b * CTXL + tile * 64;
            else { ks = s0 - 128 + (tile - 4) * 64; if (ks < 0 || ks >= SEQ) continue; krow0 = b * SEQ + ks; }
            __syncthreads();
            { const int key = F.tid >> 3, ch = F.tid & 7; const bf16* kp = QKV + (size_t)(krow0 + key) * 768 + 512 + kvh * 64 + ch * 8;
              const v4u kv = *(const v4u*)kp, vv = *(const v4u*)(kp + 128);
              *(LAS v4u*)(Ks + key * KP + ch * 16) = kv; *(LAS v4u*)(Vs + key * KP + ch * 16) = vv; }
            __syncthreads();
            f32x16 p0 = {}, p1 = {};
#pragma unroll
            for (int s = 0; s < 4; ++s) {
                const bf16x8 a0 = *(const LAS bf16x8*)(Ks + r32 * KP + (16 * s + 8 * hi) * 2);
                const bf16x8 a1 = *(const LAS bf16x8*)(Ks + (32 + r32) * KP + (16 * s + 8 * hi) * 2);
                p0 = mfma32(a0, qf[s], p0); p1 = mfma32(a1, qf[s], p1);
            }
            if (local) {
#pragma unroll
                for (int r = 0; r < 16; ++r) { const int key = (r & 3) + 8 * (r >> 2) + 4 * hi; const int d0 = tq - (ks + key), d1 = d0 - 32;
                    if (d0 > 128 || d0 < -128) p0[r] = -INFINITY; if (d1 > 128 || d1 < -128) p1[r] = -INFINITY; }
            }
            float mx = fmaxf(p0[0], p1[0]);
#pragma unroll
            for (int r = 1; r < 16; ++r) mx = fmaxf(mx, fmaxf(p0[r], p1[r]));
            mx = fmaxf(mx, __shfl_xor(mx, 32));
            const float mn = fmaxf(m, mx), alpha = exp2f(m - mn); m = mn;
            float ls = 0.f;
#pragma unroll
            for (int r = 0; r < 16; ++r) { p0[r] = exp2f(p0[r] - mn); p1[r] = exp2f(p1[r] - mn); ls += p0[r] + p1[r]; }
            l = l * alpha + ls;
#pragma unroll
            for (int r = 0; r < 16; ++r) { o0[r] *= alpha; o1[r] *= alpha; }
            const bf16x8 pb0 = pack8(p0, 0), pb1 = pack8(p0, 8), pb2 = pack8(p1, 0), pb3 = pack8(p1, 8);
            const int i16 = lane & 15, qd = i16 >> 2, pp = i16 & 3, c0 = lane & 16;
            const LAS unsigned char* vb = Vs + (4 * hi + qd) * KP + (c0 + 4 * pp) * 2;
#define PVSTEP(s, pb) do { \
                const bf16x8 va0 = cat4(tr_read(vb + (16 * (s)) * KP), tr_read(vb + (16 * (s) + 8) * KP)); \
                const bf16x8 va1 = cat4(tr_read(vb + (16 * (s)) * KP + 64), tr_read(vb + (16 * (s) + 8) * KP + 64)); \
                o0 = mfma32(va0, pb, o0); o1 = mfma32(va1, pb, o1); } while (0)
            PVSTEP(0, pb0); PVSTEP(1, pb1); PVSTEP(2, pb2); PVSTEP(3, pb3);
#undef PVSTEP
        }
        l += __shfl_xor(l, 32);
        const float inv = 1.f / l;
        bf16* orow = O + (size_t)(b * SEQ + tq) * 1024 + head * 64;
#pragma unroll
        for (int q4 = 0; q4 < 4; ++q4) {
            const int d = 8 * q4 + 4 * hi;
            v2u w0, w1; w0.x = pk2(o0[4 * q4] * inv, o0[4 * q4 + 1] * inv); w0.y = pk2(o0[4 * q4 + 2] * inv, o0[4 * q4 + 3] * inv);
            w1.x = pk2(o1[4 * q4] * inv, o1[4 * q4 + 1] * inv); w1.y = pk2(o1[4 * q4 + 2] * inv, o1[4 * q4 + 3] * inv);
            *(v2u*)(orow + d) = w0; *(v2u*)(orow + 32 + d) = w1;
        }
    }
}

constexpr int AP = 144, AP3 = 272;
__device__ __forceinline__ void rwkv_prep_phase(Frame& F, const Args& A_) {
    const bf16* ZR = (const bf16*)(F.ws + WS_ZR); bf16* ZS = (bf16*)(F.ws + WS_ZS); float* INVN = (float*)(F.ws + WS_INVN);
    bf16* LW = (bf16*)(F.ws + WS_LW); bf16* AD = (bf16*)(F.ws + WS_AD); bf16* GG = (bf16*)((unsigned char*)F.out + DO_G);
    const bf16* W2T = (const bf16*)(F.ws + WS_LW2); const bf16* A2T = (const bf16*)(F.ws + WS_LA2); const bf16* G2T = (const bf16*)(F.ws + WS_LG2);
    LAS unsigned char* A1 = F.lds; LAS unsigned char* A2 = F.lds + 32 * AP; LAS unsigned char* A3 = F.lds + 64 * AP;
    const float* mup = A_.in[I_MUP]; const float* mun = A_.in[I_MUN]; const float* kkw = A_.in[I_KK];
    const int lane = F.lane, r32 = lane & 31, hi = lane >> 5;
    for (int unit = F.vcu; unit < MALL / 32; unit += F.G) {
        const int R0 = unit * 32;
        __syncthreads();
        for (int item = F.tid; item < 32 * 224; item += 512) {
            const int tk = item / 224, ch = item % 224, row = R0 + tk, col = ch * 8;
            const int seqlen = (row < ML) ? SEQ : CTXL; const int pos = (row < ML) ? (row & (SEQ - 1)) : ((row - ML) & (CTXL - 1));
            const v4u zc = *(const v4u*)(ZR + (size_t)row * RWC + col);
            v4u zp = {0u, 0u, 0u, 0u}, zn = {0u, 0u, 0u, 0u};
            if (pos > 0) zp = *(const v4u*)(ZR + (size_t)(row - 1) * RWC + col);
            if (pos < seqlen - 1) zn = *(const v4u*)(ZR + (size_t)(row + 1) * RWC + col);
            const f32x4 mp0 = *(const f32x4*)(mup + col), mp1 = *(const f32x4*)(mup + col + 4), mn0 = *(const f32x4*)(mun + col), mn1 = *(const f32x4*)(mun + col + 4);
            float z[8];
#pragma unroll
            for (int e = 0; e < 4; ++e) {
                const float c0 = bf_lo(zc[e]), c1 = bf_hi(zc[e]), p0 = bf_lo(zp[e]), p1 = bf_hi(zp[e]), n0 = bf_lo(zn[e]), n1 = bf_hi(zn[e]);
                const float a0 = (2 * e < 4) ? mp0[2 * e] : mp1[2 * e - 4], a1 = (2 * e + 1 < 4) ? mp0[2 * e + 1] : mp1[2 * e - 3];
                const float b0 = (2 * e < 4) ? mn0[2 * e] : mn1[2 * e - 4], b1 = (2 * e + 1 < 4) ? mn0[2 * e + 1] : mn1[2 * e - 3];
                z[2 * e] = c0 + a0 * (p0 - c0) + b0 * (n0 - c0); z[2 * e + 1] = c1 + a1 * (p1 - c1) + b1 * (n1 - c1);
            }
            if (ch < 192) {
                v4u w; w.x = pk2(z[0], z[1]); w.y = pk2(z[2], z[3]); w.z = pk2(z[4], z[5]); w.w = pk2(z[6], z[7]);
                *(v4u*)(ZS + (size_t)row * 1536 + col) = w;
            }
            {
                float ss = 0.f;
                if (ch >= 64 && ch < 128) { const f32x4 k0 = *(const f32x4*)(kkw + col - 512), k1 = *(const f32x4*)(kkw + col - 508);
#pragma unroll
                    for (int e = 0; e < 4; ++e) { const float a = z[e] * k0[e], b = z[4 + e] * k1[e]; ss += a * a + b * b; } }
                ss = sum8(ss);
                if (ch >= 64 && ch < 128 && (ch & 7) == 0) INVN[(size_t)row * 8 + ((ch - 64) >> 3)] = 1.f / sqrtf(ss + 1e-12f);
            }
            if (ch >= 192) {
                v4u w;
                if (ch < 200) {
                    float t[8];
#pragma unroll
                    for (int e = 0; e < 8; ++e) { const float ex = __expf(-2.f * fabsf(z[e])); const float th = (1.f - ex) / (1.f + ex); t[e] = z[e] < 0.f ? -th : th; }
                    w.x = pk2(t[0], t[1]); w.y = pk2(t[2], t[3]); w.z = pk2(t[4], t[5]); w.w = pk2(t[6], t[7]);
                    *(LAS v4u*)(A1 + tk * AP + (ch - 192) * 16) = w;
                } else if (ch < 208) {
                    w.x = pk2(z[0], z[1]); w.y = pk2(z[2], z[3]); w.z = pk2(z[4], z[5]); w.w = pk2(z[6], z[7]);
                    *(LAS v4u*)(A2 + tk * AP + (ch - 200) * 16) = w;
                } else {
                    float t[8];
#pragma unroll
                    for (int e = 0; e < 8; ++e) t[e] = sigmoidf_(z[e]);
                    w.x = pk2(t[0], t[1]); w.y = pk2(t[2], t[3]); w.z = pk2(t[4], t[5]); w.w = pk2(t[6], t[7]);
                    *(LAS v4u*)(A3 + tk * AP3 + (ch - 208) * 16) = w;
                }
            }
        }
        __syncthreads();
        bf16x8 af[4];
#pragma unroll
        for (int s = 0; s < 4; ++s) af[s] = *(const LAS bf16x8*)(A1 + r32 * AP + (16 * s + 8 * hi) * 2);
#pragma unroll 1
        for (int t = 0; t < 4; ++t) {
            const int n = F.wave * 128 + t * 32 + r32; f32x16 acc = {};
#pragma unroll
            for (int s = 0; s < 4; ++s) acc = mfma32(af[s], *(const bf16x8*)(W2T + (size_t)n * 64 + 16 * s + 8 * hi), acc);
            const int d = n >> 9, chn = n & 511; const float w0 = A_.in[I_DW0][d * 512 + chn];
#pragma unroll
            for (int r = 0; r < 16; ++r) { const int row = R0 + (r & 3) + 8 * (r >> 2) + 4 * hi; const float x = w0 + acc[r];
                const float sp = fmaxf(-x, 0.f) + __logf(1.f + __expf(-fabsf(x)));
                const float lw = -__expf(-sp - 0.5f);
                LW[((size_t)d * MALL + row) * 512 + chn] = (bf16)f2bf(lw); }
        }
#pragma unroll
        for (int s = 0; s < 4; ++s) af[s] = *(const LAS bf16x8*)(A2 + r32 * AP + (16 * s + 8 * hi) * 2);
#pragma unroll 1
        for (int t = 0; t < 4; ++t) {
            const int n = F.wave * 128 + t * 32 + r32; f32x16 acc = {};
#pragma unroll
            for (int s = 0; s < 4; ++s) acc = mfma32(af[s], *(const bf16x8*)(A2T + (size_t)n * 64 + 16 * s + 8 * hi), acc);
            const int d = n >> 9, chn = n & 511; const float a0 = A_.in[I_IA0][d * 512 + chn];
#pragma unroll
            for (int r = 0; r < 16; ++r) { const int row = R0 + (r & 3) + 8 * (r >> 2) + 4 * hi;
                AD[((size_t)d * MALL + row) * 512 + chn] = (bf16)f2bf(sigmoidf_(a0 + acc[r])); }
        }
        if (R0 < ML) {
#pragma unroll 1
            for (int t = 0; t < 2; ++t) {
                const int n = F.wave * 64 + t * 32 + r32; f32x16 acc = {};
#pragma unroll
                for (int s = 0; s < 8; ++s) acc = mfma32(*(const LAS bf16x8*)(A3 + r32 * AP3 + (16 * s + 8 * hi) * 2), *(const bf16x8*)(G2T + (size_t)n * 128 + 16 * s + 8 * hi), acc);
#pragma unroll
                for (int r = 0; r < 16; ++r) { const int row = R0 + (r & 3) + 8 * (r >> 2) + 4 * hi; GG[(size_t)row * 512 + n] = (bf16)f2bf(acc[r]); }
            }
        }
    }
}

__device__ __forceinline__ void rwkv_scan_phase(Frame& F, const Args& A_) {
    if (F.vcu >= 64) return;
    const int chain = F.vcu, b = chain >> 4, h = (chain >> 1) & 7, d = chain & 1;
    const bf16* ZS = (const bf16*)(F.ws + WS_ZS); const float* INVN = (const float*)(F.ws + WS_INVN);
    const bf16* LW = (const bf16*)(F.ws + WS_LW) + (size_t)d * MALL * 512; const bf16* AD = (const bf16*)(F.ws + WS_AD) + (size_t)d * MALL * 512;
    bf16* Y = (bf16*)((unsigned char*)F.out + DO_Y) + (size_t)d * ML * 512;
    LAS float* buf = (LAS float*)F.lds;
    LAS float* ybuf = (LAS float*)(F.lds + 2 * 6 * 8192);
    const int v = F.wave * 8 + (F.lane >> 3), kq = F.lane & 7;
    const int sj = F.tid >> 4, c4 = (F.tid & 15) * 4, chn = h * 64 + c4;
    const f32x4 kkc = *(const f32x4*)(A_.in[I_KK] + chn), kac = *(const f32x4*)(A_.in[I_KA] + chn);
    float S[8];
#pragma unroll
    for (int i = 0; i < 8; ++i) S[i] = 0.f;
#define rowof(s) (((s) < CTXL) ? (ML + b * CTXL + (d == 0 ? (s) : CTXL - 1 - (s))) : (b * SEQ + (d == 0 ? ((s) - CTXL) : (SEQ - 1 - ((s) - CTXL)))))
    v2u g_lw, g_a, g_r, g_k, g_v; float g_in;
#define SCAN_LOAD(bt) do { const int row_ = rowof((bt) * 32 + sj); \
        g_lw = *(const v2u*)(LW + (size_t)row_ * 512 + chn); g_a = *(const v2u*)(AD + (size_t)row_ * 512 + chn); \
        g_r = *(const v2u*)(ZS + (size_t)row_ * 1536 + chn); g_k = *(const v2u*)(ZS + (size_t)row_ * 1536 + 512 + chn); g_v = *(const v2u*)(ZS + (size_t)row_ * 1536 + 1024 + chn); \
        g_in = INVN[(size_t)row_ * 8 + h]; } while (0)
#define SCAN_STORE(bt) do { LAS float* bb_ = buf + ((bt) & 1) * 6 * 2048 + sj * 64 + c4; \
        const f32x4 lw_ = {bf_lo(g_lw.x), bf_hi(g_lw.x), bf_lo(g_lw.y), bf_hi(g_lw.y)}, a_ = {bf_lo(g_a.x), bf_hi(g_a.x), bf_lo(g_a.y), bf_hi(g_a.y)}; \
        const f32x4 r_ = {bf_lo(g_r.x), bf_hi(g_r.x), bf_lo(g_r.y), bf_hi(g_r.y)}, k_ = {bf_lo(g_k.x), bf_hi(g_k.x), bf_lo(g_k.y), bf_hi(g_k.y)}, v_ = {bf_lo(g_v.x), bf_hi(g_v.x), bf_lo(g_v.y), bf_hi(g_v.y)}; \
        f32x4 w_, kk_, b_, kd_; \
        _Pragma("unroll") for (int e = 0; e < 4; ++e) { w_[e] = __expf(lw_[e]); kk_[e] = k_[e] * kkc[e] * g_in; b_[e] = kk_[e] * a_[e]; kd_[e] = k_[e] * (1.f + (a_[e] - 1.f) * kac[e]); } \
        *(LAS f32x4*)(bb_) = w_; *(LAS f32x4*)(bb_ + 2048) = kk_; *(LAS f32x4*)(bb_ + 4096) = b_; *(LAS f32x4*)(bb_ + 6144) = kd_; *(LAS f32x4*)(bb_ + 8192) = r_; *(LAS f32x4*)(bb_ + 10240) = v_; } while (0)
    constexpr int NB = (CTXL + SEQ) / 32;
    SCAN_LOAD(0); SCAN_STORE(0);
    __syncthreads();
    for (int bt = 0; bt < NB; ++bt) {
        if (bt + 1 < NB) SCAN_LOAD(bt + 1);
        const LAS float* cb = buf + (bt & 1) * 6 * 2048;
#pragma unroll 2
        for (int j = 0; j < 32; ++j) {
            const LAS float* p = cb + j * 64 + kq * 8;
            const f32x4 w0 = *(const LAS f32x4*)(p), w1 = *(const LAS f32x4*)(p + 4);
            const f32x4 k0 = *(const LAS f32x4*)(p + 2048), k1 = *(const LAS f32x4*)(p + 2052);
            const f32x4 b0 = *(const LAS f32x4*)(p + 4096), b1 = *(const LAS f32x4*)(p + 4100);
            const f32x4 d0 = *(const LAS f32x4*)(p + 6144), d1 = *(const LAS f32x4*)(p + 6148);
            const f32x4 r0 = *(const LAS f32x4*)(p + 8192), r1 = *(const LAS f32x4*)(p + 8196);
            const float vv = cb[10240 + j * 64 + v];
            float sk = 0.f;
#pragma unroll
            for (int e = 0; e < 4; ++e) sk += S[e] * k0[e] + S[4 + e] * k1[e];
            sk = sum8(sk);
            float yy = 0.f;
#pragma unroll
            for (int e = 0; e < 4; ++e) {
                S[e] = S[e] * w0[e] + (vv * d0[e] - sk * b0[e]); S[4 + e] = S[4 + e] * w1[e] + (vv * d1[e] - sk * b1[e]);
                yy += S[e] * r0[e] + S[4 + e] * r1[e];
            }
            yy = sum8(yy);
            if (kq == 0) ybuf[j * 64 + v] = yy;
        }
        if (bt + 1 < NB) SCAN_STORE(bt + 1);
        __syncthreads();
        if (bt >= CTXL / 32) {
            const int row = rowof(bt * 32 + sj);
            const f32x4 yv = *(const LAS f32x4*)(ybuf + sj * 64 + c4);
            v2u w; w.x = pk2(yv.x, yv.y); w.y = pk2(yv.z, yv.w);
            *(v2u*)(Y + (size_t)row * 512 + chn) = w;
        }
        __syncthreads();
    }
#undef SCAN_LOAD
#undef SCAN_STORE
#undef rowof
}

__device__ __forceinline__ void rwkv_readout_phase(Frame& F, const Args& A_) {
    const bf16* ZS = (const bf16*)(F.ws + WS_ZS); const bf16* Y0 = (const bf16*)((unsigned char*)F.out + DO_Y); const bf16* Y1 = Y0 + (size_t)ML * 512;
    const bf16* GG = (const bf16*)((unsigned char*)F.out + DO_G); bf16* O = (bf16*)(F.ws + WS_ATTRW);
    const int gw = F.vcu * NWAVES + F.wave, NGW = F.G * NWAVES, ch = F.lane * 8;
    float rk[8], lg[8], lb[8];
#pragma unroll
    for (int e = 0; e < 8; ++e) { rk[e] = A_.in[I_RK][ch + e]; lg[e] = A_.in[I_LNG][ch + e]; lb[e] = A_.in[I_LNB][ch + e]; }
    for (int row = gw; row < ML; row += NGW) {
        const v4u y0 = *(const v4u*)(Y0 + (size_t)row * 512 + ch), y1 = *(const v4u*)(Y1 + (size_t)row * 512 + ch);
        const v4u rr = *(const v4u*)(ZS + (size_t)row * 1536 + ch), kk = *(const v4u*)(ZS + (size_t)row * 1536 + 512 + ch), vv = *(const v4u*)(ZS + (size_t)row * 1536 + 1024 + ch);
        const v4u gg = *(const v4u*)(GG + (size_t)row * 512 + ch);
        float y[8], s = 0.f, bs = 0.f;
#pragma unroll
        for (int e = 0; e < 4; ++e) { y[2 * e] = bf_lo(y0[e]) + bf_lo(y1[e]); y[2 * e + 1] = bf_hi(y0[e]) + bf_hi(y1[e]); s += y[2 * e] + y[2 * e + 1];
            bs += bf_lo(rr[e]) * bf_lo(kk[e]) * rk[2 * e] + bf_hi(rr[e]) * bf_hi(kk[e]) * rk[2 * e + 1]; }
        const float mean = sum8(s) * (1.f / 64.f); bs = sum8(bs);
        float q = 0.f;
#pragma unroll
        for (int e = 0; e < 8; ++e) { y[e] -= mean; q += y[e] * y[e]; }
        const float rstd = 1.f / sqrtf(sum8(q) * (1.f / 64.f) + GN_EPS);
        float o[8];
#pragma unroll
        for (int e = 0; e < 4; ++e) {
            o[2 * e] = (y[2 * e] * rstd * lg[2 * e] + lb[2 * e] + bs * bf_lo(vv[e])) * bf_lo(gg[e]);
            o[2 * e + 1] = (y[2 * e + 1] * rstd * lg[2 * e + 1] + lb[2 * e + 1] + bs * bf_hi(vv[e])) * bf_hi(gg[e]);
        }
        v4u w; w.x = pk2(o[0], o[1]); w.y = pk2(o[2], o[3]); w.z = pk2(o[4], o[5]); w.w = pk2(o[6], o[7]);
        *(v4u*)(O + (size_t)row * 1024 + 512 + ch) = w;
    }
}
constexpr int FP = 1040;
template <bool PASS_A> __device__ __forceinline__ void fft_col_phase(Frame& F) {
    constexpr int KC = PASS_A ? 64 : 128, K2 = 2 * KC, NU = PASS_A ? 2048 : 1024;
    const bf16* In = (const bf16*)(F.ws + (PASS_A ? WS_G1 : WS_Y1)); bf16* Out = (bf16*)(F.ws + (PASS_A ? WS_Y1 : WS_F1));
    const bf16* W = (const bf16*)(F.ws + (PASS_A ? WS_W2A : WS_W2B)); const float* tw = (const float*)(F.ws + WS_TW);
    LAS unsigned char* T = F.lds;
    const int lane = F.lane, r32 = lane & 31, hi = lane >> 5, i16 = lane & 15, qd = i16 >> 2, pp = i16 & 3, c0 = lane & 16;
    for (int unit = F.vcu; unit < NU; unit += F.G) {
        int b, g, fix;
        if (PASS_A) { b = unit >> 9; g = (unit >> 7) & 3; fix = unit & 127; } else { b = unit >> 8; g = (unit >> 6) & 3; fix = unit & 63; }
        __syncthreads();
        for (int it = F.tid; it < KC * 64; it += 512) { const int k = it >> 6, c16 = it & 63; const int l = PASS_A ? (k * 128 + fix) : (fix * 128 + k);
            const v4u v = *(const v4u*)(In + ((size_t)(b * SEQ + l) * 4 + g) * 512 + c16 * 8);
            *(LAS v4u*)(T + k * FP + c16 * 16) = v; }
        __syncthreads();
        f32x16 acc[4] = {};
        const int cw = 32 * F.wave;
#pragma unroll 2
        for (int ks = 0; ks < K2 / 16; ++ks) {
            const int part = (16 * ks) / KC, kb = (16 * ks) % KC;
            const LAS unsigned char* tb = T + (kb + 8 * hi + qd) * FP + (part * 256 + cw + c0 + 4 * pp) * 2;
            const bf16x8 bf = cat4(tr_read(tb), tr_read(tb + 4 * FP));
#pragma unroll
            for (int t = 0; t < 4; ++t) { const bf16x8 af = *(const bf16x8*)(W + (size_t)(32 * t + r32) * K2 + 16 * ks + 8 * hi); acc[t] = mfma32(af, bf, acc[t]); }
        }
        const int cc = cw + r32;
        if (PASS_A) {
#pragma unroll
            for (int t = 0; t < 2; ++t)
#pragma unroll
                for (int r = 0; r < 16; ++r) { const int l1p = 32 * t + (r & 3) + 8 * (r >> 2) + 4 * hi; const int ti = (fix * l1p) & 8191;
                    const float cs = tw[2 * ti], sn = tw[2 * ti + 1]; const float a = acc[t][r], bq = acc[t + 2][r];
                    bf16* op = Out + ((size_t)(b * SEQ + l1p * 128 + fix) * 4 + g) * 512 + cc;
                    op[0] = (bf16)f2bf(a * cs + bq * sn); op[256] = (bf16)f2bf(bq * cs - a * sn); }
        } else {
#pragma unroll
            for (int t = 0; t < 4; ++t)
#pragma unroll
                for (int r = 0; r < 16; ++r) { const int l2p = 32 * t + (r & 3) + 8 * (r >> 2) + 4 * hi;
                    Out[((size_t)(b * SEQ + fix + 64 * l2p) * 4 + g) * 256 + cc] = (bf16)f2bf(acc[t][r]); }
        }
    }
}

__global__ void __launch_bounds__(NWAVES * 64, 2) skel_fwd(Args A_) {
    extern __shared__ __attribute__((aligned(16))) unsigned char lds[];
    Frame F;
    F.lds = (LAS unsigned char*)lds;
    F.tid = threadIdx.x; F.lane = F.tid & 63; F.wave = __builtin_amdgcn_readfirstlane(F.tid >> 6);
    F.G = gridDim.x; { const int bx = blockIdx.x; F.vcu = (F.G % 8 == 0) ? (bx % 8) * (F.G / 8) + bx / 8 : bx; }
    F.ws = A_.ws; F.out = A_.out;
    cg::grid_group grid = cg::this_grid();
    const int lo = A_.ph_lo, hi = A_.ph_hi;
#ifndef PHMASK
#define PHMASK 0x7ffff
#endif
#define IN(k) (((PHMASK >> (k)) & 1) && lo <= (k) && (k) < hi)
#define SEAM(k) do { if (IN(k) && IN((k) + 1)) grid.sync(); } while (0)
    const float* mod0 = (const float*)(F.ws + WS_MOD); const float* mod1 = mod0 + 5 * 6144;
    bf16* XN = (bf16*)(F.ws + WS_XN);

    if (IN(0)) { p0_prologue(F, A_); } SEAM(0);
    if (IN(1)) { norm_phase(F, A_.in[I_X], A_.in[I_CTX], MALL, A_.in[I_N1G], mod0, 0, XN); } SEAM(1);
    if (IN(2)) {
        pg8::Gemm g{XN, (const bf16*)(F.ws + WS_WIN), MALL, INCOLS, DM}; pg8::StaticOrder S; S.init(MALL, INCOLS, F.G, (int)blockIdx.x);
        pg8::EpiInProj E{(bf16*)(F.ws + WS_QKV), (bf16*)(F.ws + WS_ZR), (const float*)(F.ws + WS_ROPE)};
        pg8::gemm_phase<pg8::EpiInProj, pg8::StaticOrder, true, true>(F.lds, g, S, E);
    } SEAM(2);
    if (IN(3)) { attn_phase(F, A_); rwkv_prep_phase(F, A_); } SEAM(3);
    if (IN(4)) { rwkv_scan_phase(F, A_); } SEAM(4);
    if (IN(5)) { rwkv_readout_phase(F, A_); } SEAM(5);
    if (IN(6)) {
        pg8::Gemm g{(const bf16*)(F.ws + WS_ATTRW), (const bf16*)(F.ws + WS_WOUT), ML, DM, DM}; pg8::StaticOrder S; S.init(ML, DM, F.G, (int)blockIdx.x);
        pg8::EpiResidual E{A_.in[I_X], F.out, mod0 + 2048, 6144};
        pg8::gemm_phase<pg8::EpiResidual, pg8::StaticOrder, true, true>(F.lds, g, S, E);
    } SEAM(6);
    if (IN(7)) { norm_phase(F, F.out, nullptr, ML, A_.in[I_N2G], mod0, 3072, XN); } SEAM(7);
    if (IN(8)) {
        pg8::Gemm g{XN, (const bf16*)(F.ws + WS_W1), ML, FF, DM}; pg8::StaticOrder S; S.init(ML, FF, F.G, (int)blockIdx.x);
        pg8::EpiStore<2> E{(bf16*)(F.ws + WS_H), FF};
        pg8::gemm_phase<pg8::EpiStore<2>, pg8::StaticOrder, true, true>(F.lds, g, S, E);
    } SEAM(8);
    if (IN(9)) {
        pg8::Gemm g{(const bf16*)(F.ws + WS_H), (const bf16*)(F.ws + WS_W2), ML, DM, FF}; pg8::StaticOrder S; S.init(ML, DM, F.G, (int)blockIdx.x);
        pg8::EpiResidual E{F.out, F.out, mod0 + 5120, 6144};
        pg8::gemm_phase<pg8::EpiResidual, pg8::StaticOrder, true, true>(F.lds, g, S, E);
    } SEAM(9);
    if (IN(10)) { norm_phase(F, F.out, nullptr, ML, A_.in[I_N1G] + DM, mod1, 0, XN); } SEAM(10);
    if (IN(11)) {
        pg8::Gemm g{XN, (const bf16*)(F.ws + WS_DFTC), ML * 4, 512, 256}; pg8::StaticOrder S; S.init(ML * 4, 512, F.G, (int)blockIdx.x);
        pg8::EpiStore<0> E{(bf16*)(F.ws + WS_G1), 512};
        pg8::gemm_phase<pg8::EpiStore<0>, pg8::StaticOrder, true, true>(F.lds, g, S, E);
    } SEAM(11);
    if (IN(12)) { fft_col_phase<true>(F); } SEAM(12);
    if (IN(13)) { fft_col_phase<false>(F); } SEAM(13);
    if (IN(14)) {
        pg8::Gemm g{(const bf16*)(F.ws + WS_F1), (const bf16*)(F.ws + WS_WF), ML, DM, DM}; pg8::StaticOrder S; S.init(ML, DM, F.G, (int)blockIdx.x);
        pg8::EpiResidual E{F.out, F.out, mod1 + 2048, 6144};
        pg8::gemm_phase<pg8::EpiResidual, pg8::StaticOrder, true, true>(F.lds, g, S, E);
    } SEAM(14);
    if (IN(15)) { norm_phase(F, F.out, nullptr, ML, A_.in[I_N2G] + DM, mod1, 3072, XN); } SEAM(15);
    if (IN(16)) {
        pg8::Gemm g{XN, (const bf16*)(F.ws + WS_W1) + (size_t)DM * FF, ML, FF, DM}; pg8::StaticOrder S; S.init(ML, FF, F.G, (int)blockIdx.x);
        pg8::EpiStore<2> E{(bf16*)(F.ws + WS_H), FF};
        pg8::gemm_phase<pg8::EpiStore<2>, pg8::StaticOrder, true, true>(F.lds, g, S, E);
    } SEAM(16);
    if (IN(17)) {
        pg8::Gemm g{(const bf16*)(F.ws + WS_H), (const bf16*)(F.ws + WS_W2) + (size_t)DM * FF, ML, DM, FF}; pg8::StaticOrder S; S.init(ML, DM, F.G, (int)blockIdx.x);
        pg8::EpiResidual E{F.out, F.out, mod1 + 5120, 6144};
        pg8::gemm_phase<pg8::EpiResidual, pg8::StaticOrder, true, true>(F.lds, g, S, E);
    } SEAM(17);
    if (IN(18)) { final_norm_phase(F, F.out, A_.in[I_FING]); }
#undef IN
#undef SEAM
}

extern "C" void kernel_launch(void* const* d_in, const int* in_sizes, int n_in, void* d_out, int out_size, void* d_ws, size_t ws_size, hipStream_t stream) {
    static int grid = 0;
    if (grid == 0) {
        if (n_in != 27 || out_size != ML * DM || ws_size < WS_END) { fprintf(stderr, "kernel_launch: unexpected shapes: n_in %d out %d ws %zu\n", n_in, out_size, ws_size); grid = -1; return; }
        int dev = 0, cus = 0, per_cu = 0;
        (void)hipGetDevice(&dev); (void)hipDeviceGetAttribute(&cus, hipDeviceAttributeMultiprocessorCount, dev);
        (void)hipFuncSetAttribute((const void*)skel_fwd, hipFuncAttributeMaxDynamicSharedMemorySize, LDS_BYTES);
        (void)hipOccupancyMaxActiveBlocksPerMultiprocessor(&per_cu, (const void*)skel_fwd, NWAVES * 64, LDS_BYTES);
        (void)hipGetLastError();
        if (per_cu < 1) { fprintf(stderr, "kernel_launch: occupancy query reports %d\n", per_cu); }
        grid = cus;
    }
    if (grid < 0) return;
    Args a{};
    for (int i = 0; i < 27; ++i) a.in[i] = (const float*)d_in[i];
    a.out = (float*)d_out; a.ws = (unsigned char*)d_ws;
    if (MK_N_LAUNCHES == 1) {
        a.ph_lo = 0; a.ph_hi = N_PHASES;
        void* kargs[] = {&a};
        hipError_t e = hipLaunchCooperativeKernel((const void*)skel_fwd, dim3(grid), dim3(NWAVES * 64), kargs, LDS_BYTES, stream);
        if (e != hipSuccess) fprintf(stderr, "cooperative launch failed: %s (grid %d)\n", hipGetErrorString(e), grid);
    } else {
        for (int p = 0; p < N_PHASES; ++p) { a.ph_lo = p; a.ph_hi = p + 1; hipLaunchKernelGGL(skel_fwd, dim3(grid), dim3(NWAVES * 64), LDS_BYTES, stream, a); }
    }
}
```

```cpp
#include <hip/hip_runtime.h>
#include <hip/hip_cooperative_groups.h>
#include <cstdio>
#include <cstdint>
namespace cg = cooperative_groups;
namespace pg8 {
#define PG8_LAS __attribute__((address_space(3)))
typedef unsigned short bf16_t;
typedef short bf16x8 __attribute__((ext_vector_type(8)));
typedef float f32x4 __attribute__((ext_vector_type(4)));
typedef unsigned u32x4 __attribute__((ext_vector_type(4)));
constexpr int BM = 256, BK = 64, HALF = 128, HTB = HALF * BK * 2  , STAGE_BYTES = 8 * HTB, NXCD = 8, WGM = 8;

__host__ __device__ __forceinline__ int lds_byte(int r, int c) { const int st = (r >> 4) * 2 + (c >> 5), rr = r & 15, cc = c & 31, ob = rr * 64 + cc * 2; return st * 1024 + (ob ^ (((ob >> 9) & 1) << 5)); }
__host__ __device__ __forceinline__ void stage_rc(int b, int& R, int& C) { const int st = b / 1024, sb = b % 1024, swz = sb ^ (((sb >> 9) & 1) << 5); R = (st >> 1) * 16 + swz / 64; C = (st & 1) * 32 + (swz % 64) / 2; }
__host__ __device__ __forceinline__ int perm32(int rho) { const int n = rho >> 4, i = rho & 15; return 8 * (i >> 2) + 4 * n + (i & 3); }

struct Unit { int pm, pn; };
struct Gemm { const bf16_t* A; const bf16_t* Bt; int M, N, K; };

struct StaticOrder {
    int nM, nN, nwg, G, c;
    __host__ __device__ void init(int M, int N, int G_, int c_) { nM = M / BM; nN = N / BM; nwg = nM * nN; G = G_; c = c_; }
    __host__ __device__ bool next(int i, Unit& u) const {
        const long L = (long)i * G + c; if (L >= nwg) return false;
        int wgid = (int)L; { const int q = nwg / NXCD, r = nwg % NXCD, xcd = wgid % NXCD, off = wgid / NXCD; wgid = (xcd < r ? xcd * (q + 1) : r * (q + 1) + (xcd - r) * q) + off; }
        const int nig = WGM * nN, gid = wgid / nig, fm = gid * WGM, gsz = (nM - fm) < WGM ? (nM - fm) : WGM;
        u.pm = fm + ((wgid % nig) % gsz); u.pn = (wgid % nig) / gsz; return true;
    }
    __device__ __forceinline__ void a_ready(const Unit&) const {}
    __device__ __forceinline__ void done(const Unit&) const {}
};

__device__ __forceinline__ unsigned cvt_pk_bf16(float lo, float hi) { unsigned r; asm volatile("v_cvt_pk_bf16_f32 %0, %1, %2" : "=v"(r) : "v"(lo), "v"(hi)); return r; }
typedef float f32x2 __attribute__((ext_vector_type(2)));
__device__ __forceinline__ f32x2 gelu_pk(f32x2 v) {
    const f32x2 av = __builtin_elementwise_abs(v), d = av * 0.2316418882f + 1.0f;
    f32x2 t; t.x = __builtin_amdgcn_rcpf(d.x); t.y = __builtin_amdgcn_rcpf(d.y);
    f32x2 q = t * 0.5307027145f + (-0.7265760135f); q = q * t + 0.7107068705f; q = q * t + (-0.142248368f); q = q * t + 0.127414796f; q = q * t;
    const f32x2 s = (v * v) * (-0.72134752044f);
    f32x2 e; e.x = __builtin_amdgcn_exp2f(s.x); e.y = __builtin_amdgcn_exp2f(s.y);
    const f32x2 m = v * (q * e), r = v - m;
    f32x2 o; o.x = v.x < 0.f ? m.x : r.x; o.y = v.y < 0.f ? m.y : r.y; return o;
}

template <int ACT  > struct EpiBf16 {
    static constexpr bool PERM = true, AFTER_DRAIN = false; static_assert(ACT == 0 || ACT == 1, "EpiBf16: ACT is 0 (none) or 1 (gelu_pk)");
    bf16_t* O; int ldc; const float* bias; int split_cols; size_t split_stride; float scale0;
    __device__ __forceinline__ void operator()(const f32x4 (&acc)[2][2][4][2], const Unit& u, int wr, int wc, int fr, int fq) const {
        const int row0 = u.pm * BM + wr * 64 + fr; int colt = u.pn * BM; bf16_t* base = O;
        float sc = 1.f; if (split_cols) { const int t = colt / split_cols; base += (size_t)t * split_stride; colt -= t * split_cols; if (t == 0) sc = scale0; }
        const int col0 = colt + wc * 32 + 8 * fq, bcol0 = u.pn * BM + wc * 32 + 8 * fq;
        f32x4 bv[2][2];
#pragma unroll
        for (int bj = 0; bj < 2; ++bj)
#pragma unroll
            for (int n = 0; n < 2; ++n) bv[bj][n] = bias ? *(const f32x4*)(bias + bcol0 + bj * HALF + 4 * n) : (f32x4){0.f, 0.f, 0.f, 0.f};
#pragma unroll
        for (int ai = 0; ai < 2; ++ai)
#pragma unroll
            for (int m = 0; m < 4; ++m) { bf16_t* rowp = base + (size_t)(row0 + ai * HALF + m * 16) * ldc + col0;
#pragma unroll
                for (int bj = 0; bj < 2; ++bj) { f32x4 v0 = acc[ai][bj][m][0] + bv[bj][0], v1 = acc[ai][bj][m][1] + bv[bj][1];
                    if (ACT == 1) { f32x2 a = gelu_pk((f32x2){v0[0], v0[1]}), b = gelu_pk((f32x2){v0[2], v0[3]}), c = gelu_pk((f32x2){v1[0], v1[1]}), d = gelu_pk((f32x2){v1[2], v1[3]});
                        v0 = (f32x4){a.x, a.y, b.x, b.y}; v1 = (f32x4){c.x, c.y, d.x, d.y}; }
                    v0 = v0 * sc; v1 = v1 * sc; u32x4 w; w.x = cvt_pk_bf16(v0[0], v0[1]); w.y = cvt_pk_bf16(v0[2], v0[3]); w.z = cvt_pk_bf16(v1[0], v1[1]); w.w = cvt_pk_bf16(v1[2], v1[3]);
                    *(u32x4*)(rowp + bj * HALF) = w; } }
    }
};
typedef float f32x2e __attribute__((ext_vector_type(2)));
struct EpiInProj {
    static constexpr bool PERM = true, AFTER_DRAIN = false;
    bf16_t* QKV; bf16_t* ZR; const float* rope;
    __device__ __forceinline__ void operator()(const f32x4 (&acc)[2][2][4][2], const Unit& u, int wr, int wc, int fr, int fq) const {
        const int row0 = u.pm * BM + wr * 64 + fr; const int colt = u.pn * BM;
        if (colt >= 768) {
#pragma unroll
            for (int ai = 0; ai < 2; ++ai)
#pragma unroll
                for (int m = 0; m < 4; ++m) { bf16_t* rowp = ZR + (size_t)(row0 + ai * HALF + m * 16) * 1792 + (colt - 768) + wc * 32 + 8 * fq;
#pragma unroll
                    for (int bj = 0; bj < 2; ++bj) { const f32x4 v0 = acc[ai][bj][m][0], v1 = acc[ai][bj][m][1];
                        u32x4 w; w.x = cvt_pk_bf16(v0[0], v0[1]); w.y = cvt_pk_bf16(v0[2], v0[3]); w.z = cvt_pk_bf16(v1[0], v1[1]); w.w = cvt_pk_bf16(v1[2], v1[3]);
                        *(u32x4*)(rowp + bj * HALF) = w; } }
            return;
        }
        const bool latent = u.pm < 128;
        const int axis = wc & 1;
        const float sgn = (fq < 2) ? -1.f : 1.f;
#pragma unroll
        for (int ai = 0; ai < 2; ++ai)
#pragma unroll
            for (int m = 0; m < 4; ++m) {
                const int row = row0 + ai * HALF + m * 16; const int t = row & 8191; const int pos = axis ? (t & 63) : (t >> 6);
                f32x4 cs[4];
                if (latent) {
#pragma unroll
                    for (int i = 0; i < 4; ++i) cs[i] = *(const f32x4*)(rope + (size_t)(pos * 16 + 8 * (fq & 1) + 2 * i) * 2);
                }
                bf16_t* rowp = QKV + (size_t)row * 768 + colt + wc * 32 + 8 * fq;
#pragma unroll
                for (int bj = 0; bj < 2; ++bj) {
                    const int colb = colt + bj * HALF;
                    const bool is_v = (colb == 640), is_q = (colb < 512);
                    f32x4 v0 = acc[ai][bj][m][0], v1 = acc[ai][bj][m][1];
                    if (latent && !is_v) {
                        f32x4 o0, o1;
#pragma unroll
                        for (int e = 0; e < 4; ++e) { o0[e] = __shfl_xor(v0[e], 32); o1[e] = __shfl_xor(v1[e], 32); }
                        v0[0] = v0[0] * cs[0][0] + sgn * o0[0] * cs[0][1]; v0[1] = v0[1] * cs[0][2] + sgn * o0[1] * cs[0][3];
                        v0[2] = v0[2] * cs[1][0] + sgn * o0[2] * cs[1][1]; v0[3] = v0[3] * cs[1][2] + sgn * o0[3] * cs[1][3];
                        v1[0] = v1[0] * cs[2][0] + sgn * o1[0] * cs[2][1]; v1[1] = v1[1] * cs[2][2] + sgn * o1[1] * cs[2][3];
                        v1[2] = v1[2] * cs[3][0] + sgn * o1[2] * cs[3][1]; v1[3] = v1[3] * cs[3][2] + sgn * o1[3] * cs[3][3];
                    }
                    if (is_q) { v0 = v0 * 0.18033688011112042f; v1 = v1 * 0.18033688011112042f; }
                    u32x4 w; w.x = cvt_pk_bf16(v0[0], v0[1]); w.y = cvt_pk_bf16(v0[2], v0[3]); w.z = cvt_pk_bf16(v1[0], v1[1]); w.w = cvt_pk_bf16(v1[2], v1[3]);
                    *(u32x4*)(rowp + bj * HALF) = w;
                }
            }
    }
};
template <bool FFTROWS, bool BIN, bool BOUT> struct EpiResidualT {
    static constexpr bool PERM = true, AFTER_DRAIN = false;
    const void* base; void* out; const float* gate; int gate_stride;
    __device__ __forceinline__ void operator()(const f32x4 (&acc)[2][2][4][2], const Unit& u, int wr, int wc, int fr, int fq) const {
        const int row0 = u.pm * BM + wr * 64 + fr; const int col0 = u.pn * BM + wc * 32 + 8 * fq;
        const float* gp = gate + (size_t)(u.pm >> 5) * gate_stride + col0;
        f32x4 gv[2][2];
#pragma unroll
        for (int bj = 0; bj < 2; ++bj)
#pragma unroll
            for (int n = 0; n < 2; ++n) gv[bj][n] = *(const f32x4*)(gp + bj * HALF + n * 4);
#pragma unroll
        for (int ai = 0; ai < 2; ++ai)
#pragma unroll
            for (int m = 0; m < 4; ++m) { int row = row0 + ai * HALF + m * 16;
                if (FFTROWS) row = (row & ~8191) | ((row >> 7) & 63) | ((row & 127) << 6);
                const size_t off = (size_t)row * 1024 + col0;
#pragma unroll
                for (int bj = 0; bj < 2; ++bj) {
                    f32x4 b0, b1;
                    if (BIN) { const u32x4 w = *(const u32x4*)((const bf16_t*)base + off + bj * HALF);
                        b0 = (f32x4){__builtin_bit_cast(float, w.x << 16), __builtin_bit_cast(float, w.x & 0xffff0000u), __builtin_bit_cast(float, w.y << 16), __builtin_bit_cast(float, w.y & 0xffff0000u)};
                        b1 = (f32x4){__builtin_bit_cast(float, w.z << 16), __builtin_bit_cast(float, w.z & 0xffff0000u), __builtin_bit_cast(float, w.w << 16), __builtin_bit_cast(float, w.w & 0xffff0000u)}; }
                    else { b0 = *(const f32x4*)((const float*)base + off + bj * HALF); b1 = *(const f32x4*)((const float*)base + off + bj * HALF + 4); }
                    const f32x4 o0 = b0 + gv[bj][0] * acc[ai][bj][m][0], o1 = b1 + gv[bj][1] * acc[ai][bj][m][1];
                    if (BOUT) { u32x4 w; w.x = cvt_pk_bf16(o0[0], o0[1]); w.y = cvt_pk_bf16(o0[2], o0[3]); w.z = cvt_pk_bf16(o1[0], o1[1]); w.w = cvt_pk_bf16(o1[2], o1[3]); *(u32x4*)((bf16_t*)out + off + bj * HALF) = w; }
                    else { *(f32x4*)((float*)out + off + bj * HALF) = o0; *(f32x4*)((float*)out + off + bj * HALF + 4) = o1; }
                } }
    }
};
template <int ACT, bool FFTROWS = false> struct EpiStore {
    static constexpr bool PERM = true, AFTER_DRAIN = false;
    bf16_t* O; int ldc;
    __device__ __forceinline__ void operator()(const f32x4 (&acc)[2][2][4][2], const Unit& u, int wr, int wc, int fr, int fq) const {
        const int row0 = u.pm * BM + wr * 64 + fr; const int col0 = u.pn * BM + wc * 32 + 8 * fq;
#pragma unroll
        for (int ai = 0; ai < 2; ++ai)
#pragma unroll
            for (int m = 0; m < 4; ++m) { int row = row0 + ai * HALF + m * 16;
                if (FFTROWS) { const int g = row & 3, l = (row >> 2) & 8191, b = row >> 15; row = (((b * 128 + (l & 127)) * 4 + g) << 6) | (l >> 7); }
                bf16_t* rowp = O + (size_t)row * ldc + col0;
#pragma unroll
                for (int bj = 0; bj < 2; ++bj) { f32x4 v0 = acc[ai][bj][m][0], v1 = acc[ai][bj][m][1];
                    if (ACT == 2) {
#pragma unroll
                        for (int e = 0; e < 4; ++e) { const float a = fmaxf(v0[e], 0.f), b = fmaxf(v1[e], 0.f); v0[e] = a * a; v1[e] = b * b; }
                    }
                    u32x4 w; w.x = cvt_pk_bf16(v0[0], v0[1]); w.y = cvt_pk_bf16(v0[2], v0[3]); w.z = cvt_pk_bf16(v1[0], v1[1]); w.w = cvt_pk_bf16(v1[2], v1[3]);
                    *(u32x4*)(rowp + bj * HALF) = w; } }
    }
};
template <class Epi, class Sched, bool ALIGN_EPI = false, bool SP2 = false>
__device__ __forceinline__ void gemm_phase(PG8_LAS unsigned char* lds, const Gemm g, const Sched& S, const Epi& E) {
    const int tid = threadIdx.x, wid = __builtin_amdgcn_readfirstlane(tid >> 6), lane = tid & 63, wr = wid >> 2, wc = wid & 3, fr = lane & 15, fq = lane >> 4;
    int K_ = g.K; asm volatile("" : "+s"(K_)); const int K = K_, nt = K / BK;
    unsigned voffA[2], voffB[2];
#pragma unroll
    for (int i = 0; i < 2; ++i) { int R, C; stage_rc(tid * 16 + i * 8192, R, C); const int Rb = Epi::PERM ? ((R & ~31) + perm32(R & 31)) : R;
        voffA[i] = (unsigned)(R * K + C) * 2u; voffB[i] = (unsigned)(Rb * K + C) * 2u; }
    const size_t kstep = (size_t)(BK * 2);
    const size_t hstep = (size_t)HALF * K * 2;
    const size_t tstep = 2 * hstep;
    const unsigned ldsw = (unsigned)wid * 1024u;
    const int aoff = lds_byte(wr * 64 + fr, fq * 8), boff = lds_byte(wc * 32 + fr, fq * 8);
#define PG8_SA(b, h) (((b) * 2 + (h)) * HTB)
#define PG8_SB(b, h) ((4 + (b) * 2 + (h)) * HTB)
#define PG8_STAGE(bufoff, gbase, voff) do { _Pragma("unroll") for (int _i = 0; _i < 2; ++_i) \
        __builtin_amdgcn_global_load_lds((const unsigned*)((const char*)(gbase) + (voff)[_i]), (PG8_LAS unsigned*)(lds + (bufoff) + ldsw + _i * 8192), 16, 0, 0); } while (0)
#define PG8_LDA(dst, b, h) do { _Pragma("unroll") for (int m = 0; m < 4; ++m) _Pragma("unroll") for (int k = 0; k < 2; ++k) dst[m][k] = *(const PG8_LAS bf16x8*)(lds + PG8_SA(b, h) + aoff + m * 2048 + k * 1024); } while (0)
#define PG8_LDB(dst, b, h) do { _Pragma("unroll") for (int n = 0; n < 2; ++n) _Pragma("unroll") for (int k = 0; k < 2; ++k) dst[n][k] = *(const PG8_LAS bf16x8*)(lds + PG8_SB(b, h) + boff + n * 2048 + k * 1024); } while (0)
#define PG8_MMA(ai, bj, At, Bt) do { __builtin_amdgcn_s_setprio(1); _Pragma("unroll") for (int m = 0; m < 4; ++m) _Pragma("unroll") for (int n = 0; n < 2; ++n) _Pragma("unroll") for (int k = 0; k < 2; ++k) \
        acc[ai][bj][m][n] = __builtin_amdgcn_mfma_f32_16x16x32_bf16(Bt[n][k], At[m][k], acc[ai][bj][m][n], 0, 0, 0); __builtin_amdgcn_s_setprio(0); } while (0)
#define PG8_WAIT_V(n) asm volatile("s_waitcnt vmcnt(" #n ")" ::: "memory")
#define PG8_WAIT_L(n) asm volatile("s_waitcnt lgkmcnt(" #n ")" ::: "memory")
#define PG8_BAR __builtin_amdgcn_s_barrier()
#define PG8_SCHED __builtin_amdgcn_sched_barrier(0)
    Unit cur, nxt; int ui = 0;
    if (!S.next(0, cur)) return;
    f32x4 acc[2][2][4][2];
#pragma unroll
    for (int a = 0; a < 2; ++a)
#pragma unroll
        for (int b = 0; b < 2; ++b)
#pragma unroll
            for (int m = 0; m < 4; ++m)
#pragma unroll
                for (int n = 0; n < 2; ++n) acc[a][b][m][n] = (f32x4){0.f, 0.f, 0.f, 0.f};
    bf16x8 At[4][2], B0[2][2], B1[2][2];
    const char* cA = (const char*)g.A + (size_t)cur.pm * tstep; const char* cB = (const char*)g.Bt + (size_t)cur.pn * tstep;
    S.a_ready(cur);
    if constexpr (SP2) {
        PG8_STAGE(PG8_SB(0, 0), cB, voffB); PG8_STAGE(PG8_SB(0, 1), cB + hstep, voffB); PG8_STAGE(PG8_SA(0, 0), cA, voffA); PG8_STAGE(PG8_SA(0, 1), cA + hstep, voffA);
        if (wr == 1) PG8_BAR;
        PG8_WAIT_V(2); PG8_BAR;
        PG8_STAGE(PG8_SB(1, 0), cB + kstep, voffB); PG8_STAGE(PG8_SA(1, 0), cA + kstep, voffA); PG8_STAGE(PG8_SB(1, 1), cB + hstep + kstep, voffB);
        PG8_WAIT_V(6); PG8_BAR;
    } else {
        PG8_STAGE(PG8_SB(0, 0), cB, voffB); PG8_STAGE(PG8_SA(0, 0), cA, voffA); PG8_STAGE(PG8_SB(0, 1), cB + hstep, voffB); PG8_STAGE(PG8_SA(0, 1), cA + hstep, voffA);
        if (wr == 1) PG8_BAR;
        PG8_WAIT_V(4); PG8_BAR;
        PG8_STAGE(PG8_SB(1, 0), cB + kstep, voffB); PG8_STAGE(PG8_SA(1, 0), cA + kstep, voffA); PG8_STAGE(PG8_SB(1, 1), cB + hstep + kstep, voffB);
        PG8_WAIT_V(6); PG8_BAR;
    }
    for (;;) {
        const bool has_next = S.next(ui + 1, nxt);
        const char* nA = has_next ? (const char*)g.A + (size_t)nxt.pm * tstep : cA; const char* nB = has_next ? (const char*)g.Bt + (size_t)nxt.pn * tstep : cB;
        for (int t = 0; t < nt; t += 2) {
            const bool last = (t == nt - 2);
            const char* a1 = cA + (size_t)(t + 1) * kstep;
            const char* a2 = last ? nA : cA + (size_t)(t + 2) * kstep; const char* b2 = last ? nB : cB + (size_t)(t + 2) * kstep;
            const char* a3 = a2 + kstep; const char* b3 = b2 + kstep;
            if (last && has_next) S.a_ready(nxt);
            if constexpr (SP2) {
            PG8_LDB(B0, 0, 0); PG8_LDB(B1, 0, 1); PG8_SCHED; PG8_LDA(At, 0, 0); PG8_STAGE(PG8_SA(1, 1), a1 + hstep, voffA);
            PG8_WAIT_V(8); PG8_WAIT_L(0); PG8_BAR; PG8_MMA(0, 0, At, B0); PG8_MMA(0, 1, At, B1); PG8_BAR; PG8_SCHED;
            PG8_LDA(At, 0, 1); PG8_STAGE(PG8_SB(0, 0), b2, voffB); PG8_STAGE(PG8_SB(0, 1), b2 + hstep, voffB); PG8_STAGE(PG8_SA(0, 0), a2, voffA);
            PG8_WAIT_V(8); PG8_WAIT_L(0); PG8_BAR; PG8_MMA(1, 0, At, B0); PG8_MMA(1, 1, At, B1); PG8_BAR; PG8_SCHED;
            PG8_LDB(B0, 1, 0); PG8_LDB(B1, 1, 1); PG8_SCHED; PG8_LDA(At, 1, 0); PG8_STAGE(PG8_SA(0, 1), a2 + hstep, voffA);
            PG8_WAIT_V(8); PG8_WAIT_L(0); PG8_BAR; PG8_MMA(0, 0, At, B0); PG8_MMA(0, 1, At, B1); PG8_BAR; PG8_SCHED;
            PG8_LDA(At, 1, 1); PG8_STAGE(PG8_SB(1, 0), b3, voffB); PG8_STAGE(PG8_SB(1, 1), b3 + hstep, voffB); PG8_STAGE(PG8_SA(1, 0), a3, voffA);
            PG8_WAIT_V(8); PG8_WAIT_L(0); PG8_BAR; PG8_MMA(1, 0, At, B0); PG8_MMA(1, 1, At, B1); PG8_BAR; PG8_SCHED;
            } else {
            PG8_LDB(B0, 0, 0); PG8_SCHED; PG8_LDA(At, 0, 0); PG8_STAGE(PG8_SA(1, 1), a1 + hstep, voffA);
            PG8_WAIT_L(8); PG8_BAR; PG8_WAIT_L(0); PG8_MMA(0, 0, At, B0); PG8_BAR; PG8_SCHED;
            PG8_LDB(B1, 0, 1); PG8_STAGE(PG8_SB(0, 0), b2, voffB);
            PG8_BAR; PG8_WAIT_L(0); PG8_MMA(0, 1, At, B1); PG8_BAR;
            PG8_LDA(At, 0, 1); PG8_STAGE(PG8_SA(0, 0), a2, voffA);
            PG8_BAR; PG8_WAIT_L(0); PG8_MMA(1, 0, At, B0); PG8_BAR; PG8_SCHED;
            PG8_STAGE(PG8_SB(0, 1), b2 + hstep, voffB);
            PG8_WAIT_V(6); PG8_BAR; PG8_MMA(1, 1, At, B1); PG8_BAR;
            PG8_LDB(B0, 1, 0); PG8_SCHED; PG8_LDA(At, 1, 0); PG8_STAGE(PG8_SA(0, 1), a2 + hstep, voffA);
            PG8_WAIT_L(8); PG8_BAR; PG8_WAIT_L(0); PG8_MMA(0, 0, At, B0); PG8_BAR; PG8_SCHED;
            PG8_LDB(B1, 1, 1); PG8_STAGE(PG8_SB(1, 0), b3, voffB);
            PG8_BAR; PG8_WAIT_L(0); PG8_MMA(0, 1, At, B1); PG8_BAR;
            PG8_LDA(At, 1, 1); PG8_STAGE(PG8_SA(1, 0), a3, voffA);
            PG8_BAR; PG8_WAIT_L(0); PG8_MMA(1, 0, At, B0); PG8_BAR; PG8_SCHED;
            PG8_STAGE(PG8_SB(1, 1), b3 + hstep, voffB);
            PG8_WAIT_V(6); PG8_BAR; PG8_MMA(1, 1, At, B1); PG8_BAR;
            }
        }
        if constexpr (ALIGN_EPI) { if (wr == 0) PG8_BAR; }
        if constexpr (!Epi::AFTER_DRAIN) { E(acc, cur, wr, wc, fr, fq); S.done(cur); }
        if (!has_next) break;
#pragma unroll
        for (int a = 0; a < 2; ++a)
#pragma unroll
            for (int b = 0; b < 2; ++b)
#pragma unroll
                for (int m = 0; m < 4; ++m)
#pragma unroll
                    for (int n = 0; n < 2; ++n) acc[a][b][m][n] = (f32x4){0.f, 0.f, 0.f, 0.f};
        cur = nxt; cA = nA; cB = nB; ++ui;
        if constexpr (ALIGN_EPI) { if (wr == 1) PG8_BAR; }
    }
    PG8_WAIT_V(0);
    if constexpr (!ALIGN_EPI) { if (wr == 0) PG8_BAR; }
    PG8_BAR;
    if constexpr (Epi::AFTER_DRAIN) { E.fused(acc, cur, wr, wc, fr, fq, lds, wid, lane); S.done(cur); }
#undef PG8_SA
#undef PG8_SB
#undef PG8_STAGE
#undef PG8_LDA
#undef PG8_LDB
#undef PG8_MMA
#undef PG8_WAIT_V
#undef PG8_WAIT_L
#undef PG8_BAR
#undef PG8_SCHED
}
}
constexpr int NWAVES = 8;
constexpr int BATCH = 4, SEQ = 8192, DM = 1024, CTXL = 256, FF = 4096;
constexpr int ML = BATCH * SEQ;
constexpr int MC = BATCH * CTXL;
constexpr int MALL = ML + MC;
constexpr int INCOLS = 2560, RWC = 1792;
constexpr float NORM_EPS = 1e-6f, GN_EPS = 64e-5f;
#ifndef MK_N_LAUNCHES
#define MK_N_LAUNCHES 1
#endif
constexpr int N_PHASES = 19;

constexpr size_t MiB = 1u << 20;
constexpr size_t WS_MOD = 0;
constexpr size_t WS_ROPE = 256 * 1024;
constexpr size_t WS_TW = 320 * 1024;
constexpr size_t WS_DFTC = 384 * 1024;
constexpr size_t WS_W2A = 640 * 1024;
constexpr size_t WS_W2B = 704 * 1024;
constexpr size_t WS_LW2 = 768 * 1024;
constexpr size_t WS_LA2 = 896 * 1024;
constexpr size_t WS_LG2 = 1024 * 1024;
constexpr size_t WS_ZERO = 1152 * 1024;
constexpr size_t WS_INVN = 1280 * 1024;
constexpr size_t WS_BAR = 2400 * 1024;
constexpr size_t WS_WIN = 3 * MiB, WS_WOUT = 8 * MiB, WS_WF = 10 * MiB, WS_W1 = 12 * MiB  , WS_W2 = 28 * MiB  ;
constexpr size_t WS_XN = 44 * MiB;
constexpr size_t WS_QT = 44 * MiB;
constexpr size_t WS_QKV = 110 * MiB;
constexpr size_t WS_ZR = 160 * MiB;
constexpr size_t WS_MT = 160 * MiB;
constexpr size_t WS_NN = 226 * MiB;
constexpr size_t WS_LIN = 292 * MiB;
constexpr size_t WS_SS = 301 * MiB;
constexpr size_t WS_ZS = 340 * MiB;
constexpr size_t WS_ATTRW = 439 * MiB;
constexpr size_t WS_XR = 108 * MiB;
constexpr size_t WS_H = 172 * MiB;
constexpr size_t WS_G1 = 160 * MiB;
constexpr size_t WS_Y1 = 288 * MiB;
constexpr size_t WS_F1 = 416 * MiB;
constexpr size_t WS_END = 512 * MiB;
constexpr size_t DO_Y = 0, DO_G = 64 * MiB, DO_SS = 96 * MiB;

constexpr int RING_BYTES = 131072;
constexpr int LDS_BYTES = 151552;
constexpr int MISC_OFF = 150528;

#define GAS __attribute__((address_space(1)))
#define LAS __attribute__((address_space(3)))
typedef unsigned short bf16;
typedef unsigned v4u __attribute__((ext_vector_type(4)));
typedef unsigned v2u __attribute__((ext_vector_type(2)));
typedef float f32x4 __attribute__((ext_vector_type(4)));
typedef float f32x16 __attribute__((ext_vector_type(16)));
typedef short bf16x8 __attribute__((ext_vector_type(8)));
typedef short s16x4 __attribute__((ext_vector_type(4)));
#define LDS_WAIT() asm volatile("s_waitcnt lgkmcnt(0)" ::: "memory")
__device__ __forceinline__ unsigned f2bf(float f) { unsigned u = __builtin_bit_cast(unsigned, f); return (u + 0x7fffu + ((u >> 16) & 1u)) >> 16; }
__device__ __forceinline__ unsigned pk2(float lo, float hi) { return f2bf(lo) | (f2bf(hi) << 16); }
__device__ __forceinline__ float bf_lo(unsigned u) { return __builtin_bit_cast(float, u << 16); }
__device__ __forceinline__ float bf_hi(unsigned u) { return __builtin_bit_cast(float, u & 0xffff0000u); }
__device__ __forceinline__ float bf1(bf16 u) { return __builtin_bit_cast(float, (unsigned)u << 16); }
__device__ __forceinline__ float wave_sum(float v) {
#pragma unroll
    for (int o = 1; o < 64; o <<= 1) v += __shfl_xor(v, o);
    return v;
}
template <int CTRL> __device__ __forceinline__ float dppf(float x) { return __builtin_bit_cast(float, __builtin_amdgcn_mov_dpp(__builtin_bit_cast(int, x), CTRL, 0xf, 0xf, true)); }
__device__ __forceinline__ float sum8(float x) { x += dppf<0xB1>(x); x += dppf<0x4E>(x); x += dppf<0x141>(x); return x; }
__device__ __forceinline__ float sigmoidf_(float x) { return 1.f / (1.f + __expf(-x)); }

typedef GAS unsigned gu32;
typedef GAS unsigned long long gu64;
#define RLX_AGENT __ATOMIC_RELAXED, __HIP_MEMORY_SCOPE_AGENT
#define XB_TMO      128
#define XB_XCNT(j)  (256  + 64 * (j))
#define XB_XSUB(j)  (1280 + 64 * (j))
#define XB_XGEN(j)  (2304 + 64 * (j))
#define XB_TOP      3328
#define XB_TOPGEN   3392
#define XCD_BAR_WORDS 3456
#define XB_SPIN_CAP (1u << 18)

__device__ __forceinline__ unsigned xb_ld(unsigned* p)              { return __hip_atomic_load(p, __ATOMIC_RELAXED, __HIP_MEMORY_SCOPE_AGENT); }
__device__ __forceinline__ unsigned xb_add(unsigned* p, unsigned v) { return __hip_atomic_fetch_add(p, v, __ATOMIC_RELAXED, __HIP_MEMORY_SCOPE_AGENT); }
__device__ __forceinline__ unsigned xb_xcc_id() { return (unsigned)__builtin_amdgcn_s_getreg((3 << 11) | 20) & 0xFu; }
#define XB_SPIN(cond, bar) do { unsigned _sp = 0; while (cond) { __builtin_amdgcn_s_sleep(1); \
    if ((++_sp & 255u) == 0u) { if (xb_ld(&(bar)[XB_TMO])) break; if (_sp > XB_SPIN_CAP) { atomicAdd(&(bar)[XB_TMO], 1u); break; } } } } while (0)

struct XcdBarrier {
    unsigned* bar; unsigned x;
    volatile LAS unsigned* st;
};

__device__ __forceinline__ XcdBarrier xcd_barrier_post(unsigned* bar, volatile LAS unsigned* st) {
    XcdBarrier b; b.bar = bar; b.x = xb_xcc_id(); b.st = st;
    if (threadIdx.x == 0) (void)xb_add(&bar[XB_XCNT(b.x)], 1u);
    return b;
}
__device__ __forceinline__ void xcd_barrier_complete(unsigned* bar, unsigned x, unsigned& nloc, unsigned& nx) {
    const unsigned G = gridDim.x * gridDim.y * gridDim.z;
    unsigned sum, cnt, mine, sp = 0u;
    for (;;) {
        sum = 0u; cnt = 0u; mine = 0u;
#pragma unroll
        for (unsigned j = 0; j < 16; ++j) { const unsigned c = xb_ld(&bar[XB_XCNT(j)]); sum += c; cnt += (c > 0u) ? 1u : 0u; mine = (j == x) ? c : mine; }
        if (sum == G) break;
        __builtin_amdgcn_s_sleep(1);
        if ((++sp & 255u) == 0u) { if (xb_ld(&bar[XB_TMO])) break; if (sp > XB_SPIN_CAP) { atomicAdd(&bar[XB_TMO], 1u); break; } }
    }
    nloc = mine > 0u ? mine : 1u; nx = cnt > 0u ? cnt : 1u;
}

__device__ __forceinline__ void xcd_barrier(const XcdBarrier& b) {
    asm volatile("s_waitcnt vmcnt(0)" ::: "memory");
    __syncthreads();
    if (threadIdx.x == 0) {
        unsigned* bar = b.bar;
        __builtin_amdgcn_s_waitcnt(0);
        unsigned nloc = b.st[0], nx = b.st[1];
        if (nloc == 0u) { xcd_barrier_complete(bar, b.x, nloc, nx); b.st[0] = nloc; b.st[1] = nx; }
        const unsigned old = xb_add(&bar[XB_XSUB(b.x)], 1u);
        const unsigned gen = old / nloc;
        if (old + 1u == (gen + 1u) * nloc) {
            __builtin_amdgcn_fence(__ATOMIC_RELEASE, "agent");
            asm volatile("s_waitcnt vmcnt(0)" ::: "memory");
            const unsigned og = xb_add(&bar[XB_TOP], 1u);
            const unsigned tg = og / nx;
            if (og + 1u == (tg + 1u) * nx) xb_add(&bar[XB_TOPGEN], 1u);
            else XB_SPIN(xb_ld(&bar[XB_TOPGEN]) == tg, bar);
            __builtin_amdgcn_fence(__ATOMIC_ACQUIRE, "agent");
            xb_add(&bar[XB_XGEN(b.x)], 1u);
            asm volatile("s_waitcnt vmcnt(0)" ::: "memory");
        } else {
            XB_SPIN(xb_ld(&bar[XB_XGEN(b.x)]) == gen, bar);
            __builtin_amdgcn_fence(__ATOMIC_ACQUIRE, "agent");
            asm volatile("s_waitcnt vmcnt(0)" ::: "memory");
        }
    }
    __syncthreads();
}

struct Frame {
    LAS unsigned char* lds;
    int tid, lane, wave, vcu, G;
    unsigned char* ws; float* out;
};
struct Args { const float* in[27]; float* out; unsigned char* ws; int ph_lo, ph_hi; };
enum { I_X = 0, I_C, I_CTX, I_CCTX, I_ADAW, I_ADAB, I_N1G, I_N2G, I_WIN, I_WOUT, I_SINK, I_MUP, I_MUN, I_DW0, I_DW2, I_IA0, I_IA2, I_GG2, I_KK, I_KA, I_RK, I_LNG, I_LNB, I_FW, I_W1, I_W2, I_FING };

__device__ __forceinline__ void p0_transpose_item(const float* W, int K, int N, bf16* WT, LAS float* scr, int item, int lane, float scale) {
    const int nblk = N / 32, kb = item / nblk, nb = item % nblk, k0 = 64 * kb, n0 = 32 * nb;
#pragma unroll 8
    for (int i = 0; i < 32; ++i) { const int kk = 2 * i + (lane >> 5); scr[kk * 33 + (lane & 31)] = W[(size_t)(k0 + kk) * N + n0 + (lane & 31)] * scale; }
    LDS_WAIT(); asm volatile("" ::: "memory");
    const int c = lane & 7;
#pragma unroll
    for (int j = 0; j < 4; ++j) { const int n = (lane >> 3) + 8 * j; const LAS float* s = scr + (8 * c) * 33 + n;
        v4u o; o.x = pk2(s[0 * 33], s[1 * 33]); o.y = pk2(s[2 * 33], s[3 * 33]); o.z = pk2(s[4 * 33], s[5 * 33]); o.w = pk2(s[6 * 33], s[7 * 33]);
        *(GAS v4u*)(WT + (size_t)(n0 + n) * K + k0 + 8 * c) = o; }
    LDS_WAIT(); asm volatile("" ::: "memory");
}
__device__ __forceinline__ void p0_prologue(Frame& F, const Args& A_) {
    LAS float* scr = (LAS float*)(F.lds + F.wave * 16384);
    const int gw = F.vcu * NWAVES + F.wave, NGW = F.G * NWAVES;
    constexpr int I_IN = 16 * 80, I_O = 16 * 32, I_U = 16 * 128, I_D = 64 * 32;
    constexpr int I_LW = 2 * 16, I_LG = 2 * 16;
    constexpr int NITEMS = I_IN + 2 * I_O + 2 * I_U + 2 * I_D + 2 * I_LW + I_LG;
    for (int it = gw; it < NITEMS; it += NGW) {
        int r = it;
        if (r < I_IN) { p0_transpose_item(A_.in[I_WIN], 1024, INCOLS, (bf16*)(F.ws + WS_WIN), scr, r, F.lane, 1.f); continue; } r -= I_IN;
        if (r < I_O) { p0_transpose_item(A_.in[I_WOUT], 1024, 1024, (bf16*)(F.ws + WS_WOUT), scr, r, F.lane, 1.f); continue; } r -= I_O;
        if (r < I_O) { p0_transpose_item(A_.in[I_FW], 1024, 1024, (bf16*)(F.ws + WS_WF), scr, r, F.lane, 1.f); continue; } r -= I_O;
        if (r < 2 * I_U) { const int l = r / I_U; p0_transpose_item(A_.in[I_W1] + (size_t)l * 1024 * FF, 1024, FF, (bf16*)(F.ws + WS_W1) + (size_t)l * 1024 * FF, scr, r % I_U, F.lane, 1.f); continue; } r -= 2 * I_U;
        if (r < 2 * I_D) { const int l = r / I_D; p0_transpose_item(A_.in[I_W2] + (size_t)l * 1024 * FF, FF, 1024, (bf16*)(F.ws + WS_W2) + (size_t)l * 1024 * FF, scr, r % I_D, F.lane, 1.f); continue; } r -= 2 * I_D;
        if (r < I_LW) { const int d = r / 16; p0_transpose_item(A_.in[I_DW2] + (size_t)d * 64 * 512, 64, 512, (bf16*)(F.ws + WS_LW2) + (size_t)d * 512 * 64, scr, r % 16, F.lane, 1.f); continue; } r -= I_LW;
        if (r < I_LW) { const int d = r / 16; p0_transpose_item(A_.in[I_IA2] + (size_t)d * 64 * 512, 64, 512, (bf16*)(F.ws + WS_LA2) + (size_t)d * 512 * 64, scr, r % 16, F.lane, 1.f); continue; } r -= I_LW;
        p0_transpose_item(A_.in[I_GG2], 128, 512, (bf16*)(F.ws + WS_LG2), scr, r, F.lane, 1.f);
    }
    const int gt = F.vcu * 512 + F.tid, NGT = F.G * 512;
    const float TWO_PI = 6.283185307179586f;
    for (int i = gt; i < 128 * 16; i += NGT) {
        const int pos = i >> 4, j = i & 15; const float inv = exp2f(-(float)j * (13.287712379549449f / 16.f));
        const float ang = (float)pos * inv; const float rev = ang * 0.15915494309189535f;
        float* o = (float*)(F.ws + WS_ROPE) + 2 * i; o[0] = __builtin_amdgcn_cosf(rev - floorf(rev)); o[1] = __builtin_amdgcn_sinf(rev - floorf(rev));
    }
    for (int i = gt; i < 8192; i += NGT) { const float rev = (float)i * (1.f / 8192.f); float* o = (float*)(F.ws + WS_TW) + 2 * i; o[0] = __builtin_amdgcn_cosf(rev); o[1] = __builtin_amdgcn_sinf(rev); }
    for (int i = gt; i < 512 * 256; i += NGT) {
        const int j = i >> 8, c = i & 255; const int ph = (c * (j & 255)) & 255; const float rev = (float)ph * (1.f / 256.f);
        const float v = (j < 256) ? __builtin_amdgcn_cosf(rev) : -__builtin_amdgcn_sinf(rev);
        ((bf16*)(F.ws + WS_DFTC))[i] = (bf16)f2bf(v * 0.0625f);
    }
    for (int i = gt; i < 128 * 128; i += NGT) {
        const int o = i >> 7, k = i & 127; const int pp = o >> 6, l1p = o & 63, p = k >> 6, l1 = k & 63; const float rev = (float)((l1 * l1p) & 63) * (1.f / 64.f);
        const float cs = __builtin_amdgcn_cosf(rev), sn = __builtin_amdgcn_sinf(rev);
        const float v = (pp == 0) ? (p == 0 ? cs : sn) : (p == 0 ? -sn : cs);
        ((bf16*)(F.ws + WS_W2A))[i] = (bf16)f2bf(v * 0.125f);
    }
    for (int i = gt; i < 128 * 256; i += NGT) {
        const int o = i >> 8, k = i & 255; const int p = k >> 7, l2 = k & 127; const float rev = (float)((l2 * o) & 127) * (1.f / 128.f);
        const float v = (p == 0) ? __builtin_amdgcn_cosf(rev) : __builtin_amdgcn_sinf(rev);
        ((bf16*)(F.ws + WS_W2B))[i] = (bf16)f2bf(v * 0.08838834764831845f);
    }
    for (int i = gt; i < 1024; i += NGT) ((float*)(F.ws + WS_ZERO))[i] = 0.f;
    {
        LAS float* sl = (LAS float*)(F.lds + 0);
        __syncthreads();
        for (int i = F.tid; i < 5 * 1024; i += 512) { const int r = i >> 10, k = i & 1023; const float cv = (r < 4) ? A_.in[I_C][r * 1024 + k] : A_.in[I_CCTX][k]; sl[i] = cv * sigmoidf_(cv); }
        __syncthreads();
        LAS float* red = (LAS float*)(F.lds + 32768);
        for (int item = F.vcu; item < 2 * 96; item += F.G) {
            const int layer = item / 96, n0 = (item % 96) * 64;
            const float* W = A_.in[I_ADAW] + (size_t)layer * 1024 * 6144 + n0 + F.lane;
            float a0 = 0.f, a1 = 0.f, a2 = 0.f, a3 = 0.f, a4 = 0.f;
            const int k0 = F.wave * 128;
#pragma unroll 8
            for (int k = k0; k < k0 + 128; ++k) { const float w = W[(size_t)k * 6144]; a0 += sl[k] * w; a1 += sl[1024 + k] * w; a2 += sl[2048 + k] * w; a3 += sl[3072 + k] * w; a4 += sl[4096 + k] * w; }
            red[(F.wave * 5 + 0) * 64 + F.lane] = a0; red[(F.wave * 5 + 1) * 64 + F.lane] = a1; red[(F.wave * 5 + 2) * 64 + F.lane] = a2; red[(F.wave * 5 + 3) * 64 + F.lane] = a3; red[(F.wave * 5 + 4) * 64 + F.lane] = a4;
            __syncthreads();
            if (F.tid < 320) { const int r = F.tid >> 6, l = F.tid & 63; float s = 0.f;
#pragma unroll
                for (int w = 0; w < 8; ++w) s += red[(w * 5 + r) * 64 + l];
                ((float*)(F.ws + WS_MOD))[(size_t)(layer * 5 + r) * 6144 + n0 + l] = s + A_.in[I_ADAB][layer * 6144 + n0 + l]; }
            __syncthreads();
        }
    }
}

__device__ __forceinline__ void norm_phase(Frame& F, const float* xl, const float* xc, int nrows, const float* g, const float* modl  , int sh_off, bf16* dst) {
    const int gw = F.vcu * NWAVES + F.wave, NGW = F.G * NWAVES;
    f32x4 gg[4];
#pragma unroll
    for (int j = 0; j < 4; ++j) gg[j] = *(const f32x4*)(g + 4 * F.lane + 256 * j);
    for (int m0 = gw; m0 < nrows; m0 += 2 * NGW) {
        const int m1 = m0 + NGW; const bool two = m1 < nrows; const int m1c = two ? m1 : m0;
        const float* xrow0 = (m0 < ML) ? xl + (size_t)m0 * DM : xc + (size_t)(m0 - ML) * DM;
        const float* xrow1 = (m1c < ML) ? xl + (size_t)m1c * DM : xc + (size_t)(m1c - ML) * DM;
        const GAS f32x4* xr0 = (const GAS f32x4*)xrow0 + F.lane; const GAS f32x4* xr1 = (const GAS f32x4*)xrow1 + F.lane;
        f32x4 v0[4], v1[4]; float s0 = 0.f, s1 = 0.f;
#pragma unroll
        for (int j = 0; j < 4; ++j) { v0[j] = xr0[64 * j]; v1[j] = xr1[64 * j]; }
#pragma unroll
        for (int j = 0; j < 4; ++j) { s0 += (v0[j].x * v0[j].x + v0[j].y * v0[j].y) + (v0[j].z * v0[j].z + v0[j].w * v0[j].w); s1 += (v1[j].x * v1[j].x + v1[j].y * v1[j].y) + (v1[j].z * v1[j].z + v1[j].w * v1[j].w); }
        const float rstd0 = 1.f / sqrtf(wave_sum(s0) * (1.f / DM) + NORM_EPS), rstd1 = 1.f / sqrtf(wave_sum(s1) * (1.f / DM) + NORM_EPS);
#pragma unroll
        for (int rr = 0; rr < 2; ++rr) {
            if (rr == 1 && !two) break;
            const int m = rr ? m1 : m0; const int r = (m < ML) ? (m >> 13) : 4; const float rstd = rr ? rstd1 : rstd0;
            const float* sh = modl + (size_t)r * 6144 + sh_off; const float* sc = sh + 1024;
            GAS unsigned long long* o8 = (GAS unsigned long long*)(dst + (size_t)m * DM) + F.lane;
#pragma unroll
            for (int j = 0; j < 4; ++j) { const int c = 4 * F.lane + 256 * j;
                const f32x4 a = *(const f32x4*)(sc + c), b = *(const f32x4*)(sh + c);
                const f32x4 o = ((rr ? v1[j] : v0[j]) * rstd * gg[j]) * (a + 1.f) + b;
                o8[64 * j] = (unsigned long long)pk2(o.x, o.y) | ((unsigned long long)pk2(o.z, o.w) << 32); }
        }
    }
}
__device__ __forceinline__ void norm_bf16_phase(Frame& F, const bf16* xr, const float* g, const float* modl, int sh_off, bf16* dst) {
    const int gw = F.vcu * NWAVES + F.wave, NGW = F.G * NWAVES; const int c0 = 16 * F.lane;
    f32x4 gg[4];
#pragma unroll
    for (int j = 0; j < 4; ++j) gg[j] = *(const f32x4*)(g + c0 + 4 * j);
    for (int m0 = gw; m0 < ML; m0 += 2 * NGW) {
        const int m1 = (m0 + NGW < ML) ? m0 + NGW : m0;
        v4u a0 = *(const v4u*)(xr + (size_t)m0 * DM + c0), a1 = *(const v4u*)(xr + (size_t)m0 * DM + c0 + 8), b0 = *(const v4u*)(xr + (size_t)m1 * DM + c0), b1 = *(const v4u*)(xr + (size_t)m1 * DM + c0 + 8);
#pragma unroll
        for (int rr = 0; rr < 2; ++rr) {
            if (rr == 1 && m1 == m0) break;
            const int m = rr ? m1 : m0; const v4u q0 = rr ? b0 : a0, q1 = rr ? b1 : a1;
            float v[16];
#pragma unroll
            for (int e = 0; e < 4; ++e) { v[2 * e] = bf_lo(q0[e]); v[2 * e + 1] = bf_hi(q0[e]); v[8 + 2 * e] = bf_lo(q1[e]); v[8 + 2 * e + 1] = bf_hi(q1[e]); }
            float s = 0.f;
#pragma unroll
            for (int e = 0; e < 16; ++e) s += v[e] * v[e];
            const float rstd = 1.f / sqrtf(wave_sum(s) * (1.f / DM) + NORM_EPS);
            const float* sh = modl + (size_t)(m >> 13) * 6144 + sh_off + c0; const float* sc = sh + 1024;
            v4u o0, o1;
#pragma unroll
            for (int j = 0; j < 4; ++j) { const f32x4 a = *(const f32x4*)(sc + 4 * j), b = *(const f32x4*)(sh + 4 * j);
                const f32x4 x = {v[4 * j], v[4 * j + 1], v[4 * j + 2], v[4 * j + 3]}; const f32x4 o = (x * rstd * gg[j]) * (a + 1.f) + b;
                if (j < 2) { o0[2 * j] = pk2(o.x, o.y); o0[2 * j + 1] = pk2(o.z, o.w); } else { o1[2 * (j - 2)] = pk2(o.x, o.y); o1[2 * (j - 2) + 1] = pk2(o.z, o.w); } }
            *(v4u*)(dst + (size_t)m * DM + c0) = o0; *(v4u*)(dst + (size_t)m * DM + c0 + 8) = o1;
        }
    }
}
__device__ __forceinline__ void final_norm_phase(Frame& F, float* x, const float* g) {
    const int gw = F.vcu * NWAVES + F.wave, NGW = F.G * NWAVES;
    for (int m = gw; m < ML; m += NGW) {
        GAS f32x4* xr = (GAS f32x4*)(x + (size_t)m * DM) + F.lane;
        f32x4 v[4]; float s = 0.f;
#pragma unroll
        for (int j = 0; j < 4; ++j) { v[j] = xr[64 * j]; s += (v[j].x * v[j].x + v[j].y * v[j].y) + (v[j].z * v[j].z + v[j].w * v[j].w); }
        const float rstd = 1.f / sqrtf(wave_sum(s) * (1.f / DM) + NORM_EPS);
#pragma unroll
        for (int j = 0; j < 4; ++j) { const f32x4 gg = *(const f32x4*)(g + 4 * F.lane + 256 * j); xr[64 * j] = v[j] * rstd * gg; }
    }
}
__device__ __forceinline__ f32x16 mfma32(bf16x8 a, bf16x8 b, f32x16 c) { return __builtin_amdgcn_mfma_f32_32x32x16_bf16(a, b, c, 0, 0, 0); }
__device__ __forceinline__ s16x4 tr_read(const LAS unsigned char* p) { return __builtin_bit_cast(s16x4, __builtin_amdgcn_ds_read_tr16_b64_v4i16((LAS s16x4*)p)); }
__device__ __forceinline__ bf16x8 cat4(s16x4 lo, s16x4 hi) { return (bf16x8){lo[0], lo[1], lo[2], lo[3], hi[0], hi[1], hi[2], hi[3]}; }
typedef float f32x2c __attribute__((ext_vector_type(2))); typedef __bf16 bf16x2c __attribute__((ext_vector_type(2)));
__device__ __forceinline__ unsigned cvtpk(float lo, float hi) { const f32x2c v = {lo, hi}; const bf16x2c b = __builtin_convertvector(v, bf16x2c); return __builtin_bit_cast(unsigned, b); }
__device__ __forceinline__ float swap32(float x) { auto rr = __builtin_amdgcn_permlane32_swap(__float_as_uint(x), __float_as_uint(x), false, false); return __uint_as_float((threadIdx.x & 32) ? rr[0] : rr[1]); }
__device__ __forceinline__ v4u widen2(v2u a, v2u b) { auto r0 = __builtin_amdgcn_permlane32_swap(a.x, b.x, false, false); auto r1 = __builtin_amdgcn_permlane32_swap(a.y, b.y, false, false); return (v4u){r0[0], r1[0], r0[1], r1[1]}; }
__device__ __forceinline__ void store_rows16(bf16* base, v2u g0, v2u g1, v2u g2, v2u g3, int hi) {
    const v4u w0 = widen2(g0, g1), w1 = widen2(g2, g3);
    *(v4u*)(base + (hi ? 8 : 0)) = w0; *(v4u*)(base + 16 + (hi ? 8 : 0)) = w1;
}
__device__ __forceinline__ v2u pk4(float a, float b, float c, float d) { v2u w; w.x = cvtpk(a, b); w.y = cvtpk(c, d); return w; }
__device__ __forceinline__ bf16x8 pack8(const f32x16& p, int b) {
    v4u w; w.x = cvtpk(p[b + 0], p[b + 1]); w.y = cvtpk(p[b + 2], p[b + 3]); w.z = cvtpk(p[b + 4], p[b + 5]); w.w = cvtpk(p[b + 6], p[b + 7]);
    return __builtin_bit_cast(bf16x8, w);
}
constexpr int KP = 144;
__device__ __forceinline__ void attn_phase(Frame& F, const Args& A_, int ufirst, int ustride) {
    const bf16* QKV = (const bf16*)(F.ws + WS_QKV); bf16* O = (bf16*)(F.ws + WS_ATTRW);
    const int lane = F.lane, r32 = lane & 31, hi = lane >> 5;
    const int g = F.wave & 3, half = F.wave >> 2;
    const int skey = F.tid >> 3, sch = F.tid & 7;
    for (int unit = ufirst; unit < 1024; unit += ustride) {
        const int b = unit >> 8, kvh = (unit >> 7) & 1, qb = unit & 127, s0 = qb * 64;
        const int head = kvh * 4 + g; const int tq = s0 + half * 32 + r32;
        const int lo = 4 + (qb < 2 ? 2 - qb : 0), hiT = 8 - (qb > 125 ? qb - 125 : 0);
        const bf16* qrow = QKV + (size_t)(b * SEQ + tq) * 768 + head * 64;
        bf16x8 qf[4];
#pragma unroll
        for (int s = 0; s < 4; ++s) qf[s] = *(const bf16x8*)(qrow + 16 * s + 8 * hi);
        float m = A_.in[I_SINK][head] * 1.4426950408889634f, l = (hi == 0) ? 1.f : 0.f;
        f32x16 o0 = {}, o1 = {};
        const bf16* kvbase = QKV + 512 + kvh * 64 + sch * 8;
#define KROW0(t) (((t) < 4) ? (ML + b * CTXL + (t) * 64) : (b * SEQ + s0 - 128 + ((t) - 4) * 64))
        v4u pk_, pv_;
        { const bf16* kp = kvbase + (size_t)(KROW0(0) + skey) * 768; pk_ = *(const v4u*)kp; pv_ = *(const v4u*)(kp + 128); }
        __syncthreads();
        *(LAS v4u*)(F.lds + skey * KP + sch * 16) = pk_; *(LAS v4u*)(F.lds + 64 * KP + skey * KP + sch * 16) = pv_;
        __syncthreads();
        int buf = 0;
        for (int tile = 0;;) {
            const int nxt = (tile == 3) ? lo : tile + 1; const bool more = tile != hiT;
            if (more) { const bf16* kp = kvbase + (size_t)(KROW0(nxt) + skey) * 768; pk_ = *(const v4u*)kp; pv_ = *(const v4u*)(kp + 128); }
            const LAS unsigned char* Ks = F.lds + buf * (128 * KP); const LAS unsigned char* Vs = Ks + 64 * KP;
            f32x16 p0 = {}, p1 = {};
#pragma unroll
            for (int s = 0; s < 4; ++s) {
                const bf16x8 a0 = *(const LAS bf16x8*)(Ks + r32 * KP + (16 * s + 8 * hi) * 2);
                const bf16x8 a1 = *(const LAS bf16x8*)(Ks + (32 + r32) * KP + (16 * s + 8 * hi) * 2);
                p0 = mfma32(a0, qf[s], p0); p1 = mfma32(a1, qf[s], p1);
            }
            if (tile == 4 || tile == 8) {
                const int ks = s0 - 128 + (tile - 4) * 64;
#pragma unroll
                for (int r = 0; r < 16; ++r) { const int key = (r & 3) + 8 * (r >> 2) + 4 * hi; const int d0 = tq - (ks + key), d1 = d0 - 32;
                    if (d0 > 128 || d0 < -128) p0[r] = -INFINITY; if (d1 > 128 || d1 < -128) p1[r] = -INFINITY; }
            }
            float mx = fmaxf(p0[0], p1[0]);
#pragma unroll
            for (int r = 1; r < 16; ++r) mx = fmaxf(mx, fmaxf(p0[r], p1[r]));
            { auto rr = __builtin_amdgcn_permlane32_swap(__float_as_uint(mx), __float_as_uint(mx), false, false); mx = fmaxf(__uint_as_float(rr[0]), __uint_as_float(rr[1])); }
            const float mn = fmaxf(m, mx), alpha = __builtin_amdgcn_exp2f(m - mn); m = mn;
            float ls = 0.f;
#pragma unroll
            for (int r = 0; r < 16; ++r) { p0[r] = __builtin_amdgcn_exp2f(p0[r] - mn); p1[r] = __builtin_amdgcn_exp2f(p1[r] - mn); ls += p0[r] + p1[r]; }
            l = l * alpha + ls;
            if (__any(alpha != 1.f)) {
#pragma unroll
                for (int r = 0; r < 16; ++r) { o0[r] *= alpha; o1[r] *= alpha; }
            }
            const bf16x8 pb0 = pack8(p0, 0), pb1 = pack8(p0, 8), pb2 = pack8(p1, 0), pb3 = pack8(p1, 8);
            const int i16 = lane & 15, qd = i16 >> 2, pp = i16 & 3, c0 = lane & 16;
            const LAS unsigned char* vb = Vs + (4 * hi + qd) * KP + (c0 + 4 * pp) * 2;
#define PVSTEP(s, pb) do { \
                const bf16x8 va0 = cat4(tr_read(vb + (16 * (s)) * KP), tr_read(vb + (16 * (s) + 8) * KP)); \
                const bf16x8 va1 = cat4(tr_read(vb + (16 * (s)) * KP + 64), tr_read(vb + (16 * (s) + 8) * KP + 64)); \
                o0 = mfma32(va0, pb, o0); o1 = mfma32(va1, pb, o1); } while (0)
            PVSTEP(0, pb0); PVSTEP(1, pb1); PVSTEP(2, pb2); PVSTEP(3, pb3);
#undef PVSTEP
            if (!more) break;
            buf ^= 1;
            *(LAS v4u*)(F.lds + buf * (128 * KP) + skey * KP + sch * 16) = pk_; *(LAS v4u*)(F.lds + buf * (128 * KP) + 64 * KP + skey * KP + sch * 16) = pv_;
            __syncthreads();
            tile = nxt;
        }
#undef KROW0
        { auto rr = __builtin_amdgcn_permlane32_swap(__float_as_uint(l), __float_as_uint(l), false, false); l = __uint_as_float(rr[0]) + __uint_as_float(rr[1]); }
        const float inv = __builtin_amdgcn_rcpf(l);
        bf16* orow = O + (size_t)(b * SEQ + tq) * 1024 + head * 64;
        store_rows16(orow, pk4(o0[0] * inv, o0[1] * inv, o0[2] * inv, o0[3] * inv), pk4(o0[4] * inv, o0[5] * inv, o0[6] * inv, o0[7] * inv), pk4(o0[8] * inv, o0[9] * inv, o0[10] * inv, o0[11] * inv), pk4(o0[12] * inv, o0[13] * inv, o0[14] * inv, o0[15] * inv), hi);
        store_rows16(orow + 32, pk4(o1[0] * inv, o1[1] * inv, o1[2] * inv, o1[3] * inv), pk4(o1[4] * inv, o1[5] * inv, o1[6] * inv, o1[7] * inv), pk4(o1[8] * inv, o1[9] * inv, o1[10] * inv, o1[11] * inv), pk4(o1[12] * inv, o1[13] * inv, o1[14] * inv, o1[15] * inv), hi);
    }
}

constexpr int AP3 = 272;
__device__ __forceinline__ void rwkv_prep_phase(Frame& F, const Args& A_) {
    const bf16* ZR = (const bf16*)(F.ws + WS_ZR); bf16* ZS = (bf16*)(F.ws + WS_ZS); float* INVN = (float*)(F.ws + WS_INVN);
    bf16* LIN = (bf16*)(F.ws + WS_LIN); bf16* GG = (bf16*)((unsigned char*)F.out + DO_G);
    const bf16* G2T = (const bf16*)(F.ws + WS_LG2);
    LAS unsigned char* A3 = F.lds;
    const float* mup = A_.in[I_MUP]; const float* mun = A_.in[I_MUN]; const float* kkw = A_.in[I_KK];
    const int lane = F.lane, r32 = lane & 31, hi = lane >> 5;
    const int pch = F.tid & 255, pth = F.tid >> 8, pcol = pch * 8; const bool pact = pch < 224;
    f32x4 mp0 = {}, mp1 = {}, mn0 = {}, mn1 = {}, kc0 = {}, kc1 = {};
    if (pact) { mp0 = *(const f32x4*)(mup + pcol); mp1 = *(const f32x4*)(mup + pcol + 4); mn0 = *(const f32x4*)(mun + pcol); mn1 = *(const f32x4*)(mun + pcol + 4); }
    if (pch >= 64 && pch < 128) { kc0 = *(const f32x4*)(kkw + pcol - 512); kc1 = *(const f32x4*)(kkw + pcol - 508); }
    bf16x8 g2f0[8], g2f1[8];
#pragma unroll
    for (int s = 0; s < 8; ++s) { g2f0[s] = *(const bf16x8*)(G2T + (size_t)(F.wave * 64 + r32) * 128 + 16 * s + 8 * hi); g2f1[s] = *(const bf16x8*)(G2T + (size_t)(F.wave * 64 + 32 + r32) * 128 + 16 * s + 8 * hi); }
    for (int unit = F.vcu; unit < MALL / 32; unit += F.G) {
        const int R0 = unit * 32;
        __syncthreads();
        {
            const int Rt = R0 + 16 * pth;
            const int seqlen = (R0 < ML) ? SEQ : CTXL; const int pos0 = (R0 < ML) ? (Rt & (SEQ - 1)) : ((Rt - ML) & (CTXL - 1));
            v4u zz[18];
#pragma unroll
            for (int i = 0; i < 18; ++i) { const int p = pos0 + i - 1; zz[i] = (v4u){0u, 0u, 0u, 0u}; if (pact && p >= 0 && p < seqlen) zz[i] = *(const v4u*)(ZR + (size_t)(Rt + i - 1) * RWC + pcol); }
#pragma unroll
            for (int i = 0; i < 16; ++i) {
                const int tk = 16 * pth + i, row = Rt + i, ch = pch, col = pcol;
                const v4u zp = zz[i], zc = zz[i + 1], zn = zz[i + 2];
                float z[8];
#pragma unroll
                for (int e = 0; e < 4; ++e) {
                    const float c0 = bf_lo(zc[e]), c1 = bf_hi(zc[e]), p0 = bf_lo(zp[e]), p1 = bf_hi(zp[e]), n0 = bf_lo(zn[e]), n1 = bf_hi(zn[e]);
                    const float a0 = (2 * e < 4) ? mp0[2 * e] : mp1[2 * e - 4], a1 = (2 * e + 1 < 4) ? mp0[2 * e + 1] : mp1[2 * e - 3];
                    const float b0 = (2 * e < 4) ? mn0[2 * e] : mn1[2 * e - 4], b1 = (2 * e + 1 < 4) ? mn0[2 * e + 1] : mn1[2 * e - 3];
                    z[2 * e] = c0 + a0 * (p0 - c0) + b0 * (n0 - c0); z[2 * e + 1] = c1 + a1 * (p1 - c1) + b1 * (n1 - c1);
                }
                if (ch < 192) {
                    v4u w; w.x = pk2(z[0], z[1]); w.y = pk2(z[2], z[3]); w.z = pk2(z[4], z[5]); w.w = pk2(z[6], z[7]);
                    *(v4u*)(ZS + (size_t)row * 1536 + col) = w;
                }
                {
                    float ss = 0.f;
#pragma unroll
                    for (int e = 0; e < 4; ++e) { const float a = z[e] * kc0[e], b = z[4 + e] * kc1[e]; ss += a * a + b * b; }
                    ss = sum8(ss);
                    if (ch >= 64 && ch < 128 && (ch & 7) == 0) INVN[(size_t)row * 8 + ((ch - 64) >> 3)] = 1.f / sqrtf(ss + 1e-12f);
                }
                if (ch >= 192 && pact) {
                    v4u w;
                    if (ch < 200) {
                        float t[8];
#pragma unroll
                        for (int e = 0; e < 8; ++e) { const float ex = __expf(-2.f * fabsf(z[e])); const float th = (1.f - ex) * __builtin_amdgcn_rcpf(1.f + ex); t[e] = z[e] < 0.f ? -th : th; }
                        w.x = pk2(t[0], t[1]); w.y = pk2(t[2], t[3]); w.z = pk2(t[4], t[5]); w.w = pk2(t[6], t[7]);
                        *(v4u*)(LIN + (size_t)row * 128 + (ch - 192) * 8) = w;
                    } else if (ch < 208) {
                        w.x = pk2(z[0], z[1]); w.y = pk2(z[2], z[3]); w.z = pk2(z[4], z[5]); w.w = pk2(z[6], z[7]);
                        *(v4u*)(LIN + (size_t)row * 128 + 64 + (ch - 200) * 8) = w;
                    } else {
                        float t[8];
#pragma unroll
                        for (int e = 0; e < 8; ++e) t[e] = __builtin_amdgcn_rcpf(1.f + __expf(-z[e]));
                        w.x = pk2(t[0], t[1]); w.y = pk2(t[2], t[3]); w.z = pk2(t[4], t[5]); w.w = pk2(t[6], t[7]);
                        *(LAS v4u*)(A3 + tk * AP3 + (ch - 208) * 16) = w;
                    }
                }
            }
        }
        __syncthreads();
        if (R0 < ML) {
#pragma unroll
            for (int t = 0; t < 2; ++t) {
                const int n0 = F.wave * 64 + t * 32; f32x16 acc = {};
#pragma unroll
                for (int s = 0; s < 8; ++s) acc = mfma32(t ? g2f1[s] : g2f0[s], *(const LAS bf16x8*)(A3 + r32 * AP3 + (16 * s + 8 * hi) * 2), acc);
                store_rows16(GG + (size_t)(R0 + r32) * 512 + n0, pk4(acc[0], acc[1], acc[2], acc[3]), pk4(acc[4], acc[5], acc[6], acc[7]), pk4(acc[8], acc[9], acc[10], acc[11]), pk4(acc[12], acc[13], acc[14], acc[15]), hi);
            }
        }
    }
}

#ifndef AREPMASK
#define AREPMASK 0
#endif
#ifndef AREPS
#define AREPS 5
#endif
#if AREPMASK
#define ALOOP(k) for (int ar_ = 0; ar_ < (((AREPMASK >> (k)) & 1) ? AREPS : 1); ++ar_, __syncthreads())
#else
#define ALOOP(k)
#endif
constexpr int SP = 144, SLOT = 64 * SP;
constexpr int NCHUNK = (CTXL + SEQ) / 64;
#define ROWOF(s) (((s) < CTXL) ? (ML + b * CTXL + (d == 0 ? (s) : CTXL - 1 - (s))) : (b * SEQ + (d == 0 ? ((s) - CTXL) : (SEQ - 1 - ((s) - CTXL)))))
__device__ __forceinline__ bf16x8 ldA(const LAS unsigned char* X, int row0, int ks, int r32, int hi) { return *(const LAS bf16x8*)(X + (row0 + r32) * SP + (16 * ks + 8 * hi) * 2); }
__device__ __forceinline__ bf16x8 ldT(const LAS unsigned char* X, int n0, int ks, int lane) {
    const int hi = lane >> 5, i16 = lane & 15, qd = i16 >> 2, pp = i16 & 3, c0 = lane & 16;
    const LAS unsigned char* p = X + (16 * ks + 8 * hi + qd) * SP + (n0 + c0 + 4 * pp) * 2;
    return cat4(tr_read(p), tr_read(p + 4 * SP));
}
#define KPOS(rb, q4, hi) ((rb) * 32 + (2 * ((q4) & 1) + (hi)) * 8 + ((q4) >> 1) * 4)
__device__ __forceinline__ v2u pack4(float a, float b, float c, float d) { v2u w; w.x = pk2(a, b); w.y = pk2(c, d); return w; }
__device__ __forceinline__ void stT(LAS unsigned char* M, const f32x16& dv, int r0, int c0, int r32, int hi) {
#pragma unroll
    for (int q4 = 0; q4 < 4; ++q4) *(LAS v2u*)(M + (c0 + r32) * SP + (r0 + 8 * q4 + 4 * hi) * 2) = pack4(dv[4 * q4], dv[4 * q4 + 1], dv[4 * q4 + 2], dv[4 * q4 + 3]);
}
__device__ __forceinline__ void rwkv_chunkA_phase(Frame& F, const Args& A_) {
    const bf16* ZS = (const bf16*)(F.ws + WS_ZS); const float* INVN = (const float*)(F.ws + WS_INVN); const bf16* LIN = (const bf16*)(F.ws + WS_LIN);
    const bf16* W2T = (const bf16*)(F.ws + WS_LW2); const bf16* A2T = (const bf16*)(F.ws + WS_LA2);
    bf16* MTg = (bf16*)(F.ws + WS_MT); bf16* NNg = (bf16*)(F.ws + WS_NN); bf16* QTg = (bf16*)(F.ws + WS_QT);
    bf16* Yg = (bf16*)((unsigned char*)F.out + DO_Y);
    LAS unsigned char* L = F.lds;
    LAS unsigned char* sKKt = L, *sBh = L + SLOT, *sKh = L + 2 * SLOT, *sRt = L + 3 * SLOT, *sBp = L + 4 * SLOT, *sKp = L + 5 * SLOT, *sVm = L + 6 * SLOT,
                     *sT = L + 7 * SLOT, *sAkN = L + 8 * SLOT, *sBbT = L + 9 * SLOT, *sHT = L + 10 * SLOT;
    LAS unsigned char* sFT = sBh; LAS unsigned char* sZT = sBbT; LAS unsigned char* sWyT = sBp; LAS unsigned char* sXT = sHT;
    LAS float* AB = (LAS float*)(L + 11 * SLOT);
    LAS unsigned char* sL1 = L + 11 * SLOT; LAS unsigned char* sL2 = L + 12 * SLOT;
    LAS float* LWf = (LAS float*)(L + 7 * SLOT); LAS float* AAf = LWf + 4096;
    LAS unsigned char* sR0 = L + 13 * SLOT, *sK0 = L + 14 * SLOT, *sV0 = L + 15 * SLOT;
    LAS float* SEG = (LAS float*)(L + 16 * SLOT);
    const int lane = F.lane, r32 = lane & 31, hi = lane >> 5, w = F.wave;
    constexpr int IPB = 64 * NCHUNK / 256;
    const int chain = F.vcu / (NCHUNK / IPB), b = chain >> 4, h = (chain >> 1) & 7, d = chain & 1, cfirst = (F.vcu % (NCHUNK / IPB)) * IPB;
    const int lwhich = w >> 2, ltb = (w >> 1) & 1, lcb = w & 1;
    bf16x8 wfrag[4]; float lbias;
    { const int chn = h * 64 + 32 * lcb + r32; const bf16* Bt = (lwhich ? A2T : W2T) + (size_t)(d * 512 + chn) * 64;
#pragma unroll
      for (int ks = 0; ks < 4; ++ks) wfrag[ks] = *(const bf16x8*)(Bt + 16 * ks + 8 * hi);
      lbias = (lwhich ? A_.in[I_IA0] : A_.in[I_DW0])[d * 512 + chn]; }
    const float kkc = A_.in[I_KK][h * 64 + (F.tid & 63)], kac = A_.in[I_KA][h * 64 + (F.tid & 63)];
    v4u pf_l1, pf_l2, pf_r, pf_k, pf_v; float pf_in = 0.f;
    const int ptok = F.tid >> 3, pc16 = F.tid & 7;
#define CHA_PREFETCH(cc) do { const int row_ = ROWOF(64 * (cc) + ptok); \
        pf_l1 = *(const v4u*)(LIN + (size_t)row_ * 128 + pc16 * 8); pf_l2 = *(const v4u*)(LIN + (size_t)row_ * 128 + 64 + pc16 * 8); \
        const bf16* zp_ = ZS + (size_t)row_ * 1536 + h * 64 + pc16 * 8; pf_r = *(const v4u*)zp_; pf_k = *(const v4u*)(zp_ + 512); pf_v = *(const v4u*)(zp_ + 1024); \
        if (F.tid < 64) pf_in = INVN[(size_t)ROWOF(64 * (cc) + F.tid) * 8 + h]; } while (0)
#define CHA_STAGE() do { *(LAS v4u*)(sL1 + ptok * SP + pc16 * 16) = pf_l1; *(LAS v4u*)(sL2 + ptok * SP + pc16 * 16) = pf_l2; \
        *(LAS v4u*)(sR0 + ptok * SP + pc16 * 16) = pf_r; *(LAS v4u*)(sK0 + ptok * SP + pc16 * 16) = pf_k; *(LAS v4u*)(sV0 + ptok * SP + pc16 * 16) = pf_v; \
        if (F.tid < 64) SEG[9 * 64 + F.tid] = pf_in; } while (0)
    __syncthreads();
    CHA_PREFETCH(cfirst); CHA_STAGE();
    CHA_PREFETCH(cfirst + 1);
#pragma unroll 1
    for (int ii = 0; ii < IPB; ++ii) {
        const int c = cfirst + ii, inst = chain * NCHUNK + c;
        const bool latent = c >= CTXL / 64;
        __syncthreads();
        ALOOP(0) { f32x16 acc = {};
#pragma unroll
          for (int ks = 0; ks < 4; ++ks) acc = mfma32(ldA(lwhich ? sL2 : sL1, 32 * ltb, ks, r32, hi), wfrag[ks], acc);
#pragma unroll
          for (int r = 0; r < 16; ++r) { const int tok = 32 * ltb + (r & 3) + 8 * (r >> 2) + 4 * hi; const float x = lbias + acc[r];
              const float sg = __builtin_amdgcn_rcpf(1.f + __expf(-x));
              if (lwhich == 0) LWf[tok * 64 + 32 * lcb + r32] = -0.6065306597126334f * sg; else AAf[tok * 64 + 32 * lcb + r32] = sg; }
        }
        __syncthreads();
        {
            const int ch = F.tid & 63, seg = F.tid >> 6;
            float lw[8], aa[8], rr[8], kx[8], inn[8]; bf16 vraw[8];
#pragma unroll
            for (int e = 0; e < 8; ++e) vraw[e] = *(const LAS bf16*)(sV0 + (8 * seg + e) * SP + ch * 2);
#pragma unroll
            for (int e = 0; e < 8; ++e) { const int tok = 8 * seg + e; lw[e] = LWf[tok * 64 + ch]; aa[e] = AAf[tok * 64 + ch];
                rr[e] = bf1(*(const LAS bf16*)(sR0 + tok * SP + ch * 2)); kx[e] = bf1(*(const LAS bf16*)(sK0 + tok * SP + ch * 2)); inn[e] = SEG[9 * 64 + tok]; }
            float cl[8]; cl[0] = lw[0];
#pragma unroll
            for (int e = 1; e < 8; ++e) cl[e] = cl[e - 1] + lw[e];
            SEG[seg * 64 + ch] = cl[7];
            __syncthreads();
            float pre = 0.f, tot = 0.f;
#pragma unroll
            for (int s = 0; s < 8; ++s) { const float t = SEG[s * 64 + ch]; tot += t; if (s < seg) pre += t; }
            if (seg == 0) SEG[8 * 64 + ch] = tot;
            const float ptot = __expf(tot); float epprev = __expf(pre);
#pragma unroll
            for (int e = 0; e < 8; ++e) {
                const int tok = 8 * seg + e; const float c_ = pre + cl[e];
                const float kk = kx[e] * kkc * inn[e], bb = kk * aa[e], kd = kx[e] * (1.f + (aa[e] - 1.f) * kac);
                const float em = __expf(-c_), ep = __builtin_amdgcn_rcpf(em), ee = ptot * em, e1 = epprev; epprev = ep;
                const int o = tok * SP + ch * 2;
                *(LAS bf16*)(sKKt + o) = (bf16)f2bf(kk * e1); *(LAS bf16*)(sBh + o) = (bf16)f2bf(bb * em); *(LAS bf16*)(sKh + o) = (bf16)f2bf(kd * em); *(LAS bf16*)(sRt + o) = (bf16)f2bf(rr[e] * ep);
                *(LAS bf16*)(sBp + o) = (bf16)f2bf(bb * ee); *(LAS bf16*)(sKp + o) = (bf16)f2bf(kd * ee); *(LAS bf16*)(sVm + o) = vraw[e];
            }
        }
        __syncthreads();
        ALOOP(1)
        if (w < 4) {
            const int rb = (w >> 1) & 1, cb = w & 1;
            f32x16 acc = {};
#pragma unroll
            for (int ks = 0; ks < 4; ++ks) acc = mfma32(ldA(sKKt, 32 * rb, ks, r32, hi), ldA(sBh, 32 * cb, ks, r32, hi), acc);
            const int col = 32 * cb + r32;
#pragma unroll
            for (int r = 0; r < 16; ++r) { const int row = 32 * rb + (r & 3) + 8 * (r >> 2) + 4 * hi; if (!(col < row)) acc[r] = 0.f; }
#pragma unroll
            for (int q4 = 0; q4 < 4; ++q4) *(LAS f32x4*)(AB + col * 68 + 32 * rb + 8 * q4 + 4 * hi) = (f32x4){acc[4 * q4], acc[4 * q4 + 1], acc[4 * q4 + 2], acc[4 * q4 + 3]};
        }
        __syncthreads();
        ALOOP(2) {
            const int gm = 1 + (w >> 2), grb = (w >> 1) & 1, gcb = w & 1;
            f32x16 gacc = {};
            { const LAS unsigned char* GX = (gm == 2) ? sBh : sKKt; const LAS unsigned char* GY = (gm == 1) ? sKh : sRt;
#pragma unroll
              for (int ks = 0; ks < 4; ++ks) gacc = mfma32(ldA(GX, 32 * grb, ks, r32, hi), ldA(GY, 32 * gcb, ks, r32, hi), gacc); }
            const int col = F.tid >> 3, jq = F.tid & 7, blk = col >> 5, cc = col & 31; float t0 = 0.f, t1 = 0.f, t2 = 0.f, t3 = 0.f;
            const LAS float* arow = AB + (32 * blk) * 68 + 32 * blk + 4 * jq;
#pragma unroll
            for (int i = 31; i >= 0; --i) {
                const f32x4 av = *(const LAS f32x4*)(arow + i * 68);
                float p = av[0] * t0 + av[1] * t1 + av[2] * t2 + av[3] * t3; p = sum8(p);
                const float val = (i == cc) ? 1.f : ((i < cc) ? -p : 0.f);
                if (jq == (i >> 2)) { if ((i & 3) == 0) t0 = val; else if ((i & 3) == 1) t1 = val; else if ((i & 3) == 2) t2 = val; else t3 = val; }
            }
            { const int gcol = 32 * gcb + r32;
#pragma unroll
              for (int r = 0; r < 16; ++r) { const int row = 32 * grb + (r & 3) + 8 * (r >> 2) + 4 * hi;
                  const bool keep = (gm == 2) ? (row <= gcol) : (gcol < row); float vl = keep ? gacc[r] : 0.f; if (gm == 1) vl = -vl; gacc[r] = vl; }
              stT((gm == 1) ? sAkN : sBbT, gacc, 32 * grb, 32 * gcb, r32, hi); }
            { LAS unsigned char* tp_ = sT + (32 * blk + 4 * jq) * SP + (32 * blk + cc) * 2;
              *(LAS bf16*)(tp_) = (bf16)f2bf(t0); *(LAS bf16*)(tp_ + SP) = (bf16)f2bf(t1); *(LAS bf16*)(tp_ + 2 * SP) = (bf16)f2bf(t2); *(LAS bf16*)(tp_ + 3 * SP) = (bf16)f2bf(t3); }
            if (F.tid < 64) { const v4u z = {0u, 0u, 0u, 0u}; LAS unsigned char* zp = sT + (32 + (F.tid >> 1)) * SP + (F.tid & 1) * 32; *(LAS v4u*)zp = z; *(LAS v4u*)(zp + 16) = z; }
        }
        __syncthreads();
        if (w == 0) {
            f32x16 x = {};
#pragma unroll
            for (int ks = 0; ks < 2; ++ks) { const LAS float* ap = AB + r32 * 68 + 32 + 16 * ks + 8 * hi; const f32x4 a0 = *(const LAS f32x4*)ap, a1 = *(const LAS f32x4*)(ap + 4);
                v4u aw; aw.x = pk2(a0[0], a0[1]); aw.y = pk2(a0[2], a0[3]); aw.z = pk2(a1[0], a1[1]); aw.w = pk2(a1[2], a1[3]);
                const int i16 = lane & 15, qd = i16 >> 2, pp = i16 & 3, c0 = lane & 16;
                const LAS unsigned char* tp = sT + (32 + 16 * ks + 8 * hi + qd) * SP + (32 + c0 + 4 * pp) * 2;
                x = mfma32(__builtin_bit_cast(bf16x8, aw), cat4(tr_read(tp), tr_read(tp + 4 * SP)), x); }
            stT(sXT, x, 0, 0, r32, hi);
            f32x16 tr = {};
#pragma unroll
            for (int ks = 0; ks < 2; ++ks) tr = mfma32(ldA(sT, 0, ks, r32, hi), ldA(sXT, 0, ks, r32, hi), tr);
#pragma unroll
            for (int r = 0; r < 16; ++r) { const int i = (r & 3) + 8 * (r >> 2) + 4 * hi; *(LAS bf16*)(sT + i * SP + (32 + r32) * 2) = (bf16)f2bf(-tr[r]); }
        }
        __syncthreads();
        ALOOP(3) { const int which = w >> 2, rb = (w >> 1) & 1, cb = w & 1; f32x16 acc = {};
#pragma unroll
          for (int ks = 0; ks < 4; ++ks) acc = mfma32(ldA(sT, 32 * rb, ks, r32, hi), which ? ldT(sBp, 32 * cb, ks, lane) : ldA(sBbT, 32 * cb, ks, r32, hi), acc);
          stT(which ? sHT : sFT, acc, 32 * rb, 32 * cb, r32, hi); }
        __syncthreads();
        if (ii + 1 < IPB) { CHA_STAGE(); if (ii + 2 < IPB) CHA_PREFETCH(c + 2); }
        const size_t ioff = (size_t)(c * 64 + chain) * 4096; const size_t qoff = (size_t)((c - 4) * 64 + chain) * 4096;
        ALOOP(4)
#pragma unroll 1
        for (int q = w; q < 16; q += 8) {
            const int kind = q >> 2, rb = (q >> 1) & 1, cb = q & 1; const int col = 32 * cb + r32;
            if (!latent && (kind == 1 || kind == 3)) continue;
            f32x16 acc = {};
            if (kind == 3) {
#pragma unroll
                for (int ks = 0; ks < 4; ++ks) acc = mfma32(ldA(sKh, 32 * rb, ks, r32, hi), ldA(sRt, 32 * cb, ks, r32, hi), acc);
#pragma unroll
                for (int r = 0; r < 16; ++r) { const int row = 32 * rb + (r & 3) + 8 * (r >> 2) + 4 * hi; if (row > col) acc[r] = 0.f; }
            }
#pragma unroll
            for (int ks = 0; ks < 4; ++ks) {
                const bf16x8 a = (kind < 2) ? ldT(sKKt, 32 * rb, ks, lane) : ldA(sAkN, 32 * rb, ks, r32, hi);
                const bf16x8 bq = (kind == 0 || kind == 2) ? ldA(sHT, 32 * cb, ks, r32, hi) : ldA(sFT, 32 * cb, ks, r32, hi);
                acc = mfma32(a, bq, acc);
            }
            if (kind == 0) {
                const float pc = __expf(SEG[8 * 64 + col]); v2u pq[4];
#pragma unroll
                for (int q4 = 0; q4 < 4; ++q4) { const int r0 = 32 * rb + 8 * q4 + 4 * hi; float o[4];
#pragma unroll
                    for (int e = 0; e < 4; ++e) o[e] = ((r0 + e == col) ? pc : 0.f) - acc[4 * q4 + e];
                    pq[q4] = pk4(o[0], o[1], o[2], o[3]); }
                bf16* dp = MTg + ioff + (size_t)col * 64 + rb * 32;
                *(v4u*)(dp + hi * 8) = (v4u){pq[0].x, pq[0].y, pq[2].x, pq[2].y}; *(v4u*)(dp + (2 + hi) * 8) = (v4u){pq[1].x, pq[1].y, pq[3].x, pq[3].y};
            } else if (kind == 1) {
                v2u pq[4];
#pragma unroll
                for (int q4 = 0; q4 < 4; ++q4) { const int r0 = 32 * rb + 8 * q4 + 4 * hi; const v2u rv = *(const LAS v2u*)(sRt + col * SP + r0 * 2);
                    pq[q4] = pk4(bf_lo(rv.x) - acc[4 * q4], bf_hi(rv.x) - acc[4 * q4 + 1], bf_lo(rv.y) - acc[4 * q4 + 2], bf_hi(rv.y) - acc[4 * q4 + 3]); }
                bf16* dp = QTg + qoff + (size_t)col * 64 + rb * 32;
                *(v4u*)(dp + hi * 8) = (v4u){pq[0].x, pq[0].y, pq[2].x, pq[2].y}; *(v4u*)(dp + (2 + hi) * 8) = (v4u){pq[1].x, pq[1].y, pq[3].x, pq[3].y};
            } else if (kind == 2) {
#pragma unroll
                for (int r = 0; r < 16; ++r) { const int row = 32 * rb + (r & 3) + 8 * (r >> 2) + 4 * hi; acc[r] += bf1(*(const LAS bf16*)(sKp + row * SP + col * 2)); }
                stT(sZT, acc, 32 * rb, 32 * cb, r32, hi);
            } else stT(sWyT, acc, 32 * rb, 32 * cb, r32, hi);
        }
        __syncthreads();
        ALOOP(5) { const int which = w >> 2, rb = (w >> 1) & 1, cb = w & 1; const int col = 32 * cb + r32;
          if (which == 0 || latent) {
            f32x16 acc = {};
#pragma unroll
            for (int ks = 0; ks < 4; ++ks) acc = which ? mfma32(ldT(sVm, 32 * rb, ks, lane), ldA(sWyT, 32 * cb, ks, r32, hi), acc) : mfma32(ldA(sZT, 32 * rb, ks, r32, hi), ldT(sVm, 32 * cb, ks, lane), acc);
            const v2u q0 = pk4(acc[0], acc[1], acc[2], acc[3]), q1 = pk4(acc[4], acc[5], acc[6], acc[7]), q2 = pk4(acc[8], acc[9], acc[10], acc[11]), q3 = pk4(acc[12], acc[13], acc[14], acc[15]);
            if (which) store_rows16(Yg + ((size_t)d * ML + ROWOF(64 * c + col)) * 512 + h * 64 + 32 * rb, q0, q1, q2, q3, hi);
            else { bf16* dp = NNg + ioff + (size_t)col * 64 + 8 * rb;
                *(v4u*)(dp + hi * 16) = (v4u){q0.x, q0.y, q2.x, q2.y}; *(v4u*)(dp + (2 + hi) * 16) = (v4u){q1.x, q1.y, q3.x, q3.y}; }
          } }
    }
}

typedef float f32x4_t __attribute__((ext_vector_type(4)));
__device__ __forceinline__ f32x4_t mfma16(bf16x8 a, bf16x8 b, f32x4_t c) { return __builtin_amdgcn_mfma_f32_16x16x32_bf16(a, b, c, 0, 0, 0); }
__device__ __forceinline__ bf16* ss_ptr(Frame& F, int cl, int chain) { return ((cl < 64) ? (bf16*)(F.ws + WS_SS) : (bf16*)((unsigned char*)F.out + DO_SS)) + (size_t)((cl & 63) * 64 + chain) * 4096; }
__device__ __forceinline__ void st16_asm(void* p, v4u v) { asm volatile("global_store_dwordx4 %0, %1, off\n\ts_nop 1" :: "v"(p), "v"(v) : "memory"); }
struct ChunkOps { v4u m[8]; v4u n[2]; };
__device__ __forceinline__ void chB_load(ChunkOps& o, const bf16* mt, const bf16* nn) {
#pragma unroll
    for (int tn = 0; tn < 4; ++tn) { o.m[2 * tn] = *(const v4u*)(mt + tn * 1024); o.m[2 * tn + 1] = *(const v4u*)(mt + tn * 1024 + 32); }
    o.n[0] = *(const v4u*)nn; o.n[1] = *(const v4u*)(nn + 8);
}
__device__ __forceinline__ void rwkv_chunkB_phase(Frame& F, const Args& A_, int mode = 0) {
    if (F.vcu >= 64) return;
    const int chain = F.vcu, vb = F.wave & 3; const bool comp = F.wave < 4;
    const int l15 = F.lane & 15, g = F.lane >> 4;
    const int lt = F.tid & 255;
    const bf16* mtg = (const bf16*)(F.ws + WS_MT) + (size_t)chain * 4096 + lt * 8;
    const bf16* nng = (const bf16*)(F.ws + WS_NN) + (size_t)chain * 4096 + lt * 8;
    const int ssoff = (16 * vb + l15) * 64 + 8 * g;
    const int wr = lt >> 3, wp = lt & 7; const int woff = wr * 128 + ((wp ^ (wr & 7)) << 4);
    LAS unsigned char* img = F.lds;
    bf16x8 S0 = {}, S1 = {};
    struct R4 { v4u a, b, c, d; };
    R4 r0, r1, r2, r3, r4, r5;
#define B_LD(r, cc) do { r.a = *(const v4u*)(mtg + (size_t)(cc) * 262144); r.b = *(const v4u*)(mtg + (size_t)(cc) * 262144 + 2048); r.c = *(const v4u*)(nng + (size_t)(cc) * 262144); r.d = *(const v4u*)(nng + (size_t)(cc) * 262144 + 2048); } while (0)
#define B_ST(r, cc) do { LAS unsigned char* d_ = img + ((cc) & 1) * 16384 + woff; *(LAS v4u*)d_ = r.a; *(LAS v4u*)(d_ + 4096) = r.b; *(LAS v4u*)(d_ + 8192) = r.c; *(LAS v4u*)(d_ + 12288) = r.d; } while (0)
    if (!comp) { B_LD(r0, 0); B_LD(r1, 1); B_LD(r2, 2); B_LD(r3, 3); B_LD(r4, 4); B_LD(r5, 5); }
    __syncthreads();
    if (!comp) { B_ST(r0, 0); B_LD(r0, 6); }
    __syncthreads();
#define B_ITER(Rn, cc) do { \
        if (!comp) { if ((cc) + 1 < NCHUNK && mode != 2) { B_ST(Rn, (cc) + 1); if ((cc) + 7 < NCHUNK) B_LD(Rn, (cc) + 7); } } \
        else if (mode != 1) { \
            const LAS unsigned char* si_ = img + ((cc) & 1) * 16384; \
            if ((cc) >= 4) { bf16* sp_ = ss_ptr(F, (cc) - 4, chain) + ssoff; *(v4u*)sp_ = __builtin_bit_cast(v4u, S0); *(v4u*)(sp_ + 32) = __builtin_bit_cast(v4u, S1); } \
            const int vr_ = 16 * vb + l15; \
            const v4u n0_ = *(const LAS v4u*)(si_ + 8192 + vr_ * 128 + (((2 * g) ^ (vr_ & 7)) << 4)), n1_ = *(const LAS v4u*)(si_ + 8192 + vr_ * 128 + (((2 * g + 1) ^ (vr_ & 7)) << 4)); \
            f32x4_t dn_[4]; \
            _Pragma("unroll") for (int tn = 0; tn < 4; ++tn) { const int nr_ = 16 * tn + l15; \
                const bf16x8 a0_ = *(const LAS bf16x8*)(si_ + nr_ * 128 + ((g ^ (nr_ & 7)) << 4)), a1_ = *(const LAS bf16x8*)(si_ + nr_ * 128 + (((4 + g) ^ (nr_ & 7)) << 4)); \
                const v4u nq_ = (tn >> 1) ? n1_ : n0_; const unsigned nx_ = (tn & 1) ? nq_.z : nq_.x, ny_ = (tn & 1) ? nq_.w : nq_.y; \
                const f32x4_t ci_ = {bf_lo(nx_), bf_hi(nx_), bf_lo(ny_), bf_hi(ny_)}; \
                dn_[tn] = mfma16(a0_, S0, ci_); dn_[tn] = mfma16(a1_, S1, dn_[tn]); } \
            v4u w0_, w1_; w0_.x = cvtpk(dn_[0][0], dn_[0][1]); w0_.y = cvtpk(dn_[0][2], dn_[0][3]); w0_.z = cvtpk(dn_[1][0], dn_[1][1]); w0_.w = cvtpk(dn_[1][2], dn_[1][3]); \
            w1_.x = cvtpk(dn_[2][0], dn_[2][1]); w1_.y = cvtpk(dn_[2][2], dn_[2][3]); w1_.z = cvtpk(dn_[3][0], dn_[3][1]); w1_.w = cvtpk(dn_[3][2], dn_[3][3]); \
            S0 = __builtin_bit_cast(bf16x8, w0_); S1 = __builtin_bit_cast(bf16x8, w1_); } \
        __syncthreads(); } while (0)
#pragma unroll 1
    for (int c = 0; c < NCHUNK; c += 6) { B_ITER(r1, c); B_ITER(r2, c + 1); B_ITER(r3, c + 2); B_ITER(r4, c + 3); B_ITER(r5, c + 4); B_ITER(r0, c + 5); }
#undef B_LD
#undef B_ST
#undef B_ITER
}
__device__ __forceinline__ void rwkv_chunkC_phase(Frame& F, const Args& A_, bool do_store) {
    const bf16* QTg = (const bf16*)(F.ws + WS_QT); bf16* Yg = (bf16*)((unsigned char*)F.out + DO_Y);
    const int lane = F.lane, r32 = lane & 31, hi = lane >> 5;
    const int gw = F.vcu * NWAVES + F.wave, NGW = F.G * NWAVES;
#pragma unroll 1
    for (int q = gw; q < 64 * (NCHUNK - 4); q += NGW) {
        const int cl = q >> 6, chain = q & 63, c = cl + 4, b = chain >> 4, h = (chain >> 1) & 7, d = chain & 1;
        const bf16* sp = ss_ptr(F, cl, chain); const bf16* qp = QTg + (size_t)q * 4096;
        bf16x8 af[2][4], bq[2][4];
#pragma unroll
        for (int t = 0; t < 2; ++t)
#pragma unroll
            for (int ks = 0; ks < 4; ++ks) { af[t][ks] = *(const bf16x8*)(sp + (size_t)(32 * t + r32) * 64 + 16 * ks + 8 * hi); bq[t][ks] = *(const bf16x8*)(qp + (size_t)(32 * t + r32) * 64 + 16 * ks + 8 * hi); }
#pragma unroll
        for (int ct = 0; ct < 2; ++ct) {
            bf16* yrow = Yg + ((size_t)d * ML + ROWOF(64 * c + 32 * ct + r32)) * 512 + h * 64;
#pragma unroll
            for (int rt = 0; rt < 2; ++rt) {
                f32x16 acc;
                { const v4u w0 = *(const v4u*)(yrow + 32 * rt + (hi ? 8 : 0)), w1 = *(const v4u*)(yrow + 32 * rt + 16 + (hi ? 8 : 0));
                  const v4u u0 = widen2((v2u){w0.x, w0.y}, (v2u){w0.z, w0.w}), u1 = widen2((v2u){w1.x, w1.y}, (v2u){w1.z, w1.w});
                  acc[0] = bf_lo(u0.x); acc[1] = bf_hi(u0.x); acc[2] = bf_lo(u0.y); acc[3] = bf_hi(u0.y); acc[4] = bf_lo(u0.z); acc[5] = bf_hi(u0.z); acc[6] = bf_lo(u0.w); acc[7] = bf_hi(u0.w);
                  acc[8] = bf_lo(u1.x); acc[9] = bf_hi(u1.x); acc[10] = bf_lo(u1.y); acc[11] = bf_hi(u1.y); acc[12] = bf_lo(u1.z); acc[13] = bf_hi(u1.z); acc[14] = bf_lo(u1.w); acc[15] = bf_hi(u1.w); }
#pragma unroll
                for (int ks = 0; ks < 4; ++ks) acc = mfma32(af[rt][ks], bq[ct][ks], acc);
                if (do_store) store_rows16(yrow + 32 * rt, pk4(acc[0], acc[1], acc[2], acc[3]), pk4(acc[4], acc[5], acc[6], acc[7]), pk4(acc[8], acc[9], acc[10], acc[11]), pk4(acc[12], acc[13], acc[14], acc[15]), hi);
                else asm volatile("" :: "v"(acc));
            }
        }
    }
}

__device__ __forceinline__ void rwkv_readout_phase(Frame& F, const Args& A_) {
    const bf16* ZS = (const bf16*)(F.ws + WS_ZS); const bf16* Y0 = (const bf16*)((unsigned char*)F.out + DO_Y); const bf16* Y1 = Y0 + (size_t)ML * 512;
    const bf16* GG = (const bf16*)((unsigned char*)F.out + DO_G); bf16* O = (bf16*)(F.ws + WS_ATTRW);
    const int gw = F.vcu * NWAVES + F.wave, NGW = F.G * NWAVES, ch = F.lane * 8;
    float rk[8], lg[8], lb[8];
#pragma unroll
    for (int e = 0; e < 8; ++e) { rk[e] = A_.in[I_RK][ch + e]; lg[e] = A_.in[I_LNG][ch + e]; lb[e] = A_.in[I_LNB][ch + e]; }
    for (int row = gw; row < ML; row += NGW) {
        const v4u y0 = *(const v4u*)(Y0 + (size_t)row * 512 + ch), y1 = *(const v4u*)(Y1 + (size_t)row * 512 + ch);
        const v4u rr = *(const v4u*)(ZS + (size_t)row * 1536 + ch), kk = *(const v4u*)(ZS + (size_t)row * 1536 + 512 + ch), vv = *(const v4u*)(ZS + (size_t)row * 1536 + 1024 + ch);
        const v4u gg = *(const v4u*)(GG + (size_t)row * 512 + ch);
        float y[8], s = 0.f, bs = 0.f;
#pragma unroll
        for (int e = 0; e < 4; ++e) { y[2 * e] = bf_lo(y0[e]) + bf_lo(y1[e]); y[2 * e + 1] = bf_hi(y0[e]) + bf_hi(y1[e]); s += y[2 * e] + y[2 * e + 1];
            bs += bf_lo(rr[e]) * bf_lo(kk[e]) * rk[2 * e] + bf_hi(rr[e]) * bf_hi(kk[e]) * rk[2 * e + 1]; }
        const float mean = sum8(s) * (1.f / 64.f); bs = sum8(bs);
        float q = 0.f;
#pragma unroll
        for (int e = 0; e < 8; ++e) { y[e] -= mean; q += y[e] * y[e]; }
        const float rstd = 1.f / sqrtf(sum8(q) * (1.f / 64.f) + GN_EPS);
        float o[8];
#pragma unroll
        for (int e = 0; e < 4; ++e) {
            o[2 * e] = (y[2 * e] * rstd * lg[2 * e] + lb[2 * e] + bs * bf_lo(vv[e])) * bf_lo(gg[e]);
            o[2 * e + 1] = (y[2 * e + 1] * rstd * lg[2 * e + 1] + lb[2 * e + 1] + bs * bf_hi(vv[e])) * bf_hi(gg[e]);
        }
        v4u w; w.x = pk2(o[0], o[1]); w.y = pk2(o[2], o[3]); w.z = pk2(o[4], o[5]); w.w = pk2(o[6], o[7]);
        *(v4u*)(O + (size_t)row * 1024 + 512 + ch) = w;
    }
}
#ifndef FFT_ABL
#define FFT_ABL 0
#endif
template <bool PASS_A> __device__ __forceinline__ void fft_col_phase(Frame& F, bool real_run = true) {
    const int abl = real_run ? 0 : FFT_ABL;
    constexpr int KC = PASS_A ? 64 : 128, K2 = 2 * KC, NU = 2048;
    constexpr int TCOLS = PASS_A ? 512 : 256, FP = TCOLS * 2 + 16, WP = K2 * 2 + 16, NT = PASS_A ? 4 : 2;
    const bf16* In = (const bf16*)(F.ws + (PASS_A ? WS_G1 : WS_Y1)); bf16* Out = (bf16*)(F.ws + (PASS_A ? WS_Y1 : WS_F1));
    const bf16* W = (const bf16*)(F.ws + (PASS_A ? WS_W2A : WS_W2B)); const float* tw = (const float*)(F.ws + WS_TW);
    LAS unsigned char* T = F.lds; LAS unsigned char* WL = F.lds + KC * FP;
    const int lane = F.lane, r32 = lane & 31, hi = lane >> 5, i16 = lane & 15, qd = i16 >> 2, pp = i16 & 3, c0 = lane & 16;
#ifndef WLDS
#define WLDS 2
#endif
    constexpr bool USE_WL = (WLDS >> (PASS_A ? 0 : 1)) & 1;
    __syncthreads();
    if (USE_WL) for (int it = F.tid; it < 128 * (K2 / 8); it += 512) { const int r = it / (K2 / 8), ch = it % (K2 / 8); *(LAS v4u*)(WL + r * WP + ch * 16) = *(const v4u*)(W + (size_t)r * K2 + ch * 8); }
    const int cw = PASS_A ? 32 * F.wave : 32 * (F.wave & 3), t0 = PASS_A ? 0 : 2 * (F.wave >> 2);
#ifndef FFT_PF
#define FFT_PF 3
#endif
    constexpr bool PF = (FFT_PF >> (PASS_A ? 0 : 1)) & 1;
    v4u pf[8];
#define FFT_DEC(u_, b, g, fix, half) do { b = (u_) >> 9; g = ((u_) >> 7) & 3; if (PASS_A) { fix = (u_) & 127; half = 0; } else { fix = ((u_) >> 1) & 63; half = (u_) & 1; } } while (0)
#define FFT_LD(u_) do { int b_, g_, f_, h_; FFT_DEC(u_, b_, g_, f_, h_); \
        _Pragma("unroll") for (int i = 0; i < 8; ++i) { const int it = F.tid + 512 * i; \
            if (PASS_A) { const int k = it >> 6, c16 = it & 63; pf[i] = *(const v4u*)(In + ((size_t)((b_ * 128 + f_) * 4 + g_) * 64 + k) * 512 + c16 * 8); } \
            else { const int k = it >> 5, c16 = it & 31, part = c16 >> 4, cc = c16 & 15; pf[i] = *(const v4u*)(In + ((size_t)((b_ * 64 + f_) * 4 + g_) * 128 + k) * 512 + part * 256 + h_ * 128 + cc * 8); } } } while (0)
#define FFT_ST() do { _Pragma("unroll") for (int i = 0; i < 8; ++i) { const int it = F.tid + 512 * i; const int k = PASS_A ? (it >> 6) : (it >> 5), c16 = PASS_A ? (it & 63) : (it & 31); *(LAS v4u*)(T + k * FP + c16 * 16) = pf[i]; } } while (0)
    if (F.vcu < NU) { FFT_LD(F.vcu); FFT_ST(); }
    for (int unit = F.vcu; unit < NU; unit += F.G) {
        int b, g, fix, half; FFT_DEC(unit, b, g, fix, half);
        const bool more = unit + F.G < NU;
        __syncthreads();
        if (PF && more && abl != 2) FFT_LD(unit + F.G);
        f32x16 acc[NT] = {};
        if (abl == 1) {} else if (!USE_WL) {
#pragma unroll 1
            for (int t = 0; t < NT; ++t) {
                bf16x8 wfr[K2 / 16];
#pragma unroll
                for (int ks = 0; ks < K2 / 16; ++ks) wfr[ks] = *(const bf16x8*)(W + (size_t)(32 * (t0 + t) + r32) * K2 + 16 * ks + 8 * hi);
                f32x16 a = {};
#pragma unroll
                for (int ks = 0; ks < K2 / 16; ++ks) {
                    const int part = (16 * ks) / KC, kb = (16 * ks) % KC;
                    const LAS unsigned char* tb = T + (kb + 8 * hi + qd) * FP + (part * (TCOLS / 2) + cw + c0 + 4 * pp) * 2;
                    a = mfma32(cat4(tr_read(tb), tr_read(tb + 4 * FP)), wfr[ks], a);
                }
                if (t == 0) acc[0] = a; else if (t == 1) acc[1] = a; else if (t == 2) acc[NT > 2 ? 2 : 0] = a; else acc[NT > 3 ? 3 : 0] = a;
            }
        } else {
#pragma unroll 8
        for (int ks = 0; ks < K2 / 16; ++ks) {
            const int part = (16 * ks) / KC, kb = (16 * ks) % KC;
            const LAS unsigned char* tb = T + (kb + 8 * hi + qd) * FP + (part * (TCOLS / 2) + cw + c0 + 4 * pp) * 2;
            const bf16x8 af = cat4(tr_read(tb), tr_read(tb + 4 * FP));
#pragma unroll
            for (int t = 0; t < NT; ++t) { const bf16x8 wf = *(const LAS bf16x8*)(WL + (32 * (t0 + t) + r32) * WP + (16 * ks + 8 * hi) * 2); acc[t] = mfma32(af, wf, acc[t]); }
        }
        }
        __syncthreads();
        constexpr int OP = PASS_A ? 1040 : 272;
        if (PASS_A) {
#pragma unroll
            for (int t = 0; t < 2; ++t) { const int l1p = 32 * t + r32; const int ti = (fix * l1p) & 8191; const float cs = tw[2 * ti], sn = tw[2 * ti + 1];
                LAS unsigned char* op = T + l1p * OP + cw * 2;
#pragma unroll
                for (int q4 = 0; q4 < 4; ++q4) { float re[4], im[4];
#pragma unroll
                    for (int e = 0; e < 4; ++e) { const float a = acc[t][4 * q4 + e], bq = acc[(t + 2) % NT][4 * q4 + e]; re[e] = a * cs + bq * sn; im[e] = bq * cs - a * sn; }
                    *(LAS v2u*)(op + (8 * q4 + 4 * hi) * 2) = pk4(re[0], re[1], re[2], re[3]); *(LAS v2u*)(op + 512 + (8 * q4 + 4 * hi) * 2) = pk4(im[0], im[1], im[2], im[3]); } }
        } else {
#pragma unroll
            for (int t = 0; t < 2; ++t) { LAS unsigned char* op = T + (32 * (t0 + t) + r32) * OP + cw * 2;
#pragma unroll
                for (int q4 = 0; q4 < 4; ++q4) *(LAS v2u*)(op + (8 * q4 + 4 * hi) * 2) = pk4(acc[t][4 * q4], acc[t][4 * q4 + 1], acc[t][4 * q4 + 2], acc[t][4 * q4 + 3]); }
        }
        __syncthreads();
        if (abl != 3) {
            if (PASS_A) {
#pragma unroll
                for (int i = 0; i < 8; ++i) { const int it = F.tid + 512 * i; const int row = it >> 6, c16 = it & 63;
                    *(v4u*)(Out + ((size_t)((b * 64 + row) * 4 + g) * 128 + fix) * 512 + c16 * 8) = *(const LAS v4u*)(T + row * OP + c16 * 16); }
            } else {
#pragma unroll
                for (int i = 0; i < 4; ++i) { const int it = F.tid + 512 * i; const int row = it >> 4, c16 = it & 15;
                    *(v4u*)(Out + ((size_t)((b * 64 + fix) * 128 + row) * 4 + g) * 256 + half * 128 + c16 * 8) = *(const LAS v4u*)(T + row * OP + c16 * 16); }
            }
        }
        __syncthreads();
        if (more) { if (!PF && abl != 2) FFT_LD(unit + F.G); FFT_ST(); }
    }
#undef FFT_DEC
#undef FFT_LD
#undef FFT_ST
}

__device__ __forceinline__ void fft_passA_fused_phase(Frame& F) {
    constexpr int XP = 528, TP = 1040, WP = 272, XO = 0, TO = 64 * XP, WO = TO + 64 * TP, NU = 2048;
    const bf16* XN = (const bf16*)(F.ws + WS_XN); bf16* Out = (bf16*)(F.ws + WS_Y1);
    const bf16* DFTC = (const bf16*)(F.ws + WS_DFTC); const bf16* W = (const bf16*)(F.ws + WS_W2A); const float* tw = (const float*)(F.ws + WS_TW);
    LAS unsigned char* X = F.lds + XO; LAS unsigned char* T = F.lds + TO; LAS unsigned char* WL = F.lds + WO;
    const int lane = F.lane, r32 = lane & 31, hi = lane >> 5, i16 = lane & 15, qd = i16 >> 2, pp = i16 & 3, c0 = lane & 16, w = F.wave, cw = 32 * w;
    __syncthreads();
    for (int it = F.tid; it < 128 * 16; it += 512) { const int r = it >> 4, ch = it & 15; *(LAS v4u*)(WL + r * WP + ch * 16) = *(const v4u*)(W + (size_t)r * 128 + ch * 8); }
    bf16x8 dfr[2][16];
#pragma unroll
    for (int t = 0; t < 2; ++t)
#pragma unroll
        for (int ks = 0; ks < 16; ++ks) dfr[t][ks] = *(const bf16x8*)(DFTC + (size_t)(64 * w + 32 * t + r32) * 256 + 16 * ks + 8 * hi);
    v4u px[4];
#define FA_LD(u_) do { const int b_ = (u_) >> 9, g_ = ((u_) >> 7) & 3, f_ = (u_) & 127; \
        _Pragma("unroll") for (int i = 0; i < 4; ++i) { const int it = F.tid + 512 * i; const int k = it >> 5, c16 = it & 31; px[i] = *(const v4u*)(XN + (size_t)(b_ * SEQ + k * 128 + f_) * 1024 + g_ * 256 + c16 * 8); } } while (0)
#define FA_ST() do { _Pragma("unroll") for (int i = 0; i < 4; ++i) { const int it = F.tid + 512 * i; const int k = it >> 5, c16 = it & 31; *(LAS v4u*)(X + k * XP + c16 * 16) = px[i]; } } while (0)
    if (F.vcu < NU) { FA_LD(F.vcu); FA_ST(); }
    for (int unit = F.vcu; unit < NU; unit += F.G) {
        const int b = unit >> 9, g = (unit >> 7) & 3, fix = unit & 127; const bool more = unit + F.G < NU;
        __syncthreads();
        if (more) FA_LD(unit + F.G);
        {
            f32x16 a2[2][2] = {};
#pragma unroll
            for (int ks = 0; ks < 16; ++ks) {
                const bf16x8 x0 = *(const LAS bf16x8*)(X + r32 * XP + (16 * ks + 8 * hi) * 2), x1 = *(const LAS bf16x8*)(X + (32 + r32) * XP + (16 * ks + 8 * hi) * 2);
#pragma unroll
                for (int t = 0; t < 2; ++t) { a2[t][0] = mfma32(dfr[t][ks], x0, a2[t][0]); a2[t][1] = mfma32(dfr[t][ks], x1, a2[t][1]); }
            }
#pragma unroll
            for (int t = 0; t < 2; ++t)
#pragma unroll
                for (int ct = 0; ct < 2; ++ct) { LAS unsigned char* tp = T + (32 * ct + r32) * TP + (64 * w + 32 * t) * 2;
#pragma unroll
                    for (int q4 = 0; q4 < 4; ++q4) *(LAS v2u*)(tp + (8 * q4 + 4 * hi) * 2) = pk4(a2[t][ct][4 * q4], a2[t][ct][4 * q4 + 1], a2[t][ct][4 * q4 + 2], a2[t][ct][4 * q4 + 3]); }
        }
        __syncthreads();
        if (more) FA_ST();
        f32x16 acc[4] = {};
#pragma unroll 2
        for (int ks = 0; ks < 8; ++ks) {
            const int part = ks >> 2, kb = (16 * ks) & 63;
            const LAS unsigned char* tb = T + (kb + 8 * hi + qd) * TP + (part * 256 + cw + c0 + 4 * pp) * 2;
            const bf16x8 af = cat4(tr_read(tb), tr_read(tb + 4 * TP));
#pragma unroll
            for (int t = 0; t < 4; ++t) acc[t] = mfma32(af, *(const LAS bf16x8*)(WL + (32 * t + r32) * WP + (16 * ks + 8 * hi) * 2), acc[t]);
        }
        __syncthreads();
#pragma unroll
        for (int t = 0; t < 2; ++t) { const int l1p = 32 * t + r32; const int ti = (fix * l1p) & 8191; const float cs = tw[2 * ti], sn = tw[2 * ti + 1];
            LAS unsigned char* op = T + l1p * TP + cw * 2;
#pragma unroll
            for (int q4 = 0; q4 < 4; ++q4) { float re[4], im[4];
#pragma unroll
                for (int e = 0; e < 4; ++e) { const float a = acc[t][4 * q4 + e], bq = acc[t + 2][4 * q4 + e]; re[e] = a * cs + bq * sn; im[e] = bq * cs - a * sn; }
                *(LAS v2u*)(op + (8 * q4 + 4 * hi) * 2) = pk4(re[0], re[1], re[2], re[3]); *(LAS v2u*)(op + 512 + (8 * q4 + 4 * hi) * 2) = pk4(im[0], im[1], im[2], im[3]); } }
        __syncthreads();
#pragma unroll
        for (int i = 0; i < 8; ++i) { const int it = F.tid + 512 * i; const int row = it >> 6, c16 = it & 63;
            *(v4u*)(Out + ((size_t)((b * 64 + row) * 4 + g) * 128 + fix) * 512 + c16 * 8) = *(const LAS v4u*)(T + row * TP + c16 * 16); }
    }
#undef FA_LD
#undef FA_ST
}

__global__ void __launch_bounds__(NWAVES * 64, 2) skel_fwd(Args A_) {
    extern __shared__ __attribute__((aligned(16))) unsigned char lds[];
    Frame F;
    F.lds = (LAS unsigned char*)lds;
    F.tid = threadIdx.x; F.lane = F.tid & 63; F.wave = __builtin_amdgcn_readfirstlane(F.tid >> 6);
    F.G = gridDim.x; { const int bx = blockIdx.x; F.vcu = (F.G % 8 == 0) ? (bx % 8) * (F.G / 8) + bx / 8 : bx; }
    F.ws = A_.ws; F.out = A_.out;
    cg::grid_group grid = cg::this_grid();
    { volatile LAS unsigned* misc = (volatile LAS unsigned*)(F.lds + MISC_OFF); if (F.tid < 16) misc[F.tid] = 0u; }
    __syncthreads();
    XcdBarrier bar = xcd_barrier_post((unsigned*)(F.ws + WS_BAR), (volatile LAS unsigned*)(F.lds + MISC_OFF));
#ifndef USE_CG
#define GSYNC() xcd_barrier(bar)
#else
#define GSYNC() grid.sync()
#endif
    const int lo = A_.ph_lo, hi = A_.ph_hi;
#ifndef PHMASK
#define PHMASK 0x7ffff
#endif
#define IN(k) (((PHMASK >> (k)) & 1) && lo <= (k) && (k) < hi)
#define SEAM(k) do { if (IN(k) && IN((k) + 1)) { if ((k) == 0) grid.sync(); else GSYNC(); } } while (0)
#ifndef REPMASK
#define REPMASK 0
#endif
#ifndef REPS
#define REPS 2
#endif
#define NREP(k) (((REPMASK >> (k)) & 1) ? REPS : 1)
#define PH(k) if (IN(k)) for (int rep_ = 0; rep_ < NREP(k); ++rep_, (rep_ < NREP(k) ? GSYNC() : (void)0))
#define LASTREP(k) (rep_ == NREP(k) - 1)
    const float* zero_gate = (const float*)(F.ws + WS_ZERO);
    const float* mod0 = (const float*)(F.ws + WS_MOD); const float* mod1 = mod0 + 5 * 6144;
    bf16* XN = (bf16*)(F.ws + WS_XN); bf16* XR = (bf16*)(F.ws + WS_XR);

    PH(0) { p0_prologue(F, A_); } SEAM(0);
    PH(1) { norm_phase(F, A_.in[I_X], A_.in[I_CTX], MALL, A_.in[I_N1G], mod0, 0, XN); } SEAM(1);
    PH(2) {
        pg8::Gemm g{XN, (const bf16*)(F.ws + WS_WIN), MALL, INCOLS, DM}; pg8::StaticOrder S; S.init(MALL, INCOLS, F.G, (int)blockIdx.x);
        pg8::EpiInProj E{(bf16*)(F.ws + WS_QKV), (bf16*)(F.ws + WS_ZR), (const float*)(F.ws + WS_ROPE)};
        pg8::gemm_phase<pg8::EpiInProj, pg8::StaticOrder, true, true>(F.lds, g, S, E);
    } SEAM(2);
    PH(3) { rwkv_prep_phase(F, A_); } SEAM(3);
    PH(4) { rwkv_chunkA_phase(F, A_); } if (IN(4)) GSYNC();
#ifndef TM
#define TM 0
#endif
#if TM == 3
    for (int i_ = 0; i_ < 20; ++i_) GSYNC();
#endif
#if TM == 4
    if (IN(4)) { if (F.vcu >= 64) attn_phase(F, A_, F.vcu - 64, F.G - 64); GSYNC(); }
#endif
#if TM == 6 || TM == 7
    if (IN(4)) { if (F.vcu < 64) rwkv_chunkB_phase(F, A_, TM - 5); GSYNC(); }
#endif
#if TM == 5
    if (IN(4)) { if (F.vcu < 64) rwkv_chunkB_phase(F, A_); GSYNC(); }
#endif
#if TM == 1
    if (IN(4)) { if (F.vcu < 64) rwkv_chunkB_phase(F, A_); else attn_phase(F, A_, F.vcu - 64, F.G - 64); GSYNC(); }
#endif
    if (IN(4)) { if (F.vcu < 64) rwkv_chunkB_phase(F, A_); else attn_phase(F, A_, F.vcu - 64, F.G - 64); GSYNC(); }
#if TM == 2
    if (IN(4)) { rwkv_chunkC_phase(F, A_, A_.ph_lo == 12345); GSYNC(); }
#endif
    if (IN(4)) { rwkv_chunkC_phase(F, A_, true); } SEAM(4);
    PH(5) { rwkv_readout_phase(F, A_); } SEAM(5);
    PH(6) {
        pg8::Gemm g{(const bf16*)(F.ws + WS_ATTRW), (const bf16*)(F.ws + WS_WOUT), ML, DM, DM}; pg8::StaticOrder S; S.init(ML, DM, F.G, (int)blockIdx.x);
        pg8::EpiResidualT<false, false, true> E{A_.in[I_X], XR, mod0 + 2048, 6144};
        pg8::gemm_phase<pg8::EpiResidualT<false, false, true>, pg8::StaticOrder, true, true>(F.lds, g, S, E);
    } SEAM(6);
    PH(7) { norm_bf16_phase(F, XR, A_.in[I_N2G], mod0, 3072, XN); } SEAM(7);
    PH(8) {
        pg8::Gemm g{XN, (const bf16*)(F.ws + WS_W1), ML, FF, DM}; pg8::StaticOrder S; S.init(ML, FF, F.G, (int)blockIdx.x);
        pg8::EpiStore<2> E{(bf16*)(F.ws + WS_H), FF};
        pg8::gemm_phase<pg8::EpiStore<2>, pg8::StaticOrder, true, true>(F.lds, g, S, E);
    } SEAM(8);
    PH(9) {
        pg8::Gemm g{(const bf16*)(F.ws + WS_H), (const bf16*)(F.ws + WS_W2), ML, DM, FF}; pg8::StaticOrder S; S.init(ML, DM, F.G, (int)blockIdx.x);
        pg8::EpiResidualT<false, true, true> E{XR, XR, LASTREP(9) ? mod0 + 5120 : zero_gate, LASTREP(9) ? 6144 : 0};
        pg8::gemm_phase<pg8::EpiResidualT<false, true, true>, pg8::StaticOrder, true, true>(F.lds, g, S, E);
    } SEAM(9);
    PH(10) { norm_bf16_phase(F, XR, A_.in[I_N1G] + DM, mod1, 0, XN); } SEAM(10);
    PH(12) { fft_passA_fused_phase(F); } SEAM(12);
    PH(13) { fft_col_phase<false>(F, LASTREP(13)); } SEAM(13);
    PH(14) {
        pg8::Gemm g{(const bf16*)(F.ws + WS_F1), (const bf16*)(F.ws + WS_WF), ML, DM, DM}; pg8::StaticOrder S; S.init(ML, DM, F.G, (int)blockIdx.x);
        pg8::EpiResidualT<true, true, true> E{XR, XR, LASTREP(14) ? mod1 + 2048 : zero_gate, LASTREP(14) ? 6144 : 0};
        pg8::gemm_phase<pg8::EpiResidualT<true, true, true>, pg8::StaticOrder, true, true>(F.lds, g, S, E);
    } SEAM(14);
    PH(15) { norm_bf16_phase(F, XR, A_.in[I_N2G] + DM, mod1, 3072, XN); } SEAM(15);
    PH(16) {
        pg8::Gemm g{XN, (const bf16*)(F.ws + WS_W1) + (size_t)DM * FF, ML, FF, DM}; pg8::StaticOrder S; S.init(ML, FF, F.G, (int)blockIdx.x);
        pg8::EpiStore<2> E{(bf16*)(F.ws + WS_H), FF};
        pg8::gemm_phase<pg8::EpiStore<2>, pg8::StaticOrder, true, true>(F.lds, g, S, E);
    } SEAM(16);
    PH(17) {
        pg8::Gemm g{(const bf16*)(F.ws + WS_H), (const bf16*)(F.ws + WS_W2) + (size_t)DM * FF, ML, DM, FF}; pg8::StaticOrder S; S.init(ML, DM, F.G, (int)blockIdx.x);
        pg8::EpiResidualT<false, true, false> E{XR, F.out, LASTREP(17) ? mod1 + 5120 : zero_gate, LASTREP(17) ? 6144 : 0};
        pg8::gemm_phase<pg8::EpiResidualT<false, true, false>, pg8::StaticOrder, true, true>(F.lds, g, S, E);
    } SEAM(17);
    PH(18) { final_norm_phase(F, F.out, A_.in[I_FING]); }
#undef IN
#undef SEAM
}

extern "C" void kernel_launch(void* const* d_in, const int* in_sizes, int n_in, void* d_out, int out_size, void* d_ws, size_t ws_size, hipStream_t stream) {
    static int grid = 0;
    if (grid == 0) {
        if (n_in != 27 || out_size != ML * DM || ws_size < WS_END) { fprintf(stderr, "kernel_launch: unexpected shapes: n_in %d out %d ws %zu\n", n_in, out_size, ws_size); grid = -1; return; }
        int dev = 0, cus = 0, per_cu = 0;
        (void)hipGetDevice(&dev); (void)hipDeviceGetAttribute(&cus, hipDeviceAttributeMultiprocessorCount, dev);
        (void)hipFuncSetAttribute((const void*)skel_fwd, hipFuncAttributeMaxDynamicSharedMemorySize, LDS_BYTES);
        (void)hipOccupancyMaxActiveBlocksPerMultiprocessor(&per_cu, (const void*)skel_fwd, NWAVES * 64, LDS_BYTES);
        (void)hipGetLastError();
        if (per_cu < 1) { fprintf(stderr, "kernel_launch: occupancy query reports %d\n", per_cu); }
        grid = cus;
    }
    if (grid < 0) return;
    if (hipMemsetAsync((char*)d_ws + WS_BAR, 0, 16384, stream) != hipSuccess) { fprintf(stderr, "kernel_launch: memset failed\n"); return; }
    Args a{};
    for (int i = 0; i < 27; ++i) a.in[i] = (const float*)d_in[i];
    a.out = (float*)d_out; a.ws = (unsigned char*)d_ws;
    if (MK_N_LAUNCHES == 1) {
        a.ph_lo = 0; a.ph_hi = N_PHASES;
        void* kargs[] = {&a};
        hipError_t e = hipLaunchCooperativeKernel((const void*)skel_fwd, dim3(grid), dim3(NWAVES * 64), kargs, LDS_BYTES, stream);
        if (e != hipSuccess) fprintf(stderr, "cooperative launch failed: %s (grid %d)\n", hipGetErrorString(e), grid);
    } else {
        for (int p = 0; p < N_PHASES; ++p) { a.ph_lo = p; a.ph_hi = p + 1; hipLaunchKernelGGL(skel_fwd, dim3(grid), dim3(NWAVES * 64), LDS_BYTES, stream, a); }
    }
}
```

```cpp
#include <hip/hip_runtime.h>
#include <hip/hip_cooperative_groups.h>
#include <cstdio>
#include <cstdint>
namespace cg = cooperative_groups;
namespace pg8 {
#define PG8_LAS __attribute__((address_space(3)))
typedef unsigned short bf16_t;
typedef short bf16x8 __attribute__((ext_vector_type(8)));
typedef float f32x4 __attribute__((ext_vector_type(4)));
typedef unsigned u32x4 __attribute__((ext_vector_type(4)));
constexpr int BM = 256, BK = 64, HALF = 128, HTB = HALF * BK * 2  , STAGE_BYTES = 8 * HTB, NXCD = 8, WGM = 8;

__host__ __device__ __forceinline__ int lds_byte(int r, int c) { const int st = (r >> 4) * 2 + (c >> 5), rr = r & 15, cc = c & 31, ob = rr * 64 + cc * 2; return st * 1024 + (ob ^ (((ob >> 9) & 1) << 5)); }
__host__ __device__ __forceinline__ void stage_rc(int b, int& R, int& C) { const int st = b / 1024, sb = b % 1024, swz = sb ^ (((sb >> 9) & 1) << 5); R = (st >> 1) * 16 + swz / 64; C = (st & 1) * 32 + (swz % 64) / 2; }
__host__ __device__ __forceinline__ int perm32(int rho) { const int n = rho >> 4, i = rho & 15; return 8 * (i >> 2) + 4 * n + (i & 3); }

struct Unit { int pm, pn; };
struct Gemm { const bf16_t* A; const bf16_t* Bt; int M, N, K; };

struct StaticOrder {
    int nM, nN, nwg, G, c;
    __host__ __device__ void init(int M, int N, int G_, int c_) { nM = M / BM; nN = N / BM; nwg = nM * nN; G = G_; c = c_; }
    __host__ __device__ bool next(int i, Unit& u) const {
        const long L = (long)i * G + c; if (L >= nwg) return false;
        int wgid = (int)L; { const int q = nwg / NXCD, r = nwg % NXCD, xcd = wgid % NXCD, off = wgid / NXCD; wgid = (xcd < r ? xcd * (q + 1) : r * (q + 1) + (xcd - r) * q) + off; }
        const int nig = WGM * nN, gid = wgid / nig, fm = gid * WGM, gsz = (nM - fm) < WGM ? (nM - fm) : WGM;
        u.pm = fm + ((wgid % nig) % gsz); u.pn = (wgid % nig) / gsz; return true;
    }
    __device__ __forceinline__ void a_ready(const Unit&) const {}
    __device__ __forceinline__ void done(const Unit&) const {}
};

__device__ __forceinline__ unsigned cvt_pk_bf16(float lo, float hi) { unsigned r; asm volatile("v_cvt_pk_bf16_f32 %0, %1, %2" : "=v"(r) : "v"(lo), "v"(hi)); return r; }
typedef float f32x2 __attribute__((ext_vector_type(2)));
__device__ __forceinline__ f32x2 gelu_pk(f32x2 v) {
    const f32x2 av = __builtin_elementwise_abs(v), d = av * 0.2316418882f + 1.0f;
    f32x2 t; t.x = __builtin_amdgcn_rcpf(d.x); t.y = __builtin_amdgcn_rcpf(d.y);
    f32x2 q = t * 0.5307027145f + (-0.7265760135f); q = q * t + 0.7107068705f; q = q * t + (-0.142248368f); q = q * t + 0.127414796f; q = q * t;
    const f32x2 s = (v * v) * (-0.72134752044f);
    f32x2 e; e.x = __builtin_amdgcn_exp2f(s.x); e.y = __builtin_amdgcn_exp2f(s.y);
    const f32x2 m = v * (q * e), r = v - m;
    f32x2 o; o.x = v.x < 0.f ? m.x : r.x; o.y = v.y < 0.f ? m.y : r.y; return o;
}

template <int ACT  > struct EpiBf16 {
    static constexpr bool PERM = true, AFTER_DRAIN = false; static_assert(ACT == 0 || ACT == 1, "EpiBf16: ACT is 0 (none) or 1 (gelu_pk)");
    bf16_t* O; int ldc; const float* bias; int split_cols; size_t split_stride; float scale0;
    __device__ __forceinline__ void operator()(const f32x4 (&acc)[2][2][4][2], const Unit& u, int wr, int wc, int fr, int fq) const {
        const int row0 = u.pm * BM + wr * 64 + fr; int colt = u.pn * BM; bf16_t* base = O;
        float sc = 1.f; if (split_cols) { const int t = colt / split_cols; base += (size_t)t * split_stride; colt -= t * split_cols; if (t == 0) sc = scale0; }
        const int col0 = colt + wc * 32 + 8 * fq, bcol0 = u.pn * BM + wc * 32 + 8 * fq;
        f32x4 bv[2][2];
#pragma unroll
        for (int bj = 0; bj < 2; ++bj)
#pragma unroll
            for (int n = 0; n < 2; ++n) bv[bj][n] = bias ? *(const f32x4*)(bias + bcol0 + bj * HALF + 4 * n) : (f32x4){0.f, 0.f, 0.f, 0.f};
#pragma unroll
        for (int ai = 0; ai < 2; ++ai)
#pragma unroll
            for (int m = 0; m < 4; ++m) { bf16_t* rowp = base + (size_t)(row0 + ai * HALF + m * 16) * ldc + col0;
#pragma unroll
                for (int bj = 0; bj < 2; ++bj) { f32x4 v0 = acc[ai][bj][m][0] + bv[bj][0], v1 = acc[ai][bj][m][1] + bv[bj][1];
                    if (ACT == 1) { f32x2 a = gelu_pk((f32x2){v0[0], v0[1]}), b = gelu_pk((f32x2){v0[2], v0[3]}), c = gelu_pk((f32x2){v1[0], v1[1]}), d = gelu_pk((f32x2){v1[2], v1[3]});
                        v0 = (f32x4){a.x, a.y, b.x, b.y}; v1 = (f32x4){c.x, c.y, d.x, d.y}; }
                    v0 = v0 * sc; v1 = v1 * sc; u32x4 w; w.x = cvt_pk_bf16(v0[0], v0[1]); w.y = cvt_pk_bf16(v0[2], v0[3]); w.z = cvt_pk_bf16(v1[0], v1[1]); w.w = cvt_pk_bf16(v1[2], v1[3]);
                    *(u32x4*)(rowp + bj * HALF) = w; } }
    }
};
typedef float f32x2e __attribute__((ext_vector_type(2)));
struct EpiInProj {
    static constexpr bool PERM = true, AFTER_DRAIN = false;
    bf16_t* QKV; bf16_t* ZR; const float* rope;
    __device__ __forceinline__ void operator()(const f32x4 (&acc)[2][2][4][2], const Unit& u, int wr, int wc, int fr, int fq) const {
        const int row0 = u.pm * BM + wr * 64 + fr; const int colt = u.pn * BM;
        if (colt >= 768) {
#pragma unroll
            for (int ai = 0; ai < 2; ++ai)
#pragma unroll
                for (int m = 0; m < 4; ++m) { bf16_t* rowp = ZR + (size_t)(row0 + ai * HALF + m * 16) * 1792 + (colt - 768) + wc * 32 + 8 * fq;
#pragma unroll
                    for (int bj = 0; bj < 2; ++bj) { const f32x4 v0 = acc[ai][bj][m][0], v1 = acc[ai][bj][m][1];
                        u32x4 w; w.x = cvt_pk_bf16(v0[0], v0[1]); w.y = cvt_pk_bf16(v0[2], v0[3]); w.z = cvt_pk_bf16(v1[0], v1[1]); w.w = cvt_pk_bf16(v1[2], v1[3]);
                        *(u32x4*)(rowp + bj * HALF) = w; } }
            return;
        }
        const bool latent = u.pm < 128;
        const int axis = wc & 1;
        const float sgn = (fq < 2) ? -1.f : 1.f;
#pragma unroll
        for (int ai = 0; ai < 2; ++ai)
#pragma unroll
            for (int m = 0; m < 4; ++m) {
                const int row = row0 + ai * HALF + m * 16; const int t = row & 8191; const int pos = axis ? (t & 63) : (t >> 6);
                f32x4 cs[4];
                if (latent) {
#pragma unroll
                    for (int i = 0; i < 4; ++i) cs[i] = *(const f32x4*)(rope + (size_t)(pos * 16 + 8 * (fq & 1) + 2 * i) * 2);
                }
                bf16_t* rowp = QKV + (size_t)row * 768 + colt + wc * 32 + 8 * fq;
#pragma unroll
                for (int bj = 0; bj < 2; ++bj) {
                    const int colb = colt + bj * HALF;
                    const bool is_v = (colb == 640), is_q = (colb < 512);
                    f32x4 v0 = acc[ai][bj][m][0], v1 = acc[ai][bj][m][1];
                    if (latent && !is_v) {
                        f32x4 o0, o1;
#pragma unroll
                        for (int e = 0; e < 4; ++e) { o0[e] = __shfl_xor(v0[e], 32); o1[e] = __shfl_xor(v1[e], 32); }
                        v0[0] = v0[0] * cs[0][0] + sgn * o0[0] * cs[0][1]; v0[1] = v0[1] * cs[0][2] + sgn * o0[1] * cs[0][3];
                        v0[2] = v0[2] * cs[1][0] + sgn * o0[2] * cs[1][1]; v0[3] = v0[3] * cs[1][2] + sgn * o0[3] * cs[1][3];
                        v1[0] = v1[0] * cs[2][0] + sgn * o1[0] * cs[2][1]; v1[1] = v1[1] * cs[2][2] + sgn * o1[1] * cs[2][3];
                        v1[2] = v1[2] * cs[3][0] + sgn * o1[2] * cs[3][1]; v1[3] = v1[3] * cs[3][2] + sgn * o1[3] * cs[3][3];
                    }
                    if (is_q) { v0 = v0 * 0.18033688011112042f; v1 = v1 * 0.18033688011112042f; }
                    u32x4 w; w.x = cvt_pk_bf16(v0[0], v0[1]); w.y = cvt_pk_bf16(v0[2], v0[3]); w.z = cvt_pk_bf16(v1[0], v1[1]); w.w = cvt_pk_bf16(v1[2], v1[3]);
                    *(u32x4*)(rowp + bj * HALF) = w;
                }
            }
    }
};
template <bool FFTROWS, bool BIN, bool BOUT> struct EpiResidualT {
    static constexpr bool PERM = true, AFTER_DRAIN = false;
    const void* base; void* out; const float* gate; int gate_stride;
    __device__ __forceinline__ void operator()(const f32x4 (&acc)[2][2][4][2], const Unit& u, int wr, int wc, int fr, int fq) const {
        const int row0 = u.pm * BM + wr * 64 + fr; const int col0 = u.pn * BM + wc * 32 + 8 * fq;
        const float* gp = gate + (size_t)(u.pm >> 5) * gate_stride + col0;
        f32x4 gv[2][2];
#pragma unroll
        for (int bj = 0; bj < 2; ++bj)
#pragma unroll
            for (int n = 0; n < 2; ++n) gv[bj][n] = *(const f32x4*)(gp + bj * HALF + n * 4);
#pragma unroll
        for (int ai = 0; ai < 2; ++ai)
#pragma unroll
            for (int m = 0; m < 4; ++m) { int row = row0 + ai * HALF + m * 16;
                if (FFTROWS) row = (row & ~8191) | ((row >> 7) & 63) | ((row & 127) << 6);
                const size_t off = (size_t)row * 1024 + col0;
#pragma unroll
                for (int bj = 0; bj < 2; ++bj) {
                    f32x4 b0, b1;
                    if (BIN) { const u32x4 w = *(const u32x4*)((const bf16_t*)base + off + bj * HALF);
                        b0 = (f32x4){__builtin_bit_cast(float, w.x << 16), __builtin_bit_cast(float, w.x & 0xffff0000u), __builtin_bit_cast(float, w.y << 16), __builtin_bit_cast(float, w.y & 0xffff0000u)};
                        b1 = (f32x4){__builtin_bit_cast(float, w.z << 16), __builtin_bit_cast(float, w.z & 0xffff0000u), __builtin_bit_cast(float, w.w << 16), __builtin_bit_cast(float, w.w & 0xffff0000u)}; }
                    else { b0 = *(const f32x4*)((const float*)base + off + bj * HALF); b1 = *(const f32x4*)((const float*)base + off + bj * HALF + 4); }
                    const f32x4 o0 = b0 + gv[bj][0] * acc[ai][bj][m][0], o1 = b1 + gv[bj][1] * acc[ai][bj][m][1];
                    if (BOUT) { u32x4 w; w.x = cvt_pk_bf16(o0[0], o0[1]); w.y = cvt_pk_bf16(o0[2], o0[3]); w.z = cvt_pk_bf16(o1[0], o1[1]); w.w = cvt_pk_bf16(o1[2], o1[3]); *(u32x4*)((bf16_t*)out + off + bj * HALF) = w; }
                    else { *(f32x4*)((float*)out + off + bj * HALF) = o0; *(f32x4*)((float*)out + off + bj * HALF + 4) = o1; }
                } }
    }
};
template <int ACT, bool FFTROWS = false> struct EpiStore {
    static constexpr bool PERM = true, AFTER_DRAIN = false;
    bf16_t* O; int ldc;
    __device__ __forceinline__ void operator()(const f32x4 (&acc)[2][2][4][2], const Unit& u, int wr, int wc, int fr, int fq) const {
        const int row0 = u.pm * BM + wr * 64 + fr; const int col0 = u.pn * BM + wc * 32 + 8 * fq;
#pragma unroll
        for (int ai = 0; ai < 2; ++ai)
#pragma unroll
            for (int m = 0; m < 4; ++m) { int row = row0 + ai * HALF + m * 16;
                if (FFTROWS) { const int g = row & 3, l = (row >> 2) & 8191, b = row >> 15; row = (((b * 128 + (l & 127)) * 4 + g) << 6) | (l >> 7); }
                bf16_t* rowp = O + (size_t)row * ldc + col0;
#pragma unroll
                for (int bj = 0; bj < 2; ++bj) { f32x4 v0 = acc[ai][bj][m][0], v1 = acc[ai][bj][m][1];
                    if (ACT == 2) {
#pragma unroll
                        for (int e = 0; e < 4; ++e) { const float a = fmaxf(v0[e], 0.f), b = fmaxf(v1[e], 0.f); v0[e] = a * a; v1[e] = b * b; }
                    }
                    u32x4 w; w.x = cvt_pk_bf16(v0[0], v0[1]); w.y = cvt_pk_bf16(v0[2], v0[3]); w.z = cvt_pk_bf16(v1[0], v1[1]); w.w = cvt_pk_bf16(v1[2], v1[3]);
                    *(u32x4*)(rowp + bj * HALF) = w; } }
    }
};
template <class Epi, class Sched, bool ALIGN_EPI = false, bool SP2 = false>
__device__ __forceinline__ void gemm_phase(PG8_LAS unsigned char* lds, const Gemm g, const Sched& S, const Epi& E) {
    const int tid = threadIdx.x, wid = __builtin_amdgcn_readfirstlane(tid >> 6), lane = tid & 63, wr = wid >> 2, wc = wid & 3, fr = lane & 15, fq = lane >> 4;
    int K_ = g.K; asm volatile("" : "+s"(K_)); const int K = K_, nt = K / BK;
    unsigned voffA[2], voffB[2];
#pragma unroll
    for (int i = 0; i < 2; ++i) { int R, C; stage_rc(tid * 16 + i * 8192, R, C); const int Rb = Epi::PERM ? ((R & ~31) + perm32(R & 31)) : R;
        voffA[i] = (unsigned)(R * K + C) * 2u; voffB[i] = (unsigned)(Rb * K + C) * 2u; }
    const size_t kstep = (size_t)(BK * 2);
    const size_t hstep = (size_t)HALF * K * 2;
    const size_t tstep = 2 * hstep;
    const unsigned ldsw = (unsigned)wid * 1024u;
    const int aoff = lds_byte(wr * 64 + fr, fq * 8), boff = lds_byte(wc * 32 + fr, fq * 8);
#define PG8_SA(b, h) (((b) * 2 + (h)) * HTB)
#define PG8_SB(b, h) ((4 + (b) * 2 + (h)) * HTB)
#define PG8_STAGE(bufoff, gbase, voff) do { _Pragma("unroll") for (int _i = 0; _i < 2; ++_i) \
        __builtin_amdgcn_global_load_lds((const unsigned*)((const char*)(gbase) + (voff)[_i]), (PG8_LAS unsigned*)(lds + (bufoff) + ldsw + _i * 8192), 16, 0, 0); } while (0)
#define PG8_LDA(dst, b, h) do { _Pragma("unroll") for (int m = 0; m < 4; ++m) _Pragma("unroll") for (int k = 0; k < 2; ++k) dst[m][k] = *(const PG8_LAS bf16x8*)(lds + PG8_SA(b, h) + aoff + m * 2048 + k * 1024); } while (0)
#define PG8_LDB(dst, b, h) do { _Pragma("unroll") for (int n = 0; n < 2; ++n) _Pragma("unroll") for (int k = 0; k < 2; ++k) dst[n][k] = *(const PG8_LAS bf16x8*)(lds + PG8_SB(b, h) + boff + n * 2048 + k * 1024); } while (0)
#define PG8_MMA(ai, bj, At, Bt) do { __builtin_amdgcn_s_setprio(1); _Pragma("unroll") for (int m = 0; m < 4; ++m) _Pragma("unroll") for (int n = 0; n < 2; ++n) _Pragma("unroll") for (int k = 0; k < 2; ++k) \
        acc[ai][bj][m][n] = __builtin_amdgcn_mfma_f32_16x16x32_bf16(Bt[n][k], At[m][k], acc[ai][bj][m][n], 0, 0, 0); __builtin_amdgcn_s_setprio(0); } while (0)
#define PG8_WAIT_V(n) asm volatile("s_waitcnt vmcnt(" #n ")" ::: "memory")
#define PG8_WAIT_L(n) asm volatile("s_waitcnt lgkmcnt(" #n ")" ::: "memory")
#define PG8_BAR __builtin_amdgcn_s_barrier()
#define PG8_SCHED __builtin_amdgcn_sched_barrier(0)
    Unit cur, nxt; int ui = 0;
    if (!S.next(0, cur)) return;
    f32x4 acc[2][2][4][2];
#pragma unroll
    for (int a = 0; a < 2; ++a)
#pragma unroll
        for (int b = 0; b < 2; ++b)
#pragma unroll
            for (int m = 0; m < 4; ++m)
#pragma unroll
                for (int n = 0; n < 2; ++n) acc[a][b][m][n] = (f32x4){0.f, 0.f, 0.f, 0.f};
    bf16x8 At[4][2], B0[2][2], B1[2][2];
    const char* cA = (const char*)g.A + (size_t)cur.pm * tstep; const char* cB = (const char*)g.Bt + (size_t)cur.pn * tstep;
    S.a_ready(cur);
    if constexpr (SP2) {
        PG8_STAGE(PG8_SB(0, 0), cB, voffB); PG8_STAGE(PG8_SB(0, 1), cB + hstep, voffB); PG8_STAGE(PG8_SA(0, 0), cA, voffA); PG8_STAGE(PG8_SA(0, 1), cA + hstep, voffA);
        if (wr == 1) PG8_BAR;
        PG8_WAIT_V(2); PG8_BAR;
        PG8_STAGE(PG8_SB(1, 0), cB + kstep, voffB); PG8_STAGE(PG8_SA(1, 0), cA + kstep, voffA); PG8_STAGE(PG8_SB(1, 1), cB + hstep + kstep, voffB);
        PG8_WAIT_V(6); PG8_BAR;
    } else {
        PG8_STAGE(PG8_SB(0, 0), cB, voffB); PG8_STAGE(PG8_SA(0, 0), cA, voffA); PG8_STAGE(PG8_SB(0, 1), cB + hstep, voffB); PG8_STAGE(PG8_SA(0, 1), cA + hstep, voffA);
        if (wr == 1) PG8_BAR;
        PG8_WAIT_V(4); PG8_BAR;
        PG8_STAGE(PG8_SB(1, 0), cB + kstep, voffB); PG8_STAGE(PG8_SA(1, 0), cA + kstep, voffA); PG8_STAGE(PG8_SB(1, 1), cB + hstep + kstep, voffB);
        PG8_WAIT_V(6); PG8_BAR;
    }
    for (;;) {
        const bool has_next = S.next(ui + 1, nxt);
        const char* nA = has_next ? (const char*)g.A + (size_t)nxt.pm * tstep : cA; const char* nB = has_next ? (const char*)g.Bt + (size_t)nxt.pn * tstep : cB;
        for (int t = 0; t < nt; t += 2) {
            const bool last = (t == nt - 2);
            const char* a1 = cA + (size_t)(t + 1) * kstep;
            const char* a2 = last ? nA : cA + (size_t)(t + 2) * kstep; const char* b2 = last ? nB : cB + (size_t)(t + 2) * kstep;
            const char* a3 = a2 + kstep; const char* b3 = b2 + kstep;
            if (last && has_next) S.a_ready(nxt);
            if constexpr (SP2) {
            PG8_LDB(B0, 0, 0); PG8_LDB(B1, 0, 1); PG8_SCHED; PG8_LDA(At, 0, 0); PG8_STAGE(PG8_SA(1, 1), a1 + hstep, voffA);
            PG8_WAIT_V(8); PG8_WAIT_L(0); PG8_BAR; PG8_MMA(0, 0, At, B0); PG8_MMA(0, 1, At, B1); PG8_BAR; PG8_SCHED;
            PG8_LDA(At, 0, 1); PG8_STAGE(PG8_SB(0, 0), b2, voffB); PG8_STAGE(PG8_SB(0, 1), b2 + hstep, voffB); PG8_STAGE(PG8_SA(0, 0), a2, voffA);
            PG8_WAIT_V(8); PG8_WAIT_L(0); PG8_BAR; PG8_MMA(1, 0, At, B0); PG8_MMA(1, 1, At, B1); PG8_BAR; PG8_SCHED;
            PG8_LDB(B0, 1, 0); PG8_LDB(B1, 1, 1); PG8_SCHED; PG8_LDA(At, 1, 0); PG8_STAGE(PG8_SA(0, 1), a2 + hstep, voffA);
            PG8_WAIT_V(8); PG8_WAIT_L(0); PG8_BAR; PG8_MMA(0, 0, At, B0); PG8_MMA(0, 1, At, B1); PG8_BAR; PG8_SCHED;
            PG8_LDA(At, 1, 1); PG8_STAGE(PG8_SB(1, 0), b3, voffB); PG8_STAGE(PG8_SB(1, 1), b3 + hstep, voffB); PG8_STAGE(PG8_SA(1, 0), a3, voffA);
            PG8_WAIT_V(8); PG8_WAIT_L(0); PG8_BAR; PG8_MMA(1, 0, At, B0); PG8_MMA(1, 1, At, B1); PG8_BAR; PG8_SCHED;
            } else {
            PG8_LDB(B0, 0, 0); PG8_SCHED; PG8_LDA(At, 0, 0); PG8_STAGE(PG8_SA(1, 1), a1 + hstep, voffA);
            PG8_WAIT_L(8); PG8_BAR; PG8_WAIT_L(0); PG8_MMA(0, 0, At, B0); PG8_BAR; PG8_SCHED;
            PG8_LDB(B1, 0, 1); PG8_STAGE(PG8_SB(0, 0), b2, voffB);
            PG8_BAR; PG8_WAIT_L(0); PG8_MMA(0, 1, At, B1); PG8_BAR;
            PG8_LDA(At, 0, 1); PG8_STAGE(PG8_SA(0, 0), a2, voffA);
            PG8_BAR; PG8_WAIT_L(0); PG8_MMA(1, 0, At, B0); PG8_BAR; PG8_SCHED;
            PG8_STAGE(PG8_SB(0, 1), b2 + hstep, voffB);
            PG8_WAIT_V(6); PG8_BAR; PG8_MMA(1, 1, At, B1); PG8_BAR;
            PG8_LDB(B0, 1, 0); PG8_SCHED; PG8_LDA(At, 1, 0); PG8_STAGE(PG8_SA(0, 1), a2 + hstep, voffA);
            PG8_WAIT_L(8); PG8_BAR; PG8_WAIT_L(0); PG8_MMA(0, 0, At, B0); PG8_BAR; PG8_SCHED;
            PG8_LDB(B1, 1, 1); PG8_STAGE(PG8_SB(1, 0), b3, voffB);
            PG8_BAR; PG8_WAIT_L(0); PG8_MMA(0, 1, At, B1); PG8_BAR;
            PG8_LDA(At, 1, 1); PG8_STAGE(PG8_SA(1, 0), a3, voffA);
            PG8_BAR; PG8_WAIT_L(0); PG8_MMA(1, 0, At, B0); PG8_BAR; PG8_SCHED;
            PG8_STAGE(PG8_SB(1, 1), b3 + hstep, voffB);
            PG8_WAIT_V(6); PG8_BAR; PG8_MMA(1, 1, At, B1); PG8_BAR;
            }
        }
        if constexpr (ALIGN_EPI) { if (wr == 0) PG8_BAR; }
        if constexpr (!Epi::AFTER_DRAIN) { E(acc, cur, wr, wc, fr, fq); S.done(cur); }
        if (!has_next) break;
#pragma unroll
        for (int a = 0; a < 2; ++a)
#pragma unroll
            for (int b = 0; b < 2; ++b)
#pragma unroll
                for (int m = 0; m < 4; ++m)
#pragma unroll
                    for (int n = 0; n < 2; ++n) acc[a][b][m][n] = (f32x4){0.f, 0.f, 0.f, 0.f};
        cur = nxt; cA = nA; cB = nB; ++ui;
        if constexpr (ALIGN_EPI) { if (wr == 1) PG8_BAR; }
    }
    PG8_WAIT_V(0);
    if constexpr (!ALIGN_EPI) { if (wr == 0) PG8_BAR; }
    PG8_BAR;
    if constexpr (Epi::AFTER_DRAIN) { E.fused(acc, cur, wr, wc, fr, fq, lds, wid, lane); S.done(cur); }
#undef PG8_SA
#undef PG8_SB
#undef PG8_STAGE
#undef PG8_LDA
#undef PG8_LDB
#undef PG8_MMA
#undef PG8_WAIT_V
#undef PG8_WAIT_L
#undef PG8_BAR
#undef PG8_SCHED
}
}
constexpr int NWAVES = 8;
constexpr int BATCH = 4, SEQ = 8192, DM = 1024, CTXL = 256, FF = 4096;
constexpr int ML = BATCH * SEQ;
constexpr int MC = BATCH * CTXL;
constexpr int MALL = ML + MC;
constexpr int INCOLS = 2560, RWC = 1792;
constexpr float NORM_EPS = 1e-6f, GN_EPS = 64e-5f;
#ifndef MK_N_LAUNCHES
#define MK_N_LAUNCHES 1
#endif
constexpr int N_PHASES = 19;

constexpr size_t MiB = 1u << 20;
constexpr size_t WS_MOD = 0;
constexpr size_t WS_ROPE = 256 * 1024;
constexpr size_t WS_TW = 320 * 1024;
constexpr size_t WS_DFTC = 384 * 1024;
constexpr size_t WS_W2A = 640 * 1024;
constexpr size_t WS_W2B = 704 * 1024;
constexpr size_t WS_LW2 = 768 * 1024;
constexpr size_t WS_LA2 = 896 * 1024;
constexpr size_t WS_LG2 = 1024 * 1024;
constexpr size_t WS_ZERO = 1152 * 1024;
constexpr size_t WS_INVN = 1280 * 1024;
constexpr size_t WS_BAR = 2400 * 1024;
constexpr size_t WS_WIN = 3 * MiB, WS_WOUT = 8 * MiB, WS_WF = 10 * MiB, WS_W1 = 12 * MiB  , WS_W2 = 28 * MiB  ;
constexpr size_t WS_XN = 44 * MiB;
constexpr size_t WS_QT = 44 * MiB;
constexpr size_t WS_QKV = 110 * MiB;
constexpr size_t WS_ZR = 160 * MiB;
constexpr size_t WS_MT = 160 * MiB;
constexpr size_t WS_NN = 226 * MiB;
constexpr size_t WS_LIN = 292 * MiB;
constexpr size_t WS_SS = 301 * MiB;
constexpr size_t WS_ZS = 340 * MiB;
constexpr size_t WS_ATTRW = 439 * MiB;
constexpr size_t WS_XR = 108 * MiB;
constexpr size_t WS_H = 172 * MiB;
constexpr size_t WS_G1 = 160 * MiB;
constexpr size_t WS_Y1 = 288 * MiB;
constexpr size_t WS_F1 = 416 * MiB;
constexpr size_t WS_END = 512 * MiB;
constexpr size_t DO_Y = 0, DO_G = 64 * MiB, DO_SS = 96 * MiB;

constexpr int RING_BYTES = 131072;
constexpr int LDS_BYTES = 151552;
constexpr int MISC_OFF = 150528;

#define GAS __attribute__((address_space(1)))
#define LAS __attribute__((address_space(3)))
typedef unsigned short bf16;
typedef unsigned v4u __attribute__((ext_vector_type(4)));
typedef unsigned v2u __attribute__((ext_vector_type(2)));
typedef float f32x4 __attribute__((ext_vector_type(4)));
typedef float f32x16 __attribute__((ext_vector_type(16)));
typedef short bf16x8 __attribute__((ext_vector_type(8)));
typedef short s16x4 __attribute__((ext_vector_type(4)));
#define LDS_WAIT() asm volatile("s_waitcnt lgkmcnt(0)" ::: "memory")
typedef float f32x2p __attribute__((ext_vector_type(2))); typedef __bf16 bf16x2p __attribute__((ext_vector_type(2)));
__device__ __forceinline__ unsigned pk2(float lo, float hi) { const f32x2p v = {lo, hi}; return __builtin_bit_cast(unsigned, __builtin_convertvector(v, bf16x2p)); }
__device__ __forceinline__ unsigned f2bf(float f) { return pk2(f, 0.f) & 0xffffu; }
__device__ __forceinline__ float bf_lo(unsigned u) { return __builtin_bit_cast(float, u << 16); }
__device__ __forceinline__ float bf_hi(unsigned u) { return __builtin_bit_cast(float, u & 0xffff0000u); }
__device__ __forceinline__ float bf1(bf16 u) { return __builtin_bit_cast(float, (unsigned)u << 16); }
__device__ __forceinline__ float wave_sum(float v) {
#pragma unroll
    for (int o = 1; o < 64; o <<= 1) v += __shfl_xor(v, o);
    return v;
}
template <int CTRL> __device__ __forceinline__ float dppf(float x) { return __builtin_bit_cast(float, __builtin_amdgcn_mov_dpp(__builtin_bit_cast(int, x), CTRL, 0xf, 0xf, true)); }
__device__ __forceinline__ float sum8(float x) { x += dppf<0xB1>(x); x += dppf<0x4E>(x); x += dppf<0x141>(x); return x; }
__device__ __forceinline__ float sigmoidf_(float x) { return __builtin_amdgcn_rcpf(1.f + __expf(-x)); }

typedef GAS unsigned gu32;
typedef GAS unsigned long long gu64;
#define RLX_AGENT __ATOMIC_RELAXED, __HIP_MEMORY_SCOPE_AGENT
#define XB_TMO      128
#define XB_XCNT(j)  (256  + 64 * (j))
#define XB_XSUB(j)  (1280 + 64 * (j))
#define XB_XGEN(j)  (2304 + 64 * (j))
#define XB_TOP      3328
#define XB_TOPGEN   3392
#define XCD_BAR_WORDS 3456
#define XB_SPIN_CAP (1u << 18)

__device__ __forceinline__ unsigned xb_ld(unsigned* p)              { return __hip_atomic_load(p, __ATOMIC_RELAXED, __HIP_MEMORY_SCOPE_AGENT); }
__device__ __forceinline__ unsigned xb_add(unsigned* p, unsigned v) { return __hip_atomic_fetch_add(p, v, __ATOMIC_RELAXED, __HIP_MEMORY_SCOPE_AGENT); }
__device__ __forceinline__ unsigned xb_xcc_id() { return (unsigned)__builtin_amdgcn_s_getreg((3 << 11) | 20) & 0xFu; }
#define XB_SPIN(cond, bar) do { unsigned _sp = 0; while (cond) { __builtin_amdgcn_s_sleep(1); \
    if ((++_sp & 255u) == 0u) { if (xb_ld(&(bar)[XB_TMO])) break; if (_sp > XB_SPIN_CAP) { atomicAdd(&(bar)[XB_TMO], 1u); break; } } } } while (0)

struct XcdBarrier {
    unsigned* bar; unsigned x;
    volatile LAS unsigned* st;
};

__device__ __forceinline__ XcdBarrier xcd_barrier_post(unsigned* bar, volatile LAS unsigned* st) {
    XcdBarrier b; b.bar = bar; b.x = xb_xcc_id(); b.st = st;
    if (threadIdx.x == 0) (void)xb_add(&bar[XB_XCNT(b.x)], 1u);
    return b;
}
__device__ __forceinline__ void xcd_barrier_complete(unsigned* bar, unsigned x, unsigned& nloc, unsigned& nx) {
    const unsigned G = gridDim.x * gridDim.y * gridDim.z;
    unsigned sum, cnt, mine, sp = 0u;
    for (;;) {
        sum = 0u; cnt = 0u; mine = 0u;
#pragma unroll
        for (unsigned j = 0; j < 16; ++j) { const unsigned c = xb_ld(&bar[XB_XCNT(j)]); sum += c; cnt += (c > 0u) ? 1u : 0u; mine = (j == x) ? c : mine; }
        if (sum == G) break;
        __builtin_amdgcn_s_sleep(1);
        if ((++sp & 255u) == 0u) { if (xb_ld(&bar[XB_TMO])) break; if (sp > XB_SPIN_CAP) { atomicAdd(&bar[XB_TMO], 1u); break; } }
    }
    nloc = mine > 0u ? mine : 1u; nx = cnt > 0u ? cnt : 1u;
}

__device__ __forceinline__ void xcd_barrier(const XcdBarrier& b) {
    asm volatile("s_waitcnt vmcnt(0)" ::: "memory");
    __syncthreads();
    if (threadIdx.x == 0) {
        unsigned* bar = b.bar;
        __builtin_amdgcn_s_waitcnt(0);
        unsigned nloc = b.st[0], nx = b.st[1];
        if (nloc == 0u) { xcd_barrier_complete(bar, b.x, nloc, nx); b.st[0] = nloc; b.st[1] = nx; }
        const unsigned old = xb_add(&bar[XB_XSUB(b.x)], 1u);
        const unsigned gen = old / nloc;
        if (old + 1u == (gen + 1u) * nloc) {
            __builtin_amdgcn_fence(__ATOMIC_RELEASE, "agent");
            asm volatile("s_waitcnt vmcnt(0)" ::: "memory");
            const unsigned og = xb_add(&bar[XB_TOP], 1u);
            const unsigned tg = og / nx;
            if (og + 1u == (tg + 1u) * nx) xb_add(&bar[XB_TOPGEN], 1u);
            else XB_SPIN(xb_ld(&bar[XB_TOPGEN]) == tg, bar);
            __builtin_amdgcn_fence(__ATOMIC_ACQUIRE, "agent");
            xb_add(&bar[XB_XGEN(b.x)], 1u);
            asm volatile("s_waitcnt vmcnt(0)" ::: "memory");
        } else {
            XB_SPIN(xb_ld(&bar[XB_XGEN(b.x)]) == gen, bar);
            __builtin_amdgcn_fence(__ATOMIC_ACQUIRE, "agent");
            asm volatile("s_waitcnt vmcnt(0)" ::: "memory");
        }
    }
    __syncthreads();
}

struct Frame {
    LAS unsigned char* lds;
    int tid, lane, wave, vcu, G;
    unsigned char* ws; float* out;
};
struct Args { const float* in[27]; float* out; unsigned char* ws; int ph_lo, ph_hi; };
enum { I_X = 0, I_C, I_CTX, I_CCTX, I_ADAW, I_ADAB, I_N1G, I_N2G, I_WIN, I_WOUT, I_SINK, I_MUP, I_MUN, I_DW0, I_DW2, I_IA0, I_IA2, I_GG2, I_KK, I_KA, I_RK, I_LNG, I_LNB, I_FW, I_W1, I_W2, I_FING };

__device__ __forceinline__ void p0_transpose_item(const float* W, int K, int N, bf16* WT, LAS float* scr, int item, int lane, float scale) {
    const int nblk = N / 32, kb = item / nblk, nb = item % nblk, k0 = 64 * kb, n0 = 32 * nb;
#pragma unroll 8
    for (int i = 0; i < 32; ++i) { const int kk = 2 * i + (lane >> 5); scr[kk * 33 + (lane & 31)] = W[(size_t)(k0 + kk) * N + n0 + (lane & 31)] * scale; }
    LDS_WAIT(); asm volatile("" ::: "memory");
    const int c = lane & 7;
#pragma unroll
    for (int j = 0; j < 4; ++j) { const int n = (lane >> 3) + 8 * j; const LAS float* s = scr + (8 * c) * 33 + n;
        v4u o; o.x = pk2(s[0 * 33], s[1 * 33]); o.y = pk2(s[2 * 33], s[3 * 33]); o.z = pk2(s[4 * 33], s[5 * 33]); o.w = pk2(s[6 * 33], s[7 * 33]);
        *(GAS v4u*)(WT + (size_t)(n0 + n) * K + k0 + 8 * c) = o; }
    LDS_WAIT(); asm volatile("" ::: "memory");
}
__device__ __forceinline__ void p0_prologue(Frame& F, const Args& A_) {
    LAS float* scr = (LAS float*)(F.lds + F.wave * 16384);
    const int gw = F.vcu * NWAVES + F.wave, NGW = F.G * NWAVES;
    constexpr int I_IN = 16 * 80, I_O = 16 * 32, I_U = 16 * 128, I_D = 64 * 32;
    constexpr int I_LW = 2 * 16, I_LG = 2 * 16;
    constexpr int NITEMS = I_IN + 2 * I_O + 2 * I_U + 2 * I_D + 2 * I_LW + I_LG;
    for (int it = gw; it < NITEMS; it += NGW) {
        int r = it;
        if (r < I_IN) { p0_transpose_item(A_.in[I_WIN], 1024, INCOLS, (bf16*)(F.ws + WS_WIN), scr, r, F.lane, 1.f); continue; } r -= I_IN;
        if (r < I_O) { p0_transpose_item(A_.in[I_WOUT], 1024, 1024, (bf16*)(F.ws + WS_WOUT), scr, r, F.lane, 1.f); continue; } r -= I_O;
        if (r < I_O) { p0_transpose_item(A_.in[I_FW], 1024, 1024, (bf16*)(F.ws + WS_WF), scr, r, F.lane, 1.f); continue; } r -= I_O;
        if (r < 2 * I_U) { const int l = r / I_U; p0_transpose_item(A_.in[I_W1] + (size_t)l * 1024 * FF, 1024, FF, (bf16*)(F.ws + WS_W1) + (size_t)l * 1024 * FF, scr, r % I_U, F.lane, 1.f); continue; } r -= 2 * I_U;
        if (r < 2 * I_D) { const int l = r / I_D; p0_transpose_item(A_.in[I_W2] + (size_t)l * 1024 * FF, FF, 1024, (bf16*)(F.ws + WS_W2) + (size_t)l * 1024 * FF, scr, r % I_D, F.lane, 1.f); continue; } r -= 2 * I_D;
        if (r < I_LW) { const int d = r / 16; p0_transpose_item(A_.in[I_DW2] + (size_t)d * 64 * 512, 64, 512, (bf16*)(F.ws + WS_LW2) + (size_t)d * 512 * 64, scr, r % 16, F.lane, 1.f); continue; } r -= I_LW;
        if (r < I_LW) { const int d = r / 16; p0_transpose_item(A_.in[I_IA2] + (size_t)d * 64 * 512, 64, 512, (bf16*)(F.ws + WS_LA2) + (size_t)d * 512 * 64, scr, r % 16, F.lane, 1.f); continue; } r -= I_LW;
        p0_transpose_item(A_.in[I_GG2], 128, 512, (bf16*)(F.ws + WS_LG2), scr, r, F.lane, 1.f);
    }
    const int gt = F.vcu * 512 + F.tid, NGT = F.G * 512;
    const float TWO_PI = 6.283185307179586f;
    for (int i = gt; i < 128 * 16; i += NGT) {
        const int pos = i >> 4, j = i & 15; const float inv = exp2f(-(float)j * (13.287712379549449f / 16.f));
        const float ang = (float)pos * inv; const float rev = ang * 0.15915494309189535f;
        float* o = (float*)(F.ws + WS_ROPE) + 2 * i; o[0] = __builtin_amdgcn_cosf(rev - floorf(rev)); o[1] = __builtin_amdgcn_sinf(rev - floorf(rev));
    }
    for (int i = gt; i < 8192; i += NGT) { const float rev = (float)i * (1.f / 8192.f); float* o = (float*)(F.ws + WS_TW) + 2 * i; o[0] = __builtin_amdgcn_cosf(rev); o[1] = __builtin_amdgcn_sinf(rev); }
    for (int i = gt; i < 512 * 256; i += NGT) {
        const int j = i >> 8, c = i & 255; const int ph = (c * (j & 255)) & 255; const float rev = (float)ph * (1.f / 256.f);
        const float v = (j < 256) ? __builtin_amdgcn_cosf(rev) : -__builtin_amdgcn_sinf(rev);
        ((bf16*)(F.ws + WS_DFTC))[i] = (bf16)f2bf(v * 0.0625f);
    }
    for (int i = gt; i < 128 * 128; i += NGT) {
        const int o = i >> 7, k = i & 127; const int pp = o >> 6, l1p = o & 63, p = k >> 6, l1 = k & 63; const float rev = (float)((l1 * l1p) & 63) * (1.f / 64.f);
        const float cs = __builtin_amdgcn_cosf(rev), sn = __builtin_amdgcn_sinf(rev);
        const float v = (pp == 0) ? (p == 0 ? cs : sn) : (p == 0 ? -sn : cs);
        ((bf16*)(F.ws + WS_W2A))[i] = (bf16)f2bf(v * 0.125f);
    }
    for (int i = gt; i < 128 * 256; i += NGT) {
        const int o = i >> 8, k = i & 255; const int p = k >> 7, l2 = k & 127; const float rev = (float)((l2 * o) & 127) * (1.f / 128.f);
        const float v = (p == 0) ? __builtin_amdgcn_cosf(rev) : __builtin_amdgcn_sinf(rev);
        ((bf16*)(F.ws + WS_W2B))[i] = (bf16)f2bf(v * 0.08838834764831845f);
    }
    for (int i = gt; i < 1024; i += NGT) ((float*)(F.ws + WS_ZERO))[i] = 0.f;
    {
        LAS float* sl = (LAS float*)(F.lds + 0);
        __syncthreads();
        for (int i = F.tid; i < 5 * 1024; i += 512) { const int r = i >> 10, k = i & 1023; const float cv = (r < 4) ? A_.in[I_C][r * 1024 + k] : A_.in[I_CCTX][k]; sl[i] = cv * sigmoidf_(cv); }
        __syncthreads();
        LAS float* red = (LAS float*)(F.lds + 32768);
        for (int item = F.vcu; item < 2 * 96; item += F.G) {
            const int layer = item / 96, n0 = (item % 96) * 64;
            const float* W = A_.in[I_ADAW] + (size_t)layer * 1024 * 6144 + n0 + F.lane;
            float a0 = 0.f, a1 = 0.f, a2 = 0.f, a3 = 0.f, a4 = 0.f;
            const int k0 = F.wave * 128;
#pragma unroll 8
            for (int k = k0; k < k0 + 128; ++k) { const float w = W[(size_t)k * 6144]; a0 += sl[k] * w; a1 += sl[1024 + k] * w; a2 += sl[2048 + k] * w; a3 += sl[3072 + k] * w; a4 += sl[4096 + k] * w; }
            red[(F.wave * 5 + 0) * 64 + F.lane] = a0; red[(F.wave * 5 + 1) * 64 + F.lane] = a1; red[(F.wave * 5 + 2) * 64 + F.lane] = a2; red[(F.wave * 5 + 3) * 64 + F.lane] = a3; red[(F.wave * 5 + 4) * 64 + F.lane] = a4;
            __syncthreads();
            if (F.tid < 320) { const int r = F.tid >> 6, l = F.tid & 63; float s = 0.f;
#pragma unroll
                for (int w = 0; w < 8; ++w) s += red[(w * 5 + r) * 64 + l];
                ((float*)(F.ws + WS_MOD))[(size_t)(layer * 5 + r) * 6144 + n0 + l] = s + A_.in[I_ADAB][layer * 6144 + n0 + l]; }
            __syncthreads();
        }
    }
}

__device__ __forceinline__ void norm_phase(Frame& F, const float* xl, const float* xc, int nrows, const float* g, const float* modl  , int sh_off, bf16* dst) {
    const int gw = F.vcu * NWAVES + F.wave, NGW = F.G * NWAVES;
    f32x4 gg[4];
#pragma unroll
    for (int j = 0; j < 4; ++j) gg[j] = *(const f32x4*)(g + 4 * F.lane + 256 * j);
    for (int m0 = gw; m0 < nrows; m0 += 2 * NGW) {
        const int m1 = m0 + NGW; const bool two = m1 < nrows; const int m1c = two ? m1 : m0;
        const float* xrow0 = (m0 < ML) ? xl + (size_t)m0 * DM : xc + (size_t)(m0 - ML) * DM;
        const float* xrow1 = (m1c < ML) ? xl + (size_t)m1c * DM : xc + (size_t)(m1c - ML) * DM;
        const GAS f32x4* xr0 = (const GAS f32x4*)xrow0 + F.lane; const GAS f32x4* xr1 = (const GAS f32x4*)xrow1 + F.lane;
        f32x4 v0[4], v1[4]; float s0 = 0.f, s1 = 0.f;
#pragma unroll
        for (int j = 0; j < 4; ++j) { v0[j] = xr0[64 * j]; v1[j] = xr1[64 * j]; }
#pragma unroll
        for (int j = 0; j < 4; ++j) { s0 += (v0[j].x * v0[j].x + v0[j].y * v0[j].y) + (v0[j].z * v0[j].z + v0[j].w * v0[j].w); s1 += (v1[j].x * v1[j].x + v1[j].y * v1[j].y) + (v1[j].z * v1[j].z + v1[j].w * v1[j].w); }
        const float rstd0 = 1.f / sqrtf(wave_sum(s0) * (1.f / DM) + NORM_EPS), rstd1 = 1.f / sqrtf(wave_sum(s1) * (1.f / DM) + NORM_EPS);
#pragma unroll
        for (int rr = 0; rr < 2; ++rr) {
            if (rr == 1 && !two) break;
            const int m = rr ? m1 : m0; const int r = (m < ML) ? (m >> 13) : 4; const float rstd = rr ? rstd1 : rstd0;
            const float* sh = modl + (size_t)r * 6144 + sh_off; const float* sc = sh + 1024;
            GAS unsigned long long* o8 = (GAS unsigned long long*)(dst + (size_t)m * DM) + F.lane;
#pragma unroll
            for (int j = 0; j < 4; ++j) { const int c = 4 * F.lane + 256 * j;
                const f32x4 a = *(const f32x4*)(sc + c), b = *(const f32x4*)(sh + c);
                const f32x4 o = ((rr ? v1[j] : v0[j]) * rstd * gg[j]) * (a + 1.f) + b;
                o8[64 * j] = (unsigned long long)pk2(o.x, o.y) | ((unsigned long long)pk2(o.z, o.w) << 32); }
        }
    }
}
__device__ __forceinline__ void norm_bf16_phase(Frame& F, const bf16* xr, const float* g, const float* modl, int sh_off, bf16* dst) {
    const int gw = F.vcu * NWAVES + F.wave, NGW = F.G * NWAVES; const int c0 = 16 * F.lane;
    f32x4 gg[4];
#pragma unroll
    for (int j = 0; j < 4; ++j) gg[j] = *(const f32x4*)(g + c0 + 4 * j);
    for (int m0 = gw; m0 < ML; m0 += 2 * NGW) {
        const int m1 = (m0 + NGW < ML) ? m0 + NGW : m0;
        v4u a0 = *(const v4u*)(xr + (size_t)m0 * DM + c0), a1 = *(const v4u*)(xr + (size_t)m0 * DM + c0 + 8), b0 = *(const v4u*)(xr + (size_t)m1 * DM + c0), b1 = *(const v4u*)(xr + (size_t)m1 * DM + c0 + 8);
#pragma unroll
        for (int rr = 0; rr < 2; ++rr) {
            if (rr == 1 && m1 == m0) break;
            const int m = rr ? m1 : m0; const v4u q0 = rr ? b0 : a0, q1 = rr ? b1 : a1;
            float v[16];
#pragma unroll
            for (int e = 0; e < 4; ++e) { v[2 * e] = bf_lo(q0[e]); v[2 * e + 1] = bf_hi(q0[e]); v[8 + 2 * e] = bf_lo(q1[e]); v[8 + 2 * e + 1] = bf_hi(q1[e]); }
            float s = 0.f;
#pragma unroll
            for (int e = 0; e < 16; ++e) s += v[e] * v[e];
            const float rstd = 1.f / sqrtf(wave_sum(s) * (1.f / DM) + NORM_EPS);
            const float* sh = modl + (size_t)(m >> 13) * 6144 + sh_off + c0; const float* sc = sh + 1024;
            v4u o0, o1;
#pragma unroll
            for (int j = 0; j < 4; ++j) { const f32x4 a = *(const f32x4*)(sc + 4 * j), b = *(const f32x4*)(sh + 4 * j);
                const f32x4 x = {v[4 * j], v[4 * j + 1], v[4 * j + 2], v[4 * j + 3]}; const f32x4 o = (x * rstd * gg[j]) * (a + 1.f) + b;
                if (j < 2) { o0[2 * j] = pk2(o.x, o.y); o0[2 * j + 1] = pk2(o.z, o.w); } else { o1[2 * (j - 2)] = pk2(o.x, o.y); o1[2 * (j - 2) + 1] = pk2(o.z, o.w); } }
            *(v4u*)(dst + (size_t)m * DM + c0) = o0; *(v4u*)(dst + (size_t)m * DM + c0 + 8) = o1;
        }
    }
}
__device__ __forceinline__ void final_norm_bf16_phase(Frame& F, const bf16* xr, float* out, const float* g) {
    const int gw = F.vcu * NWAVES + F.wave, NGW = F.G * NWAVES; const int c0 = 16 * F.lane;
    f32x4 gg[4];
#pragma unroll
    for (int j = 0; j < 4; ++j) gg[j] = *(const f32x4*)(g + c0 + 4 * j);
    for (int m0 = gw; m0 < ML; m0 += 2 * NGW) {
        const int m1 = (m0 + NGW < ML) ? m0 + NGW : m0;
        const v4u a0 = *(const v4u*)(xr + (size_t)m0 * DM + c0), a1 = *(const v4u*)(xr + (size_t)m0 * DM + c0 + 8), b0 = *(const v4u*)(xr + (size_t)m1 * DM + c0), b1 = *(const v4u*)(xr + (size_t)m1 * DM + c0 + 8);
#pragma unroll
        for (int rr = 0; rr < 2; ++rr) {
            if (rr == 1 && m1 == m0) break;
            const int m = rr ? m1 : m0; const v4u q0 = rr ? b0 : a0, q1 = rr ? b1 : a1;
            float v[16];
#pragma unroll
            for (int e = 0; e < 4; ++e) { v[2 * e] = bf_lo(q0[e]); v[2 * e + 1] = bf_hi(q0[e]); v[8 + 2 * e] = bf_lo(q1[e]); v[8 + 2 * e + 1] = bf_hi(q1[e]); }
            float s = 0.f;
#pragma unroll
            for (int e = 0; e < 16; ++e) s += v[e] * v[e];
            const float rstd = 1.f / sqrtf(wave_sum(s) * (1.f / DM) + NORM_EPS);
            GAS f32x4* o = (GAS f32x4*)(out + (size_t)m * DM + c0);
#pragma unroll
            for (int j = 0; j < 4; ++j) { const f32x4 x = {v[4 * j], v[4 * j + 1], v[4 * j + 2], v[4 * j + 3]}; o[j] = x * rstd * gg[j]; }
        }
    }
}
__device__ __forceinline__ void final_norm_phase(Frame& F, float* x, const float* g) {
    const int gw = F.vcu * NWAVES + F.wave, NGW = F.G * NWAVES;
    for (int m = gw; m < ML; m += NGW) {
        GAS f32x4* xr = (GAS f32x4*)(x + (size_t)m * DM) + F.lane;
        f32x4 v[4]; float s = 0.f;
#pragma unroll
        for (int j = 0; j < 4; ++j) { v[j] = xr[64 * j]; s += (v[j].x * v[j].x + v[j].y * v[j].y) + (v[j].z * v[j].z + v[j].w * v[j].w); }
        const float rstd = 1.f / sqrtf(wave_sum(s) * (1.f / DM) + NORM_EPS);
#pragma unroll
        for (int j = 0; j < 4; ++j) { const f32x4 gg = *(const f32x4*)(g + 4 * F.lane + 256 * j); xr[64 * j] = v[j] * rstd * gg; }
    }
}
__device__ __forceinline__ f32x16 mfma32(bf16x8 a, bf16x8 b, f32x16 c) { return __builtin_amdgcn_mfma_f32_32x32x16_bf16(a, b, c, 0, 0, 0); }
__device__ __forceinline__ s16x4 tr_read(const LAS unsigned char* p) { return __builtin_bit_cast(s16x4, __builtin_amdgcn_ds_read_tr16_b64_v4i16((LAS s16x4*)p)); }
__device__ __forceinline__ bf16x8 cat4(s16x4 lo, s16x4 hi) { return (bf16x8){lo[0], lo[1], lo[2], lo[3], hi[0], hi[1], hi[2], hi[3]}; }
typedef float f32x2c __attribute__((ext_vector_type(2))); typedef __bf16 bf16x2c __attribute__((ext_vector_type(2)));
__device__ __forceinline__ unsigned cvtpk(float lo, float hi) { const f32x2c v = {lo, hi}; const bf16x2c b = __builtin_convertvector(v, bf16x2c); return __builtin_bit_cast(unsigned, b); }
__device__ __forceinline__ float swap32(float x) { auto rr = __builtin_amdgcn_permlane32_swap(__float_as_uint(x), __float_as_uint(x), false, false); return __uint_as_float((threadIdx.x & 32) ? rr[0] : rr[1]); }
__device__ __forceinline__ v4u widen2(v2u a, v2u b) { auto r0 = __builtin_amdgcn_permlane32_swap(a.x, b.x, false, false); auto r1 = __builtin_amdgcn_permlane32_swap(a.y, b.y, false, false); return (v4u){r0[0], r1[0], r0[1], r1[1]}; }
__device__ __forceinline__ void store_rows16(bf16* base, v2u g0, v2u g1, v2u g2, v2u g3, int hi) {
    const v4u w0 = widen2(g0, g1), w1 = widen2(g2, g3);
    *(v4u*)(base + (hi ? 8 : 0)) = w0; *(v4u*)(base + 16 + (hi ? 8 : 0)) = w1;
}
__device__ __forceinline__ v2u pk4(float a, float b, float c, float d) { v2u w; w.x = cvtpk(a, b); w.y = cvtpk(c, d); return w; }
__device__ __forceinline__ bf16x8 pack8(const f32x16& p, int b) {
    v4u w; w.x = cvtpk(p[b + 0], p[b + 1]); w.y = cvtpk(p[b + 2], p[b + 3]); w.z = cvtpk(p[b + 4], p[b + 5]); w.w = cvtpk(p[b + 6], p[b + 7]);
    return __builtin_bit_cast(bf16x8, w);
}
constexpr int KP = 144;
__device__ __forceinline__ void attn_phase(Frame& F, const Args& A_, int ufirst, int ustride) {
    const bf16* QKV = (const bf16*)(F.ws + WS_QKV); bf16* O = (bf16*)(F.ws + WS_ATTRW);
    const int lane = F.lane, r32 = lane & 31, hi = lane >> 5;
    const int g = F.wave & 3, half = F.wave >> 2;
    const int skey = F.tid >> 3, sch = F.tid & 7;
    for (int unit = ufirst; unit < 1024; unit += ustride) {
        const int b = unit >> 8, kvh = (unit >> 7) & 1, qb = unit & 127, s0 = qb * 64;
        const int head = kvh * 4 + g; const int tq = s0 + half * 32 + r32;
        const int lo = 4 + (qb < 2 ? 2 - qb : 0), hiT = 8 - (qb > 125 ? qb - 125 : 0);
        const bf16* qrow = QKV + (size_t)(b * SEQ + tq) * 768 + head * 64;
        bf16x8 qf[4];
#pragma unroll
        for (int s = 0; s < 4; ++s) qf[s] = *(const bf16x8*)(qrow + 16 * s + 8 * hi);
        float m = A_.in[I_SINK][head] * 1.4426950408889634f, l = (hi == 0) ? 1.f : 0.f;
        f32x16 o0 = {}, o1 = {};
        const bf16* kvbase = QKV + 512 + kvh * 64 + sch * 8;
#define KROW0(t) (((t) < 4) ? (ML + b * CTXL + (t) * 64) : (b * SEQ + s0 - 128 + ((t) - 4) * 64))
        v4u pk_, pv_;
        { const bf16* kp = kvbase + (size_t)(KROW0(0) + skey) * 768; pk_ = *(const v4u*)kp; pv_ = *(const v4u*)(kp + 128); }
        __syncthreads();
        *(LAS v4u*)(F.lds + skey * KP + sch * 16) = pk_; *(LAS v4u*)(F.lds + 64 * KP + skey * KP + sch * 16) = pv_;
        __syncthreads();
        int buf = 0;
        for (int tile = 0;;) {
            const int nxt = (tile == 3) ? lo : tile + 1; const bool more = tile != hiT;
            if (more) { const bf16* kp = kvbase + (size_t)(KROW0(nxt) + skey) * 768; pk_ = *(const v4u*)kp; pv_ = *(const v4u*)(kp + 128); }
            const LAS unsigned char* Ks = F.lds + buf * (128 * KP); const LAS unsigned char* Vs = Ks + 64 * KP;
            f32x16 p0 = {}, p1 = {};
#pragma unroll
            for (int s = 0; s < 4; ++s) {
                const bf16x8 a0 = *(const LAS bf16x8*)(Ks + r32 * KP + (16 * s + 8 * hi) * 2);
                const bf16x8 a1 = *(const LAS bf16x8*)(Ks + (32 + r32) * KP + (16 * s + 8 * hi) * 2);
                p0 = mfma32(a0, qf[s], p0); p1 = mfma32(a1, qf[s], p1);
            }
            if (tile == 4 || tile == 8) {
                const int ks = s0 - 128 + (tile - 4) * 64;
#pragma unroll
                for (int r = 0; r < 16; ++r) { const int key = (r & 3) + 8 * (r >> 2) + 4 * hi; const int d0 = tq - (ks + key), d1 = d0 - 32;
                    if (d0 > 128 || d0 < -128) p0[r] = -INFINITY; if (d1 > 128 || d1 < -128) p1[r] = -INFINITY; }
            }
            float mx = fmaxf(p0[0], p1[0]);
#pragma unroll
            for (int r = 1; r < 16; ++r) mx = fmaxf(mx, fmaxf(p0[r], p1[r]));
            { auto rr = __builtin_amdgcn_permlane32_swap(__float_as_uint(mx), __float_as_uint(mx), false, false); mx = fmaxf(__uint_as_float(rr[0]), __uint_as_float(rr[1])); }
            const float mn = fmaxf(m, mx), alpha = __builtin_amdgcn_exp2f(m - mn); m = mn;
            float ls = 0.f;
#pragma unroll
            for (int r = 0; r < 16; ++r) { p0[r] = __builtin_amdgcn_exp2f(p0[r] - mn); p1[r] = __builtin_amdgcn_exp2f(p1[r] - mn); ls += p0[r] + p1[r]; }
            l = l * alpha + ls;
            if (__any(alpha != 1.f)) {
#pragma unroll
                for (int r = 0; r < 16; ++r) { o0[r] *= alpha; o1[r] *= alpha; }
            }
            const bf16x8 pb0 = pack8(p0, 0), pb1 = pack8(p0, 8), pb2 = pack8(p1, 0), pb3 = pack8(p1, 8);
            const int i16 = lane & 15, qd = i16 >> 2, pp = i16 & 3, c0 = lane & 16;
            const LAS unsigned char* vb = Vs + (4 * hi + qd) * KP + (c0 + 4 * pp) * 2;
#define PVSTEP(s, pb) do { \
                const bf16x8 va0 = cat4(tr_read(vb + (16 * (s)) * KP), tr_read(vb + (16 * (s) + 8) * KP)); \
                const bf16x8 va1 = cat4(tr_read(vb + (16 * (s)) * KP + 64), tr_read(vb + (16 * (s) + 8) * KP + 64)); \
                o0 = mfma32(va0, pb, o0); o1 = mfma32(va1, pb, o1); } while (0)
            PVSTEP(0, pb0); PVSTEP(1, pb1); PVSTEP(2, pb2); PVSTEP(3, pb3);
#undef PVSTEP
            if (!more) break;
            buf ^= 1;
            *(LAS v4u*)(F.lds + buf * (128 * KP) + skey * KP + sch * 16) = pk_; *(LAS v4u*)(F.lds + buf * (128 * KP) + 64 * KP + skey * KP + sch * 16) = pv_;
            __syncthreads();
            tile = nxt;
        }
#undef KROW0
        { auto rr = __builtin_amdgcn_permlane32_swap(__float_as_uint(l), __float_as_uint(l), false, false); l = __uint_as_float(rr[0]) + __uint_as_float(rr[1]); }
        const float inv = __builtin_amdgcn_rcpf(l);
        bf16* orow = O + (size_t)(b * SEQ + tq) * 1024 + head * 64;
        store_rows16(orow, pk4(o0[0] * inv, o0[1] * inv, o0[2] * inv, o0[3] * inv), pk4(o0[4] * inv, o0[5] * inv, o0[6] * inv, o0[7] * inv), pk4(o0[8] * inv, o0[9] * inv, o0[10] * inv, o0[11] * inv), pk4(o0[12] * inv, o0[13] * inv, o0[14] * inv, o0[15] * inv), hi);
        store_rows16(orow + 32, pk4(o1[0] * inv, o1[1] * inv, o1[2] * inv, o1[3] * inv), pk4(o1[4] * inv, o1[5] * inv, o1[6] * inv, o1[7] * inv), pk4(o1[8] * inv, o1[9] * inv, o1[10] * inv, o1[11] * inv), pk4(o1[12] * inv, o1[13] * inv, o1[14] * inv, o1[15] * inv), hi);
    }
}

constexpr int AP3 = 272;
__device__ __forceinline__ void rwkv_prep_phase(Frame& F, const Args& A_) {
    const bf16* ZR = (const bf16*)(F.ws + WS_ZR); bf16* ZS = (bf16*)(F.ws + WS_ZS); float* INVN = (float*)(F.ws + WS_INVN);
    bf16* LIN = (bf16*)(F.ws + WS_LIN); bf16* GG = (bf16*)((unsigned char*)F.out + DO_G);
    const bf16* G2T = (const bf16*)(F.ws + WS_LG2);
    LAS unsigned char* A3 = F.lds;
    const float* mup = A_.in[I_MUP]; const float* mun = A_.in[I_MUN]; const float* kkw = A_.in[I_KK];
    const int lane = F.lane, r32 = lane & 31, hi = lane >> 5;
    const int pch = F.tid & 255, pth = F.tid >> 8, pcol = pch * 8; const bool pact = pch < 224;
    f32x4 mp0 = {}, mp1 = {}, mn0 = {}, mn1 = {}, kc0 = {}, kc1 = {};
    if (pact) { mp0 = *(const f32x4*)(mup + pcol); mp1 = *(const f32x4*)(mup + pcol + 4); mn0 = *(const f32x4*)(mun + pcol); mn1 = *(const f32x4*)(mun + pcol + 4); }
    if (pch >= 64 && pch < 128) { kc0 = *(const f32x4*)(kkw + pcol - 512); kc1 = *(const f32x4*)(kkw + pcol - 508); }
    bf16x8 g2f0[8], g2f1[8];
#pragma unroll
    for (int s = 0; s < 8; ++s) { g2f0[s] = *(const bf16x8*)(G2T + (size_t)(F.wave * 64 + r32) * 128 + 16 * s + 8 * hi); g2f1[s] = *(const bf16x8*)(G2T + (size_t)(F.wave * 64 + 32 + r32) * 128 + 16 * s + 8 * hi); }
    for (int unit = F.vcu; unit < MALL / 32; unit += F.G) {
        const int R0 = unit * 32;
        __syncthreads();
        {
            const int Rt = R0 + 16 * pth;
            const int seqlen = (R0 < ML) ? SEQ : CTXL; const int pos0 = (R0 < ML) ? (Rt & (SEQ - 1)) : ((Rt - ML) & (CTXL - 1));
            v4u zz[18];
#pragma unroll
            for (int i = 0; i < 18; ++i) { const int p = pos0 + i - 1; zz[i] = (v4u){0u, 0u, 0u, 0u}; if (pact && p >= 0 && p < seqlen) zz[i] = *(const v4u*)(ZR + (size_t)(Rt + i - 1) * RWC + pcol); }
#pragma unroll
            for (int i = 0; i < 16; ++i) {
                const int tk = 16 * pth + i, row = Rt + i, ch = pch, col = pcol;
                const v4u zp = zz[i], zc = zz[i + 1], zn = zz[i + 2];
                float z[8];
#pragma unroll
                for (int e = 0; e < 4; ++e) {
                    const float c0 = bf_lo(zc[e]), c1 = bf_hi(zc[e]), p0 = bf_lo(zp[e]), p1 = bf_hi(zp[e]), n0 = bf_lo(zn[e]), n1 = bf_hi(zn[e]);
                    const float a0 = (2 * e < 4) ? mp0[2 * e] : mp1[2 * e - 4], a1 = (2 * e + 1 < 4) ? mp0[2 * e + 1] : mp1[2 * e - 3];
                    const float b0 = (2 * e < 4) ? mn0[2 * e] : mn1[2 * e - 4], b1 = (2 * e + 1 < 4) ? mn0[2 * e + 1] : mn1[2 * e - 3];
                    z[2 * e] = c0 + a0 * (p0 - c0) + b0 * (n0 - c0); z[2 * e + 1] = c1 + a1 * (p1 - c1) + b1 * (n1 - c1);
                }
                if (ch < 192) {
                    v4u w; w.x = pk2(z[0], z[1]); w.y = pk2(z[2], z[3]); w.z = pk2(z[4], z[5]); w.w = pk2(z[6], z[7]);
                    *(v4u*)(ZS + (size_t)row * 1536 + col) = w;
                }
                {
                    float ss = 0.f;
#pragma unroll
                    for (int e = 0; e < 4; ++e) { const float a = z[e] * kc0[e], b = z[4 + e] * kc1[e]; ss += a * a + b * b; }
                    ss = sum8(ss);
                    if (ch >= 64 && ch < 128 && (ch & 7) == 0) INVN[(size_t)row * 8 + ((ch - 64) >> 3)] = 1.f / sqrtf(ss + 1e-12f);
                }
                if (ch >= 192 && pact) {
                    v4u w;
                    if (ch < 200) {
                        float t[8];
#pragma unroll
                        for (int e = 0; e < 8; ++e) { const float ex = __expf(-2.f * fabsf(z[e])); const float th = (1.f - ex) * __builtin_amdgcn_rcpf(1.f + ex); t[e] = z[e] < 0.f ? -th : th; }
                        w.x = pk2(t[0], t[1]); w.y = pk2(t[2], t[3]); w.z = pk2(t[4], t[5]); w.w = pk2(t[6], t[7]);
                        *(v4u*)(LIN + (size_t)row * 128 + (ch - 192) * 8) = w;
                    } else if (ch < 208) {
                        w.x = pk2(z[0], z[1]); w.y = pk2(z[2], z[3]); w.z = pk2(z[4], z[5]); w.w = pk2(z[6], z[7]);
                        *(v4u*)(LIN + (size_t)row * 128 + 64 + (ch - 200) * 8) = w;
                    } else {
                        float t[8];
#pragma unroll
                        for (int e = 0; e < 8; ++e) t[e] = __builtin_amdgcn_rcpf(1.f + __expf(-z[e]));
                        w.x = pk2(t[0], t[1]); w.y = pk2(t[2], t[3]); w.z = pk2(t[4], t[5]); w.w = pk2(t[6], t[7]);
                        *(LAS v4u*)(A3 + tk * AP3 + (ch - 208) * 16) = w;
                    }
                }
            }
        }
        __syncthreads();
        if (R0 < ML) {
#pragma unroll
            for (int t = 0; t < 2; ++t) {
                const int n0 = F.wave * 64 + t * 32; f32x16 acc = {};
#pragma unroll
                for (int s = 0; s < 8; ++s) acc = mfma32(t ? g2f1[s] : g2f0[s], *(const LAS bf16x8*)(A3 + r32 * AP3 + (16 * s + 8 * hi) * 2), acc);
                store_rows16(GG + (size_t)(R0 + r32) * 512 + n0, pk4(acc[0], acc[1], acc[2], acc[3]), pk4(acc[4], acc[5], acc[6], acc[7]), pk4(acc[8], acc[9], acc[10], acc[11]), pk4(acc[12], acc[13], acc[14], acc[15]), hi);
            }
        }
    }
}

#ifndef AREPMASK
#define AREPMASK 0
#endif
#ifndef AREPS
#define AREPS 5
#endif
#if AREPMASK
#define ALOOP(k) for (int ar_ = 0; ar_ < (((AREPMASK >> (k)) & 1) ? AREPS : 1); ++ar_, __syncthreads())
#else
#define ALOOP(k)
#endif
constexpr int SP = 144, SLOT = 64 * SP;
constexpr int NCHUNK = (CTXL + SEQ) / 64;
#define ROWOF(s) (((s) < CTXL) ? (ML + b * CTXL + (d == 0 ? (s) : CTXL - 1 - (s))) : (b * SEQ + (d == 0 ? ((s) - CTXL) : (SEQ - 1 - ((s) - CTXL)))))
__device__ __forceinline__ bf16x8 ldA(const LAS unsigned char* X, int row0, int ks, int r32, int hi) { return *(const LAS bf16x8*)(X + (row0 + r32) * SP + (16 * ks + 8 * hi) * 2); }
__device__ __forceinline__ bf16x8 ldT(const LAS unsigned char* X, int n0, int ks, int lane) {
    const int hi = lane >> 5, i16 = lane & 15, qd = i16 >> 2, pp = i16 & 3, c0 = lane & 16;
    const LAS unsigned char* p = X + (16 * ks + 8 * hi + qd) * SP + (n0 + c0 + 4 * pp) * 2;
    return cat4(tr_read(p), tr_read(p + 4 * SP));
}
#define KPOS(rb, q4, hi) ((rb) * 32 + (2 * ((q4) & 1) + (hi)) * 8 + ((q4) >> 1) * 4)
__device__ __forceinline__ v2u pack4(float a, float b, float c, float d) { v2u w; w.x = pk2(a, b); w.y = pk2(c, d); return w; }
__device__ __forceinline__ void stT(LAS unsigned char* M, const f32x16& dv, int r0, int c0, int r32, int hi) {
#pragma unroll
    for (int q4 = 0; q4 < 4; ++q4) *(LAS v2u*)(M + (c0 + r32) * SP + (r0 + 8 * q4 + 4 * hi) * 2) = pack4(dv[4 * q4], dv[4 * q4 + 1], dv[4 * q4 + 2], dv[4 * q4 + 3]);
}
__device__ __forceinline__ void rwkv_chunkA_phase(Frame& F, const Args& A_) {
    const bf16* ZS = (const bf16*)(F.ws + WS_ZS); const float* INVN = (const float*)(F.ws + WS_INVN); const bf16* LIN = (const bf16*)(F.ws + WS_LIN);
    const bf16* W2T = (const bf16*)(F.ws + WS_LW2); const bf16* A2T = (const bf16*)(F.ws + WS_LA2);
    bf16* MTg = (bf16*)(F.ws + WS_MT); bf16* NNg = (bf16*)(F.ws + WS_NN); bf16* QTg = (bf16*)(F.ws + WS_QT);
    bf16* Yg = (bf16*)((unsigned char*)F.out + DO_Y);
    LAS unsigned char* L = F.lds;
    LAS unsigned char* sKKt = L, *sBh = L + SLOT, *sKh = L + 2 * SLOT, *sRt = L + 3 * SLOT, *sBp = L + 4 * SLOT, *sKp = L + 5 * SLOT, *sVm = L + 6 * SLOT,
                     *sT = L + 7 * SLOT, *sAkN = L + 8 * SLOT, *sBbT = L + 9 * SLOT, *sHT = L + 10 * SLOT;
    LAS unsigned char* sFT = sBh; LAS unsigned char* sZT = sBbT; LAS unsigned char* sWyT = sBp; LAS unsigned char* sXT = sHT;
    LAS float* AB = (LAS float*)(L + 11 * SLOT);
    LAS unsigned char* sL1 = L + 11 * SLOT; LAS unsigned char* sL2 = L + 12 * SLOT;
    LAS float* LWf = (LAS float*)(L + 7 * SLOT); LAS float* AAf = LWf + 4096;
    LAS unsigned char* sR0 = L + 13 * SLOT, *sK0 = L + 14 * SLOT, *sV0 = L + 15 * SLOT;
    LAS float* SEG = (LAS float*)(L + 16 * SLOT);
    const int lane = F.lane, r32 = lane & 31, hi = lane >> 5, w = F.wave;
    constexpr int IPB = 64 * NCHUNK / 256;
    const int chain = F.vcu / (NCHUNK / IPB), b = chain >> 4, h = (chain >> 1) & 7, d = chain & 1, cfirst = (F.vcu % (NCHUNK / IPB)) * IPB;
    const int lwhich = w >> 2, ltb = (w >> 1) & 1, lcb = w & 1;
    bf16x8 wfrag[4]; float lbias;
    { const int chn = h * 64 + 32 * lcb + r32; const bf16* Bt = (lwhich ? A2T : W2T) + (size_t)(d * 512 + chn) * 64;
#pragma unroll
      for (int ks = 0; ks < 4; ++ks) wfrag[ks] = *(const bf16x8*)(Bt + 16 * ks + 8 * hi);
      lbias = (lwhich ? A_.in[I_IA0] : A_.in[I_DW0])[d * 512 + chn]; }
    const float kkc = A_.in[I_KK][h * 64 + (F.tid & 63)], kac = A_.in[I_KA][h * 64 + (F.tid & 63)];
    v4u pf_l1, pf_l2, pf_r, pf_k, pf_v; float pf_in = 0.f;
    const int ptok = F.tid >> 3, pc16 = F.tid & 7;
#define CHA_PREFETCH(cc) do { const int row_ = ROWOF(64 * (cc) + ptok); \
        pf_l1 = *(const v4u*)(LIN + (size_t)row_ * 128 + pc16 * 8); pf_l2 = *(const v4u*)(LIN + (size_t)row_ * 128 + 64 + pc16 * 8); \
        const bf16* zp_ = ZS + (size_t)row_ * 1536 + h * 64 + pc16 * 8; pf_r = *(const v4u*)zp_; pf_k = *(const v4u*)(zp_ + 512); pf_v = *(const v4u*)(zp_ + 1024); \
        if (F.tid < 64) pf_in = INVN[(size_t)ROWOF(64 * (cc) + F.tid) * 8 + h]; } while (0)
#define CHA_STAGE() do { *(LAS v4u*)(sL1 + ptok * SP + pc16 * 16) = pf_l1; *(LAS v4u*)(sL2 + ptok * SP + pc16 * 16) = pf_l2; \
        *(LAS v4u*)(sR0 + ptok * SP + pc16 * 16) = pf_r; *(LAS v4u*)(sK0 + ptok * SP + pc16 * 16) = pf_k; *(LAS v4u*)(sV0 + ptok * SP + pc16 * 16) = pf_v; \
        if (F.tid < 64) SEG[9 * 64 + F.tid] = pf_in; } while (0)
    __syncthreads();
    CHA_PREFETCH(cfirst); CHA_STAGE();
    CHA_PREFETCH(cfirst + 1);
#pragma unroll 1
    for (int ii = 0; ii < IPB; ++ii) {
        const int c = cfirst + ii, inst = chain * NCHUNK + c;
        const bool latent = c >= CTXL / 64;
        __syncthreads();
        ALOOP(0) { f32x16 acc = {};
#pragma unroll
          for (int ks = 0; ks < 4; ++ks) acc = mfma32(ldA(lwhich ? sL2 : sL1, 32 * ltb, ks, r32, hi), wfrag[ks], acc);
#pragma unroll
          for (int r = 0; r < 16; ++r) { const int tok = 32 * ltb + (r & 3) + 8 * (r >> 2) + 4 * hi; const float x = lbias + acc[r];
              const float sg = __builtin_amdgcn_rcpf(1.f + __expf(-x));
              if (lwhich == 0) LWf[tok * 64 + 32 * lcb + r32] = -0.6065306597126334f * sg; else AAf[tok * 64 + 32 * lcb + r32] = sg; }
        }
        __syncthreads();
        {
            const int ch = F.tid & 63, seg = F.tid >> 6;
            float lw[8], aa[8], rr[8], kx[8], inn[8]; bf16 vraw[8];
#pragma unroll
            for (int e = 0; e < 8; ++e) vraw[e] = *(const LAS bf16*)(sV0 + (8 * seg + e) * SP + ch * 2);
#pragma unroll
            for (int e = 0; e < 8; ++e) { const int tok = 8 * seg + e; lw[e] = LWf[tok * 64 + ch]; aa[e] = AAf[tok * 64 + ch];
                rr[e] = bf1(*(const LAS bf16*)(sR0 + tok * SP + ch * 2)); kx[e] = bf1(*(const LAS bf16*)(sK0 + tok * SP + ch * 2)); inn[e] = SEG[9 * 64 + tok]; }
            float cl[8]; cl[0] = lw[0];
#pragma unroll
            for (int e = 1; e < 8; ++e) cl[e] = cl[e - 1] + lw[e];
            SEG[seg * 64 + ch] = cl[7];
            __syncthreads();
            float pre = 0.f, tot = 0.f;
#pragma unroll
            for (int s = 0; s < 8; ++s) { const float t = SEG[s * 64 + ch]; tot += t; if (s < seg) pre += t; }
            if (seg == 0) SEG[8 * 64 + ch] = tot;
            const float ptot = __expf(tot); float epprev = __expf(pre);
#pragma unroll
            for (int e = 0; e < 8; ++e) {
                const int tok = 8 * seg + e; const float c_ = pre + cl[e];
                const float kk = kx[e] * kkc * inn[e], bb = kk * aa[e], kd = kx[e] * (1.f + (aa[e] - 1.f) * kac);
                const float em = __expf(-c_), ep = __builtin_amdgcn_rcpf(em), ee = ptot * em, e1 = epprev; epprev = ep;
                const int o = tok * SP + ch * 2;
                *(LAS bf16*)(sKKt + o) = (bf16)f2bf(kk * e1); *(LAS bf16*)(sBh + o) = (bf16)f2bf(bb * em); *(LAS bf16*)(sKh + o) = (bf16)f2bf(kd * em); *(LAS bf16*)(sRt + o) = (bf16)f2bf(rr[e] * ep);
                *(LAS bf16*)(sBp + o) = (bf16)f2bf(bb * ee); *(LAS bf16*)(sKp + o) = (bf16)f2bf(kd * ee); *(LAS bf16*)(sVm + o) = vraw[e];
            }
        }
        __syncthreads();
        ALOOP(1)
        if (w < 4) {
            const int rb = (w >> 1) & 1, cb = w & 1;
            f32x16 acc = {};
#pragma unroll
            for (int ks = 0; ks < 4; ++ks) acc = mfma32(ldA(sKKt, 32 * rb, ks, r32, hi), ldA(sBh, 32 * cb, ks, r32, hi), acc);
            const int col = 32 * cb + r32;
#pragma unroll
            for (int r = 0; r < 16; ++r) { const int row = 32 * rb + (r & 3) + 8 * (r >> 2) + 4 * hi; if (!(col < row)) acc[r] = 0.f; }
#pragma unroll
            for (int q4 = 0; q4 < 4; ++q4) *(LAS f32x4*)(AB + col * 68 + 32 * rb + 8 * q4 + 4 * hi) = (f32x4){acc[4 * q4], acc[4 * q4 + 1], acc[4 * q4 + 2], acc[4 * q4 + 3]};
        }
        __syncthreads();
        ALOOP(2) {
            const int gm = 1 + (w >> 2), grb = (w >> 1) & 1, gcb = w & 1;
            f32x16 gacc = {};
            { const LAS unsigned char* GX = (gm == 2) ? sBh : sKKt; const LAS unsigned char* GY = (gm == 1) ? sKh : sRt;
#pragma unroll
              for (int ks = 0; ks < 4; ++ks) gacc = mfma32(ldA(GX, 32 * grb, ks, r32, hi), ldA(GY, 32 * gcb, ks, r32, hi), gacc); }
            const int col = F.tid >> 3, jq = F.tid & 7, blk = col >> 5, cc = col & 31; float t0 = 0.f, t1 = 0.f, t2 = 0.f, t3 = 0.f;
            const LAS float* arow = AB + (32 * blk) * 68 + 32 * blk + 4 * jq;
#pragma unroll
            for (int i = 31; i >= 0; --i) {
                const f32x4 av = *(const LAS f32x4*)(arow + i * 68);
                float p = av[0] * t0 + av[1] * t1 + av[2] * t2 + av[3] * t3; p = sum8(p);
                const float val = (i == cc) ? 1.f : ((i < cc) ? -p : 0.f);
                if (jq == (i >> 2)) { if ((i & 3) == 0) t0 = val; else if ((i & 3) == 1) t1 = val; else if ((i & 3) == 2) t2 = val; else t3 = val; }
            }
            { const int gcol = 32 * gcb + r32;
#pragma unroll
              for (int r = 0; r < 16; ++r) { const int row = 32 * grb + (r & 3) + 8 * (r >> 2) + 4 * hi;
                  const bool keep = (gm == 2) ? (row <= gcol) : (gcol < row); float vl = keep ? gacc[r] : 0.f; if (gm == 1) vl = -vl; gacc[r] = vl; }
              stT((gm == 1) ? sAkN : sBbT, gacc, 32 * grb, 32 * gcb, r32, hi); }
            { LAS unsigned char* tp_ = sT + (32 * blk + 4 * jq) * SP + (32 * blk + cc) * 2;
              *(LAS bf16*)(tp_) = (bf16)f2bf(t0); *(LAS bf16*)(tp_ + SP) = (bf16)f2bf(t1); *(LAS bf16*)(tp_ + 2 * SP) = (bf16)f2bf(t2); *(LAS bf16*)(tp_ + 3 * SP) = (bf16)f2bf(t3); }
            if (F.tid < 64) { const v4u z = {0u, 0u, 0u, 0u}; LAS unsigned char* zp = sT + (32 + (F.tid >> 1)) * SP + (F.tid & 1) * 32; *(LAS v4u*)zp = z; *(LAS v4u*)(zp + 16) = z; }
        }
        __syncthreads();
        if (w == 0) {
            f32x16 x = {};
#pragma unroll
            for (int ks = 0; ks < 2; ++ks) { const LAS float* ap = AB + r32 * 68 + 32 + 16 * ks + 8 * hi; const f32x4 a0 = *(const LAS f32x4*)ap, a1 = *(const LAS f32x4*)(ap + 4);
                v4u aw; aw.x = pk2(a0[0], a0[1]); aw.y = pk2(a0[2], a0[3]); aw.z = pk2(a1[0], a1[1]); aw.w = pk2(a1[2], a1[3]);
                const int i16 = lane & 15, qd = i16 >> 2, pp = i16 & 3, c0 = lane & 16;
                const LAS unsigned char* tp = sT + (32 + 16 * ks + 8 * hi + qd) * SP + (32 + c0 + 4 * pp) * 2;
                x = mfma32(__builtin_bit_cast(bf16x8, aw), cat4(tr_read(tp), tr_read(tp + 4 * SP)), x); }
            stT(sXT, x, 0, 0, r32, hi);
            f32x16 tr = {};
#pragma unroll
            for (int ks = 0; ks < 2; ++ks) tr = mfma32(ldA(sT, 0, ks, r32, hi), ldA(sXT, 0, ks, r32, hi), tr);
#pragma unroll
            for (int r = 0; r < 16; ++r) { const int i = (r & 3) + 8 * (r >> 2) + 4 * hi; *(LAS bf16*)(sT + i * SP + (32 + r32) * 2) = (bf16)f2bf(-tr[r]); }
        }
        __syncthreads();
        ALOOP(3) { const int which = w >> 2, rb = (w >> 1) & 1, cb = w & 1; f32x16 acc = {};
#pragma unroll
          for (int ks = 0; ks < 4; ++ks) acc = mfma32(ldA(sT, 32 * rb, ks, r32, hi), which ? ldT(sBp, 32 * cb, ks, lane) : ldA(sBbT, 32 * cb, ks, r32, hi), acc);
          stT(which ? sHT : sFT, acc, 32 * rb, 32 * cb, r32, hi); }
        __syncthreads();
        if (ii + 1 < IPB) { CHA_STAGE(); if (ii + 2 < IPB) CHA_PREFETCH(c + 2); }
        const size_t ioff = (size_t)(c * 64 + chain) * 4096; const size_t qoff = (size_t)((c - 4) * 64 + chain) * 4096;
        ALOOP(4)
#pragma unroll 1
        for (int q = w; q < 16; q += 8) {
            const int kind = q >> 2, rb = (q >> 1) & 1, cb = q & 1; const int col = 32 * cb + r32;
            if (!latent && (kind == 1 || kind == 3)) continue;
            f32x16 acc = {};
            if (kind == 3) {
#pragma unroll
                for (int ks = 0; ks < 4; ++ks) acc = mfma32(ldA(sKh, 32 * rb, ks, r32, hi), ldA(sRt, 32 * cb, ks, r32, hi), acc);
#pragma unroll
                for (int r = 0; r < 16; ++r) { const int row = 32 * rb + (r & 3) + 8 * (r >> 2) + 4 * hi; if (row > col) acc[r] = 0.f; }
            }
#pragma unroll
            for (int ks = 0; ks < 4; ++ks) {
                const bf16x8 a = (kind < 2) ? ldT(sKKt, 32 * rb, ks, lane) : ldA(sAkN, 32 * rb, ks, r32, hi);
                const bf16x8 bq = (kind == 0 || kind == 2) ? ldA(sHT, 32 * cb, ks, r32, hi) : ldA(sFT, 32 * cb, ks, r32, hi);
                acc = mfma32(a, bq, acc);
            }
            if (kind == 0) {
                const float pc = __expf(SEG[8 * 64 + col]); v2u pq[4];
#pragma unroll
                for (int q4 = 0; q4 < 4; ++q4) { const int r0 = 32 * rb + 8 * q4 + 4 * hi; float o[4];
#pragma unroll
                    for (int e = 0; e < 4; ++e) o[e] = ((r0 + e == col) ? pc : 0.f) - acc[4 * q4 + e];
                    pq[q4] = pk4(o[0], o[1], o[2], o[3]); }
                bf16* dp = MTg + ioff + (size_t)col * 64 + rb * 32;
                *(v4u*)(dp + hi * 8) = (v4u){pq[0].x, pq[0].y, pq[2].x, pq[2].y}; *(v4u*)(dp + (2 + hi) * 8) = (v4u){pq[1].x, pq[1].y, pq[3].x, pq[3].y};
            } else if (kind == 1) {
                v2u pq[4];
#pragma unroll
                for (int q4 = 0; q4 < 4; ++q4) { const int r0 = 32 * rb + 8 * q4 + 4 * hi; const v2u rv = *(const LAS v2u*)(sRt + col * SP + r0 * 2);
                    pq[q4] = pk4(bf_lo(rv.x) - acc[4 * q4], bf_hi(rv.x) - acc[4 * q4 + 1], bf_lo(rv.y) - acc[4 * q4 + 2], bf_hi(rv.y) - acc[4 * q4 + 3]); }
                bf16* dp = QTg + qoff + (size_t)col * 64 + rb * 32;
                *(v4u*)(dp + hi * 8) = (v4u){pq[0].x, pq[0].y, pq[2].x, pq[2].y}; *(v4u*)(dp + (2 + hi) * 8) = (v4u){pq[1].x, pq[1].y, pq[3].x, pq[3].y};
            } else if (kind == 2) {
#pragma unroll
                for (int r = 0; r < 16; ++r) { const int row = 32 * rb + (r & 3) + 8 * (r >> 2) + 4 * hi; acc[r] += bf1(*(const LAS bf16*)(sKp + row * SP + col * 2)); }
                stT(sZT, acc, 32 * rb, 32 * cb, r32, hi);
            } else stT(sWyT, acc, 32 * rb, 32 * cb, r32, hi);
        }
        __syncthreads();
        ALOOP(5) { const int which = w >> 2, rb = (w >> 1) & 1, cb = w & 1; const int col = 32 * cb + r32;
          if (which == 0 || latent) {
            f32x16 acc = {};
#pragma unroll
            for (int ks = 0; ks < 4; ++ks) acc = which ? mfma32(ldT(sVm, 32 * rb, ks, lane), ldA(sWyT, 32 * cb, ks, r32, hi), acc) : mfma32(ldA(sZT, 32 * rb, ks, r32, hi), ldT(sVm, 32 * cb, ks, lane), acc);
            const v2u q0 = pk4(acc[0], acc[1], acc[2], acc[3]), q1 = pk4(acc[4], acc[5], acc[6], acc[7]), q2 = pk4(acc[8], acc[9], acc[10], acc[11]), q3 = pk4(acc[12], acc[13], acc[14], acc[15]);
            if (which) store_rows16(Yg + ((size_t)d * ML + ROWOF(64 * c + col)) * 512 + h * 64 + 32 * rb, q0, q1, q2, q3, hi);
            else { bf16* dp = NNg + ioff + (size_t)col * 64 + 8 * rb;
                *(v4u*)(dp + hi * 16) = (v4u){q0.x, q0.y, q2.x, q2.y}; *(v4u*)(dp + (2 + hi) * 16) = (v4u){q1.x, q1.y, q3.x, q3.y}; }
          } }
    }
}

typedef float f32x4_t __attribute__((ext_vector_type(4)));
__device__ __forceinline__ f32x4_t mfma16(bf16x8 a, bf16x8 b, f32x4_t c) { return __builtin_amdgcn_mfma_f32_16x16x32_bf16(a, b, c, 0, 0, 0); }
__device__ __forceinline__ bf16* ss_ptr(Frame& F, int cl, int chain) { return ((cl < 64) ? (bf16*)(F.ws + WS_SS) : (bf16*)((unsigned char*)F.out + DO_SS)) + (size_t)((cl & 63) * 64 + chain) * 4096; }
__device__ __forceinline__ void st16_asm(void* p, v4u v) { asm volatile("global_store_dwordx4 %0, %1, off\n\ts_nop 1" :: "v"(p), "v"(v) : "memory"); }
struct ChunkOps { v4u m[8]; v4u n[2]; };
__device__ __forceinline__ void chB_load(ChunkOps& o, const bf16* mt, const bf16* nn) {
#pragma unroll
    for (int tn = 0; tn < 4; ++tn) { o.m[2 * tn] = *(const v4u*)(mt + tn * 1024); o.m[2 * tn + 1] = *(const v4u*)(mt + tn * 1024 + 32); }
    o.n[0] = *(const v4u*)nn; o.n[1] = *(const v4u*)(nn + 8);
}
__device__ __forceinline__ void rwkv_chunkB_phase(Frame& F, const Args& A_, int mode = 0) {
    if (F.vcu >= 64) return;
    const int chain = F.vcu, vb = F.wave & 3; const bool comp = F.wave < 4;
    const int l15 = F.lane & 15, g = F.lane >> 4;
    const int lt = F.tid & 255;
    const bf16* mtg = (const bf16*)(F.ws + WS_MT) + (size_t)chain * 4096 + lt * 8;
    const bf16* nng = (const bf16*)(F.ws + WS_NN) + (size_t)chain * 4096 + lt * 8;
    const int ssoff = (16 * vb + l15) * 64 + 8 * g;
    const int wr = lt >> 3, wp = lt & 7; const int woff = wr * 128 + ((wp ^ (wr & 7)) << 4);
    LAS unsigned char* img = F.lds;
    bf16x8 S0 = {}, S1 = {};
    struct R4 { v4u a, b, c, d; };
    R4 r0, r1, r2, r3, r4, r5;
#define B_LD(r, cc) do { r.a = *(const v4u*)(mtg + (size_t)(cc) * 262144); r.b = *(const v4u*)(mtg + (size_t)(cc) * 262144 + 2048); r.c = *(const v4u*)(nng + (size_t)(cc) * 262144); r.d = *(const v4u*)(nng + (size_t)(cc) * 262144 + 2048); } while (0)
#define B_ST(r, cc) do { LAS unsigned char* d_ = img + ((cc) & 1) * 16384 + woff; *(LAS v4u*)d_ = r.a; *(LAS v4u*)(d_ + 4096) = r.b; *(LAS v4u*)(d_ + 8192) = r.c; *(LAS v4u*)(d_ + 12288) = r.d; } while (0)
    if (!comp) { B_LD(r0, 0); B_LD(r1, 1); B_LD(r2, 2); B_LD(r3, 3); B_LD(r4, 4); B_LD(r5, 5); }
    __syncthreads();
    if (!comp) { B_ST(r0, 0); B_LD(r0, 6); }
    __syncthreads();
#define B_ITER(Rn, cc) do { \
        if (!comp) { if ((cc) + 1 < NCHUNK && mode != 2) { B_ST(Rn, (cc) + 1); if ((cc) + 7 < NCHUNK) B_LD(Rn, (cc) + 7); } } \
        else if (mode != 1) { \
            const LAS unsigned char* si_ = img + ((cc) & 1) * 16384; \
            if ((cc) >= 4) { bf16* sp_ = ss_ptr(F, (cc) - 4, chain) + ssoff; *(v4u*)sp_ = __builtin_bit_cast(v4u, S0); *(v4u*)(sp_ + 32) = __builtin_bit_cast(v4u, S1); } \
            const int vr_ = 16 * vb + l15; \
            const v4u n0_ = *(const LAS v4u*)(si_ + 8192 + vr_ * 128 + (((2 * g) ^ (vr_ & 7)) << 4)), n1_ = *(const LAS v4u*)(si_ + 8192 + vr_ * 128 + (((2 * g + 1) ^ (vr_ & 7)) << 4)); \
            f32x4_t dn_[4]; \
            _Pragma("unroll") for (int tn = 0; tn < 4; ++tn) { const int nr_ = 16 * tn + l15; \
                const bf16x8 a0_ = *(const LAS bf16x8*)(si_ + nr_ * 128 + ((g ^ (nr_ & 7)) << 4)), a1_ = *(const LAS bf16x8*)(si_ + nr_ * 128 + (((4 + g) ^ (nr_ & 7)) << 4)); \
                const v4u nq_ = (tn >> 1) ? n1_ : n0_; const unsigned nx_ = (tn & 1) ? nq_.z : nq_.x, ny_ = (tn & 1) ? nq_.w : nq_.y; \
                const f32x4_t ci_ = {bf_lo(nx_), bf_hi(nx_), bf_lo(ny_), bf_hi(ny_)}; \
                dn_[tn] = mfma16(a0_, S0, ci_); dn_[tn] = mfma16(a1_, S1, dn_[tn]); } \
            v4u w0_, w1_; w0_.x = cvtpk(dn_[0][0], dn_[0][1]); w0_.y = cvtpk(dn_[0][2], dn_[0][3]); w0_.z = cvtpk(dn_[1][0], dn_[1][1]); w0_.w = cvtpk(dn_[1][2], dn_[1][3]); \
            w1_.x = cvtpk(dn_[2][0], dn_[2][1]); w1_.y = cvtpk(dn_[2][2], dn_[2][3]); w1_.z = cvtpk(dn_[3][0], dn_[3][1]); w1_.w = cvtpk(dn_[3][2], dn_[3][3]); \
            S0 = __builtin_bit_cast(bf16x8, w0_); S1 = __builtin_bit_cast(bf16x8, w1_); } \
        __syncthreads(); } while (0)
#pragma unroll 1
    for (int c = 0; c < NCHUNK; c += 6) { B_ITER(r1, c); B_ITER(r2, c + 1); B_ITER(r3, c + 2); B_ITER(r4, c + 3); B_ITER(r5, c + 4); B_ITER(r0, c + 5); }
#undef B_LD
#undef B_ST
#undef B_ITER
}
__device__ __forceinline__ void rwkv_chunkC_phase(Frame& F, const Args& A_, bool do_store) {
    const bf16* QTg = (const bf16*)(F.ws + WS_QT); bf16* Yg = (bf16*)((unsigned char*)F.out + DO_Y);
    const int lane = F.lane, r32 = lane & 31, hi = lane >> 5;
    const int gw = F.vcu * NWAVES + F.wave, NGW = F.G * NWAVES;
#pragma unroll 1
    for (int q = gw; q < 64 * (NCHUNK - 4); q += NGW) {
        const int cl = q >> 6, chain = q & 63, c = cl + 4, b = chain >> 4, h = (chain >> 1) & 7, d = chain & 1;
        const bf16* sp = ss_ptr(F, cl, chain); const bf16* qp = QTg + (size_t)q * 4096;
        bf16x8 af[2][4], bq[2][4];
#pragma unroll
        for (int t = 0; t < 2; ++t)
#pragma unroll
            for (int ks = 0; ks < 4; ++ks) { af[t][ks] = *(const bf16x8*)(sp + (size_t)(32 * t + r32) * 64 + 16 * ks + 8 * hi); bq[t][ks] = *(const bf16x8*)(qp + (size_t)(32 * t + r32) * 64 + 16 * ks + 8 * hi); }
#pragma unroll
        for (int ct = 0; ct < 2; ++ct) {
            bf16* yrow = Yg + ((size_t)d * ML + ROWOF(64 * c + 32 * ct + r32)) * 512 + h * 64;
#pragma unroll
            for (int rt = 0; rt < 2; ++rt) {
                f32x16 acc;
                { const v4u w0 = *(const v4u*)(yrow + 32 * rt + (hi ? 8 : 0)), w1 = *(const v4u*)(yrow + 32 * rt + 16 + (hi ? 8 : 0));
                  const v4u u0 = widen2((v2u){w0.x, w0.y}, (v2u){w0.z, w0.w}), u1 = widen2((v2u){w1.x, w1.y}, (v2u){w1.z, w1.w});
                  acc[0] = bf_lo(u0.x); acc[1] = bf_hi(u0.x); acc[2] = bf_lo(u0.y); acc[3] = bf_hi(u0.y); acc[4] = bf_lo(u0.z); acc[5] = bf_hi(u0.z); acc[6] = bf_lo(u0.w); acc[7] = bf_hi(u0.w);
                  acc[8] = bf_lo(u1.x); acc[9] = bf_hi(u1.x); acc[10] = bf_lo(u1.y); acc[11] = bf_hi(u1.y); acc[12] = bf_lo(u1.z); acc[13] = bf_hi(u1.z); acc[14] = bf_lo(u1.w); acc[15] = bf_hi(u1.w); }
#pragma unroll
                for (int ks = 0; ks < 4; ++ks) acc = mfma32(af[rt][ks], bq[ct][ks], acc);
                if (do_store) store_rows16(yrow + 32 * rt, pk4(acc[0], acc[1], acc[2], acc[3]), pk4(acc[4], acc[5], acc[6], acc[7]), pk4(acc[8], acc[9], acc[10], acc[11]), pk4(acc[12], acc[13], acc[14], acc[15]), hi);
                else asm volatile("" :: "v"(acc));
            }
        }
    }
}

__device__ __forceinline__ void rwkv_readout_phase(Frame& F, const Args& A_) {
    const bf16* ZS = (const bf16*)(F.ws + WS_ZS); const bf16* Y0 = (const bf16*)((unsigned char*)F.out + DO_Y); const bf16* Y1 = Y0 + (size_t)ML * 512;
    const bf16* GG = (const bf16*)((unsigned char*)F.out + DO_G); bf16* O = (bf16*)(F.ws + WS_ATTRW);
    const int gw = F.vcu * NWAVES + F.wave, NGW = F.G * NWAVES, ch = F.lane * 8;
    float rk[8], lg[8], lb[8];
#pragma unroll
    for (int e = 0; e < 8; ++e) { rk[e] = A_.in[I_RK][ch + e]; lg[e] = A_.in[I_LNG][ch + e]; lb[e] = A_.in[I_LNB][ch + e]; }
    for (int row = gw; row < ML; row += NGW) {
        const v4u y0 = *(const v4u*)(Y0 + (size_t)row * 512 + ch), y1 = *(const v4u*)(Y1 + (size_t)row * 512 + ch);
        const v4u rr = *(const v4u*)(ZS + (size_t)row * 1536 + ch), kk = *(const v4u*)(ZS + (size_t)row * 1536 + 512 + ch), vv = *(const v4u*)(ZS + (size_t)row * 1536 + 1024 + ch);
        const v4u gg = *(const v4u*)(GG + (size_t)row * 512 + ch);
        float y[8], s = 0.f, bs = 0.f;
#pragma unroll
        for (int e = 0; e < 4; ++e) { y[2 * e] = bf_lo(y0[e]) + bf_lo(y1[e]); y[2 * e + 1] = bf_hi(y0[e]) + bf_hi(y1[e]); s += y[2 * e] + y[2 * e + 1];
            bs += bf_lo(rr[e]) * bf_lo(kk[e]) * rk[2 * e] + bf_hi(rr[e]) * bf_hi(kk[e]) * rk[2 * e + 1]; }
        const float mean = sum8(s) * (1.f / 64.f); bs = sum8(bs);
        float q = 0.f;
#pragma unroll
        for (int e = 0; e < 8; ++e) { y[e] -= mean; q += y[e] * y[e]; }
        const float rstd = 1.f / sqrtf(sum8(q) * (1.f / 64.f) + GN_EPS);
        float o[8];
#pragma unroll
        for (int e = 0; e < 4; ++e) {
            o[2 * e] = (y[2 * e] * rstd * lg[2 * e] + lb[2 * e] + bs * bf_lo(vv[e])) * bf_lo(gg[e]);
            o[2 * e + 1] = (y[2 * e + 1] * rstd * lg[2 * e + 1] + lb[2 * e + 1] + bs * bf_hi(vv[e])) * bf_hi(gg[e]);
        }
        v4u w; w.x = pk2(o[0], o[1]); w.y = pk2(o[2], o[3]); w.z = pk2(o[4], o[5]); w.w = pk2(o[6], o[7]);
        *(v4u*)(O + (size_t)row * 1024 + 512 + ch) = w;
    }
}
#ifndef FFT_ABL
#define FFT_ABL 0
#endif
template <bool PASS_A> __device__ __forceinline__ void fft_col_phase(Frame& F, bool real_run = true) {
    const int abl = real_run ? 0 : FFT_ABL;
    constexpr int KC = PASS_A ? 64 : 128, K2 = 2 * KC, NU = 2048;
    constexpr int TCOLS = PASS_A ? 512 : 256, FP = TCOLS * 2 + 16, WP = K2 * 2 + 16, NT = PASS_A ? 4 : 2;
    const bf16* In = (const bf16*)(F.ws + (PASS_A ? WS_G1 : WS_Y1)); bf16* Out = (bf16*)(F.ws + (PASS_A ? WS_Y1 : WS_F1));
    const bf16* W = (const bf16*)(F.ws + (PASS_A ? WS_W2A : WS_W2B)); const float* tw = (const float*)(F.ws + WS_TW);
    LAS unsigned char* T = F.lds; LAS unsigned char* WL = F.lds + KC * FP;
    const int lane = F.lane, r32 = lane & 31, hi = lane >> 5, i16 = lane & 15, qd = i16 >> 2, pp = i16 & 3, c0 = lane & 16;
#ifndef WLDS
#define WLDS 2
#endif
    constexpr bool USE_WL = (WLDS >> (PASS_A ? 0 : 1)) & 1;
    __syncthreads();
    if (USE_WL) for (int it = F.tid; it < 128 * (K2 / 8); it += 512) { const int r = it / (K2 / 8), ch = it % (K2 / 8); *(LAS v4u*)(WL + r * WP + ch * 16) = *(const v4u*)(W + (size_t)r * K2 + ch * 8); }
    const int cw = PASS_A ? 32 * F.wave : 32 * (F.wave & 3), t0 = PASS_A ? 0 : 2 * (F.wave >> 2);
#ifndef FFT_PF
#define FFT_PF 3
#endif
    constexpr bool PF = (FFT_PF >> (PASS_A ? 0 : 1)) & 1;
    v4u pf[8];
#define FFT_DEC(u_, b, g, fix, half) do { b = (u_) >> 9; g = ((u_) >> 7) & 3; if (PASS_A) { fix = (u_) & 127; half = 0; } else { fix = ((u_) >> 1) & 63; half = (u_) & 1; } } while (0)
#define FFT_LD(u_) do { int b_, g_, f_, h_; FFT_DEC(u_, b_, g_, f_, h_); \
        _Pragma("unroll") for (int i = 0; i < 8; ++i) { const int it = F.tid + 512 * i; \
            if (PASS_A) { const int k = it >> 6, c16 = it & 63; pf[i] = *(const v4u*)(In + ((size_t)((b_ * 128 + f_) * 4 + g_) * 64 + k) * 512 + c16 * 8); } \
            else { const int k = it >> 5, c16 = it & 31, part = c16 >> 4, cc = c16 & 15; pf[i] = *(const v4u*)(In + ((size_t)((b_ * 64 + f_) * 4 + g_) * 128 + k) * 512 + part * 256 + h_ * 128 + cc * 8); } } } while (0)
#define FFT_ST() do { _Pragma("unroll") for (int i = 0; i < 8; ++i) { const int it = F.tid + 512 * i; const int k = PASS_A ? (it >> 6) : (it >> 5), c16 = PASS_A ? (it & 63) : (it & 31); *(LAS v4u*)(T + k * FP + c16 * 16) = pf[i]; } } while (0)
    if (F.vcu < NU) { FFT_LD(F.vcu); FFT_ST(); }
    for (int unit = F.vcu; unit < NU; unit += F.G) {
        int b, g, fix, half; FFT_DEC(unit, b, g, fix, half);
        const bool more = unit + F.G < NU;
        __syncthreads();
        if (PF && more && abl != 2) FFT_LD(unit + F.G);
        f32x16 acc[NT] = {};
        if (abl == 1) {} else if (!USE_WL) {
#pragma unroll 1
            for (int t = 0; t < NT; ++t) {
                bf16x8 wfr[K2 / 16];
#pragma unroll
                for (int ks = 0; ks < K2 / 16; ++ks) wfr[ks] = *(const bf16x8*)(W + (size_t)(32 * (t0 + t) + r32) * K2 + 16 * ks + 8 * hi);
                f32x16 a = {};
#pragma unroll
                for (int ks = 0; ks < K2 / 16; ++ks) {
                    const int part = (16 * ks) / KC, kb = (16 * ks) % KC;
                    const LAS unsigned char* tb = T + (kb + 8 * hi + qd) * FP + (part * (TCOLS / 2) + cw + c0 + 4 * pp) * 2;
                    a = mfma32(cat4(tr_read(tb), tr_read(tb + 4 * FP)), wfr[ks], a);
                }
                if (t == 0) acc[0] = a; else if (t == 1) acc[1] = a; else if (t == 2) acc[NT > 2 ? 2 : 0] = a; else acc[NT > 3 ? 3 : 0] = a;
            }
        } else {
#pragma unroll 8
        for (int ks = 0; ks < K2 / 16; ++ks) {
            const int part = (16 * ks) / KC, kb = (16 * ks) % KC;
            const LAS unsigned char* tb = T + (kb + 8 * hi + qd) * FP + (part * (TCOLS / 2) + cw + c0 + 4 * pp) * 2;
            const bf16x8 af = cat4(tr_read(tb), tr_read(tb + 4 * FP));
#pragma unroll
            for (int t = 0; t < NT; ++t) { const bf16x8 wf = *(const LAS bf16x8*)(WL + (32 * (t0 + t) + r32) * WP + (16 * ks + 8 * hi) * 2); acc[t] = mfma32(af, wf, acc[t]); }
        }
        }
        __syncthreads();
        constexpr int OP = PASS_A ? 1040 : 272;
        if (PASS_A) {
#pragma unroll
            for (int t = 0; t < 2; ++t) { const int l1p = 32 * t + r32; const int ti = (fix * l1p) & 8191; const float cs = tw[2 * ti], sn = tw[2 * ti + 1];
                LAS unsigned char* op = T + l1p * OP + cw * 2;
#pragma unroll
                for (int q4 = 0; q4 < 4; ++q4) { float re[4], im[4];
#pragma unroll
                    for (int e = 0; e < 4; ++e) { const float a = acc[t][4 * q4 + e], bq = acc[(t + 2) % NT][4 * q4 + e]; re[e] = a * cs + bq * sn; im[e] = bq * cs - a * sn; }
                    *(LAS v2u*)(op + (8 * q4 + 4 * hi) * 2) = pk4(re[0], re[1], re[2], re[3]); *(LAS v2u*)(op + 512 + (8 * q4 + 4 * hi) * 2) = pk4(im[0], im[1], im[2], im[3]); } }
        } else {
#pragma unroll
            for (int t = 0; t < 2; ++t) { LAS unsigned char* op = T + (32 * (t0 + t) + r32) * OP + cw * 2;
#pragma unroll
                for (int q4 = 0; q4 < 4; ++q4) *(LAS v2u*)(op + (8 * q4 + 4 * hi) * 2) = pk4(acc[t][4 * q4], acc[t][4 * q4 + 1], acc[t][4 * q4 + 2], acc[t][4 * q4 + 3]); }
        }
        __syncthreads();
        if (abl != 3) {
            if (PASS_A) {
#pragma unroll
                for (int i = 0; i < 8; ++i) { const int it = F.tid + 512 * i; const int row = it >> 6, c16 = it & 63;
                    *(v4u*)(Out + ((size_t)((b * 64 + row) * 4 + g) * 128 + fix) * 512 + c16 * 8) = *(const LAS v4u*)(T + row * OP + c16 * 16); }
            } else {
#pragma unroll
                for (int i = 0; i < 4; ++i) { const int it = F.tid + 512 * i; const int row = it >> 4, c16 = it & 15;
                    *(v4u*)(Out + ((size_t)((b * 64 + fix) * 128 + row) * 4 + g) * 256 + half * 128 + c16 * 8) = *(const LAS v4u*)(T + row * OP + c16 * 16); }
            }
        }
        __syncthreads();
        if (more) { if (!PF && abl != 2) FFT_LD(unit + F.G); FFT_ST(); }
    }
#undef FFT_DEC
#undef FFT_LD
#undef FFT_ST
}

__device__ __forceinline__ void fft_passA_fused_phase(Frame& F) {
    constexpr int XP = 528, TP = 1040, WP = 272, XO = 0, TO = 64 * XP, WO = TO + 64 * TP, NU = 2048;
    const bf16* XN = (const bf16*)(F.ws + WS_XN); bf16* Out = (bf16*)(F.ws + WS_Y1);
    const bf16* DFTC = (const bf16*)(F.ws + WS_DFTC); const bf16* W = (const bf16*)(F.ws + WS_W2A); const float* tw = (const float*)(F.ws + WS_TW);
    LAS unsigned char* X = F.lds + XO; LAS unsigned char* T = F.lds + TO; LAS unsigned char* WL = F.lds + WO;
    const int lane = F.lane, r32 = lane & 31, hi = lane >> 5, i16 = lane & 15, qd = i16 >> 2, pp = i16 & 3, c0 = lane & 16, w = F.wave, cw = 32 * w;
    __syncthreads();
    for (int it = F.tid; it < 128 * 16; it += 512) { const int r = it >> 4, ch = it & 15; *(LAS v4u*)(WL + r * WP + ch * 16) = *(const v4u*)(W + (size_t)r * 128 + ch * 8); }
    bf16x8 dfr[2][16];
#pragma unroll
    for (int t = 0; t < 2; ++t)
#pragma unroll
        for (int ks = 0; ks < 16; ++ks) dfr[t][ks] = *(const bf16x8*)(DFTC + (size_t)(64 * w + 32 * t + r32) * 256 + 16 * ks + 8 * hi);
    v4u px[4];
#define FA_LD(u_) do { const int b_ = (u_) >> 9, g_ = ((u_) >> 7) & 3, f_ = (u_) & 127; \
        _Pragma("unroll") for (int i = 0; i < 4; ++i) { const int it = F.tid + 512 * i; const int k = it >> 5, c16 = it & 31; px[i] = *(const v4u*)(XN + (size_t)(b_ * SEQ + k * 128 + f_) * 1024 + g_ * 256 + c16 * 8); } } while (0)
#define FA_ST() do { _Pragma("unroll") for (int i = 0; i < 4; ++i) { const int it = F.tid + 512 * i; const int k = it >> 5, c16 = it & 31; *(LAS v4u*)(X + k * XP + c16 * 16) = px[i]; } } while (0)
    if (F.vcu < NU) { FA_LD(F.vcu); FA_ST(); }
    for (int unit = F.vcu; unit < NU; unit += F.G) {
        const int b = unit >> 9, g = (unit >> 7) & 3, fix = unit & 127; const bool more = unit + F.G < NU;
        __syncthreads();
        if (more) FA_LD(unit + F.G);
        {
            f32x16 a2[2][2] = {};
#pragma unroll
            for (int ks = 0; ks < 16; ++ks) {
                const bf16x8 x0 = *(const LAS bf16x8*)(X + r32 * XP + (16 * ks + 8 * hi) * 2), x1 = *(const LAS bf16x8*)(X + (32 + r32) * XP + (16 * ks + 8 * hi) * 2);
#pragma unroll
                for (int t = 0; t < 2; ++t) { a2[t][0] = mfma32(dfr[t][ks], x0, a2[t][0]); a2[t][1] = mfma32(dfr[t][ks], x1, a2[t][1]); }
            }
#pragma unroll
            for (int t = 0; t < 2; ++t)
#pragma unroll
                for (int ct = 0; ct < 2; ++ct) { LAS unsigned char* tp = T + (32 * ct + r32) * TP + (64 * w + 32 * t) * 2;
#pragma unroll
                    for (int q4 = 0; q4 < 4; ++q4) *(LAS v2u*)(tp + (8 * q4 + 4 * hi) * 2) = pk4(a2[t][ct][4 * q4], a2[t][ct][4 * q4 + 1], a2[t][ct][4 * q4 + 2], a2[t][ct][4 * q4 + 3]); }
        }
        __syncthreads();
        if (more) FA_ST();
        f32x16 acc[4] = {};
#pragma unroll 2
        for (int ks = 0; ks < 8; ++ks) {
            const int part = ks >> 2, kb = (16 * ks) & 63;
            const LAS unsigned char* tb = T + (kb + 8 * hi + qd) * TP + (part * 256 + cw + c0 + 4 * pp) * 2;
            const bf16x8 af = cat4(tr_read(tb), tr_read(tb + 4 * TP));
#pragma unroll
            for (int t = 0; t < 4; ++t) acc[t] = mfma32(af, *(const LAS bf16x8*)(WL + (32 * t + r32) * WP + (16 * ks + 8 * hi) * 2), acc[t]);
        }
        __syncthreads();
#pragma unroll
        for (int t = 0; t < 2; ++t) { const int l1p = 32 * t + r32; const int ti = (fix * l1p) & 8191; const float cs = tw[2 * ti], sn = tw[2 * ti + 1];
            LAS unsigned char* op = T + l1p * TP + cw * 2;
#pragma unroll
            for (int q4 = 0; q4 < 4; ++q4) { float re[4], im[4];
#pragma unroll
                for (int e = 0; e < 4; ++e) { const float a = acc[t][4 * q4 + e], bq = acc[t + 2][4 * q4 + e]; re[e] = a * cs + bq * sn; im[e] = bq * cs - a * sn; }
                *(LAS v2u*)(op + (8 * q4 + 4 * hi) * 2) = pk4(re[0], re[1], re[2], re[3]); *(LAS v2u*)(op + 512 + (8 * q4 + 4 * hi) * 2) = pk4(im[0], im[1], im[2], im[3]); } }
        __syncthreads();
#pragma unroll
        for (int i = 0; i < 8; ++i) { const int it = F.tid + 512 * i; const int row = it >> 6, c16 = it & 63;
            *(v4u*)(Out + ((size_t)((b * 64 + row) * 4 + g) * 128 + fix) * 512 + c16 * 8) = *(const LAS v4u*)(T + row * TP + c16 * 16); }
    }
#undef FA_LD
#undef FA_ST
}

__global__ void __launch_bounds__(NWAVES * 64, 2) skel_fwd(Args A_) {
    extern __shared__ __attribute__((aligned(16))) unsigned char lds[];
    Frame F;
    F.lds = (LAS unsigned char*)lds;
    F.tid = threadIdx.x; F.lane = F.tid & 63; F.wave = __builtin_amdgcn_readfirstlane(F.tid >> 6);
    F.G = gridDim.x; { const int bx = blockIdx.x; F.vcu = (F.G % 8 == 0) ? (bx % 8) * (F.G / 8) + bx / 8 : bx; }
    F.ws = A_.ws; F.out = A_.out;
    cg::grid_group grid = cg::this_grid();
    { volatile LAS unsigned* misc = (volatile LAS unsigned*)(F.lds + MISC_OFF); if (F.tid < 16) misc[F.tid] = 0u; }
    __syncthreads();
    XcdBarrier bar = xcd_barrier_post((unsigned*)(F.ws + WS_BAR), (volatile LAS unsigned*)(F.lds + MISC_OFF));
#ifndef USE_CG
#define GSYNC() xcd_barrier(bar)
#else
#define GSYNC() grid.sync()
#endif
    const int lo = A_.ph_lo, hi = A_.ph_hi;
#ifndef PHMASK
#define PHMASK 0x7ffff
#endif
#define IN(k) (((PHMASK >> (k)) & 1) && lo <= (k) && (k) < hi)
#define SEAM(k) do { if (IN(k) && IN((k) + 1)) { if ((k) == 0) grid.sync(); else GSYNC(); } } while (0)
#ifndef REPMASK
#define REPMASK 0
#endif
#ifndef REPS
#define REPS 2
#endif
#define NREP(k) (((REPMASK >> (k)) & 1) ? REPS : 1)
#define PH(k) if (IN(k)) for (int rep_ = 0; rep_ < NREP(k); ++rep_, (rep_ < NREP(k) ? GSYNC() : (void)0))
#define LASTREP(k) (rep_ == NREP(k) - 1)
    const float* zero_gate = (const float*)(F.ws + WS_ZERO);
    const float* mod0 = (const float*)(F.ws + WS_MOD); const float* mod1 = mod0 + 5 * 6144;
    bf16* XN = (bf16*)(F.ws + WS_XN); bf16* XR = (bf16*)(F.ws + WS_XR);

    PH(0) { p0_prologue(F, A_); } SEAM(0);
    PH(1) { norm_phase(F, A_.in[I_X], A_.in[I_CTX], MALL, A_.in[I_N1G], mod0, 0, XN); } SEAM(1);
    PH(2) {
        pg8::Gemm g{XN, (const bf16*)(F.ws + WS_WIN), MALL, INCOLS, DM}; pg8::StaticOrder S; S.init(MALL, INCOLS, F.G, (int)blockIdx.x);
        pg8::EpiInProj E{(bf16*)(F.ws + WS_QKV), (bf16*)(F.ws + WS_ZR), (const float*)(F.ws + WS_ROPE)};
        pg8::gemm_phase<pg8::EpiInProj, pg8::StaticOrder, true, true>(F.lds, g, S, E);
    } SEAM(2);
    PH(3) { rwkv_prep_phase(F, A_); } SEAM(3);
    PH(4) { rwkv_chunkA_phase(F, A_); } if (IN(4)) GSYNC();
#ifndef TM
#define TM 0
#endif
#if TM == 3
    for (int i_ = 0; i_ < 20; ++i_) GSYNC();
#endif
#if TM == 4
    if (IN(4)) { if (F.vcu >= 64) attn_phase(F, A_, F.vcu - 64, F.G - 64); GSYNC(); }
#endif
#if TM == 6 || TM == 7
    if (IN(4)) { if (F.vcu < 64) rwkv_chunkB_phase(F, A_, TM - 5); GSYNC(); }
#endif
#if TM == 5
    if (IN(4)) { if (F.vcu < 64) rwkv_chunkB_phase(F, A_); GSYNC(); }
#endif
#if TM == 1
    if (IN(4)) { if (F.vcu < 64) rwkv_chunkB_phase(F, A_); else attn_phase(F, A_, F.vcu - 64, F.G - 64); GSYNC(); }
#endif
    if (IN(4)) { if (F.vcu < 64) rwkv_chunkB_phase(F, A_); else attn_phase(F, A_, F.vcu - 64, F.G - 64); GSYNC(); }
#if TM == 2
    if (IN(4)) { rwkv_chunkC_phase(F, A_, A_.ph_lo == 12345); GSYNC(); }
#endif
    if (IN(4)) { rwkv_chunkC_phase(F, A_, true); } SEAM(4);
    PH(5) { rwkv_readout_phase(F, A_); } SEAM(5);
    PH(6) {
        pg8::Gemm g{(const bf16*)(F.ws + WS_ATTRW), (const bf16*)(F.ws + WS_WOUT), ML, DM, DM}; pg8::StaticOrder S; S.init(ML, DM, F.G, (int)blockIdx.x);
        pg8::EpiResidualT<false, false, true> E{A_.in[I_X], XR, mod0 + 2048, 6144};
        pg8::gemm_phase<pg8::EpiResidualT<false, false, true>, pg8::StaticOrder, true, true>(F.lds, g, S, E);
    } SEAM(6);
    PH(7) { norm_bf16_phase(F, XR, A_.in[I_N2G], mod0, 3072, XN); } SEAM(7);
    PH(8) {
        pg8::Gemm g{XN, (const bf16*)(F.ws + WS_W1), ML, FF, DM}; pg8::StaticOrder S; S.init(ML, FF, F.G, (int)blockIdx.x);
        pg8::EpiStore<2> E{(bf16*)(F.ws + WS_H), FF};
        pg8::gemm_phase<pg8::EpiStore<2>, pg8::StaticOrder, true, true>(F.lds, g, S, E);
    } SEAM(8);
    PH(9) {
        pg8::Gemm g{(const bf16*)(F.ws + WS_H), (const bf16*)(F.ws + WS_W2), ML, DM, FF}; pg8::StaticOrder S; S.init(ML, DM, F.G, (int)blockIdx.x);
        pg8::EpiResidualT<false, true, true> E{XR, XR, LASTREP(9) ? mod0 + 5120 : zero_gate, LASTREP(9) ? 6144 : 0};
        pg8::gemm_phase<pg8::EpiResidualT<false, true, true>, pg8::StaticOrder, true, true>(F.lds, g, S, E);
    } SEAM(9);
    PH(10) { norm_bf16_phase(F, XR, A_.in[I_N1G] + DM, mod1, 0, XN); } SEAM(10);
    PH(12) { fft_passA_fused_phase(F); } SEAM(12);
    PH(13) { fft_col_phase<false>(F, LASTREP(13)); } SEAM(13);
    PH(14) {
        pg8::Gemm g{(const bf16*)(F.ws + WS_F1), (const bf16*)(F.ws + WS_WF), ML, DM, DM}; pg8::StaticOrder S; S.init(ML, DM, F.G, (int)blockIdx.x);
        pg8::EpiResidualT<true, true, true> E{XR, XR, LASTREP(14) ? mod1 + 2048 : zero_gate, LASTREP(14) ? 6144 : 0};
        pg8::gemm_phase<pg8::EpiResidualT<true, true, true>, pg8::StaticOrder, true, true>(F.lds, g, S, E);
    } SEAM(14);
    PH(15) { norm_bf16_phase(F, XR, A_.in[I_N2G] + DM, mod1, 3072, XN); } SEAM(15);
    PH(16) {
        pg8::Gemm g{XN, (const bf16*)(F.ws + WS_W1) + (size_t)DM * FF, ML, FF, DM}; pg8::StaticOrder S; S.init(ML, FF, F.G, (int)blockIdx.x);
        pg8::EpiStore<2> E{(bf16*)(F.ws + WS_H), FF};
        pg8::gemm_phase<pg8::EpiStore<2>, pg8::StaticOrder, true, true>(F.lds, g, S, E);
    } SEAM(16);
    PH(17) {
        pg8::Gemm g{(const bf16*)(F.ws + WS_H), (const bf16*)(F.ws + WS_W2) + (size_t)DM * FF, ML, DM, FF}; pg8::StaticOrder S; S.init(ML, DM, F.G, (int)blockIdx.x);
        pg8::EpiResidualT<false, true, true> E{XR, XR, LASTREP(17) ? mod1 + 5120 : zero_gate, LASTREP(17) ? 6144 : 0};
        pg8::gemm_phase<pg8::EpiResidualT<false, true, true>, pg8::StaticOrder, true, true>(F.lds, g, S, E);
    } SEAM(17);
    PH(18) { final_norm_bf16_phase(F, XR, F.out, A_.in[I_FING]); }
#undef IN
#undef SEAM
}

extern "C" void kernel_launch(void* const* d_in, const int* in_sizes, int n_in, void* d_out, int out_size, void* d_ws, size_t ws_size, hipStream_t stream) {
    static int grid = 0;
    if (grid == 0) {
        if (n_in != 27 || out_size != ML * DM || ws_size < WS_END) { fprintf(stderr, "kernel_launch: unexpected shapes: n_in %d out %d ws %zu\n", n_in, out_size, ws_size); grid = -1; return; }
        int dev = 0, cus = 0, per_cu = 0;
        (void)hipGetDevice(&dev); (void)hipDeviceGetAttribute(&cus, hipDeviceAttributeMultiprocessorCount, dev);
        (void)hipFuncSetAttribute((const void*)skel_fwd, hipFuncAttributeMaxDynamicSharedMemorySize, LDS_BYTES);
        (void)hipOccupancyMaxActiveBlocksPerMultiprocessor(&per_cu, (const void*)skel_fwd, NWAVES * 64, LDS_BYTES);
        (void)hipGetLastError();
        if (per_cu < 1) { fprintf(stderr, "kernel_launch: occupancy query reports %d\n", per_cu); }
        grid = cus;
    }
    if (grid < 0) return;
    if (hipMemsetAsync((char*)d_ws + WS_BAR, 0, 16384, stream) != hipSuccess) { fprintf(stderr, "kernel_launch: memset failed\n"); return; }
    Args a{};
    for (int i = 0; i < 27; ++i) a.in[i] = (const float*)d_in[i];
    a.out = (float*)d_out; a.ws = (unsigned char*)d_ws;
    if (MK_N_LAUNCHES == 1) {
        a.ph_lo = 0; a.ph_hi = N_PHASES;
        void* kargs[] = {&a};
        hipError_t e = hipLaunchCooperativeKernel((const void*)skel_fwd, dim3(grid), dim3(NWAVES * 64), kargs, LDS_BYTES, stream);
        if (e != hipSuccess) fprintf(stderr, "cooperative launch failed: %s (grid %d)\n", hipGetErrorString(e), grid);
    } else {
        for (int p = 0; p < N_PHASES; ++p) { a.ph_lo = p; a.ph_hi = p + 1; hipLaunchKernelGGL(skel_fwd, dim3(grid), dim3(NWAVES * 64), LDS_BYTES, stream, a); }
    }
}
```

```cpp
#include <hip/hip_runtime.h>
#include <hip/hip_cooperative_groups.h>
#include <cstdio>
#include <cstdint>
namespace cg = cooperative_groups;
namespace pg8 {
#define PG8_LAS __attribute__((address_space(3)))
typedef unsigned short bf16_t;
typedef short bf16x8 __attribute__((ext_vector_type(8)));
typedef float f32x4 __attribute__((ext_vector_type(4)));
typedef unsigned u32x4 __attribute__((ext_vector_type(4)));
constexpr int BM = 256, BK = 64, HALF = 128, HTB = HALF * BK * 2  , STAGE_BYTES = 8 * HTB, NXCD = 8, WGM = 8;

__host__ __device__ __forceinline__ int lds_byte(int r, int c) { const int st = (r >> 4) * 2 + (c >> 5), rr = r & 15, cc = c & 31, ob = rr * 64 + cc * 2; return st * 1024 + (ob ^ (((ob >> 9) & 1) << 5)); }
__host__ __device__ __forceinline__ void stage_rc(int b, int& R, int& C) { const int st = b / 1024, sb = b % 1024, swz = sb ^ (((sb >> 9) & 1) << 5); R = (st >> 1) * 16 + swz / 64; C = (st & 1) * 32 + (swz % 64) / 2; }
__host__ __device__ __forceinline__ int perm32(int rho) { const int n = rho >> 4, i = rho & 15; return 8 * (i >> 2) + 4 * n + (i & 3); }

struct Unit { int pm, pn; };
struct Gemm { const bf16_t* A; const bf16_t* Bt; int M, N, K; };

struct StaticOrder {
    int nM, nN, nwg, G, c;
    __host__ __device__ void init(int M, int N, int G_, int c_) { nM = M / BM; nN = N / BM; nwg = nM * nN; G = G_; c = c_; }
    __host__ __device__ bool next(int i, Unit& u) const {
        const long L = (long)i * G + c; if (L >= nwg) return false;
        int wgid = (int)L; { const int q = nwg / NXCD, r = nwg % NXCD, xcd = wgid % NXCD, off = wgid / NXCD; wgid = (xcd < r ? xcd * (q + 1) : r * (q + 1) + (xcd - r) * q) + off; }
        const int nig = WGM * nN, gid = wgid / nig, fm = gid * WGM, gsz = (nM - fm) < WGM ? (nM - fm) : WGM;
        u.pm = fm + ((wgid % nig) % gsz); u.pn = (wgid % nig) / gsz; return true;
    }
    __device__ __forceinline__ void a_ready(const Unit&) const {}
    __device__ __forceinline__ void done(const Unit&) const {}
};

__device__ __forceinline__ unsigned cvt_pk_bf16(float lo, float hi) { unsigned r; asm volatile("v_cvt_pk_bf16_f32 %0, %1, %2" : "=v"(r) : "v"(lo), "v"(hi)); return r; }
typedef float f32x2 __attribute__((ext_vector_type(2)));
__device__ __forceinline__ f32x2 gelu_pk(f32x2 v) {
    const f32x2 av = __builtin_elementwise_abs(v), d = av * 0.2316418882f + 1.0f;
    f32x2 t; t.x = __builtin_amdgcn_rcpf(d.x); t.y = __builtin_amdgcn_rcpf(d.y);
    f32x2 q = t * 0.5307027145f + (-0.7265760135f); q = q * t + 0.7107068705f; q = q * t + (-0.142248368f); q = q * t + 0.127414796f; q = q * t;
    const f32x2 s = (v * v) * (-0.72134752044f);
    f32x2 e; e.x = __builtin_amdgcn_exp2f(s.x); e.y = __builtin_amdgcn_exp2f(s.y);
    const f32x2 m = v * (q * e), r = v - m;
    f32x2 o; o.x = v.x < 0.f ? m.x : r.x; o.y = v.y < 0.f ? m.y : r.y; return o;
}

template <int ACT  > struct EpiBf16 {
    static constexpr bool PERM = true, AFTER_DRAIN = false; static_assert(ACT == 0 || ACT == 1, "EpiBf16: ACT is 0 (none) or 1 (gelu_pk)");
    bf16_t* O; int ldc; const float* bias; int split_cols; size_t split_stride; float scale0;
    __device__ __forceinline__ void operator()(const f32x4 (&acc)[2][2][4][2], const Unit& u, int wr, int wc, int fr, int fq) const {
        const int row0 = u.pm * BM + wr * 64 + fr; int colt = u.pn * BM; bf16_t* base = O;
        float sc = 1.f; if (split_cols) { const int t = colt / split_cols; base += (size_t)t * split_stride; colt -= t * split_cols; if (t == 0) sc = scale0; }
        const int col0 = colt + wc * 32 + 8 * fq, bcol0 = u.pn * BM + wc * 32 + 8 * fq;
        f32x4 bv[2][2];
#pragma unroll
        for (int bj = 0; bj < 2; ++bj)
#pragma unroll
            for (int n = 0; n < 2; ++n) bv[bj][n] = bias ? *(const f32x4*)(bias + bcol0 + bj * HALF + 4 * n) : (f32x4){0.f, 0.f, 0.f, 0.f};
#pragma unroll
        for (int ai = 0; ai < 2; ++ai)
#pragma unroll
            for (int m = 0; m < 4; ++m) { bf16_t* rowp = base + (size_t)(row0 + ai * HALF + m * 16) * ldc + col0;
#pragma unroll
                for (int bj = 0; bj < 2; ++bj) { f32x4 v0 = acc[ai][bj][m][0] + bv[bj][0], v1 = acc[ai][bj][m][1] + bv[bj][1];
                    if (ACT == 1) { f32x2 a = gelu_pk((f32x2){v0[0], v0[1]}), b = gelu_pk((f32x2){v0[2], v0[3]}), c = gelu_pk((f32x2){v1[0], v1[1]}), d = gelu_pk((f32x2){v1[2], v1[3]});
                        v0 = (f32x4){a.x, a.y, b.x, b.y}; v1 = (f32x4){c.x, c.y, d.x, d.y}; }
                    v0 = v0 * sc; v1 = v1 * sc; u32x4 w; w.x = cvt_pk_bf16(v0[0], v0[1]); w.y = cvt_pk_bf16(v0[2], v0[3]); w.z = cvt_pk_bf16(v1[0], v1[1]); w.w = cvt_pk_bf16(v1[2], v1[3]);
                    *(u32x4*)(rowp + bj * HALF) = w; } }
    }
};
typedef float f32x2e __attribute__((ext_vector_type(2)));
struct EpiInProj {
    static constexpr bool PERM = true, AFTER_DRAIN = false;
    bf16_t* QKV; bf16_t* ZR; const float* rope;
    __device__ __forceinline__ void operator()(const f32x4 (&acc)[2][2][4][2], const Unit& u, int wr, int wc, int fr, int fq) const {
        const int row0 = u.pm * BM + wr * 64 + fr; const int colt = u.pn * BM;
        if (colt >= 768) {
#pragma unroll
            for (int ai = 0; ai < 2; ++ai)
#pragma unroll
                for (int m = 0; m < 4; ++m) { bf16_t* rowp = ZR + (size_t)(row0 + ai * HALF + m * 16) * 1792 + (colt - 768) + wc * 32 + 8 * fq;
#pragma unroll
                    for (int bj = 0; bj < 2; ++bj) { const f32x4 v0 = acc[ai][bj][m][0], v1 = acc[ai][bj][m][1];
                        u32x4 w; w.x = cvt_pk_bf16(v0[0], v0[1]); w.y = cvt_pk_bf16(v0[2], v0[3]); w.z = cvt_pk_bf16(v1[0], v1[1]); w.w = cvt_pk_bf16(v1[2], v1[3]);
                        *(u32x4*)(rowp + bj * HALF) = w; } }
            return;
        }
        const bool latent = u.pm < 128;
        const int axis = wc & 1;
        const float sgn = (fq < 2) ? -1.f : 1.f;
#pragma unroll
        for (int ai = 0; ai < 2; ++ai)
#pragma unroll
            for (int m = 0; m < 4; ++m) {
                const int row = row0 + ai * HALF + m * 16; const int t = row & 8191; const int pos = axis ? (t & 63) : (t >> 6);
                f32x4 cs[4];
                if (latent) {
#pragma unroll
                    for (int i = 0; i < 4; ++i) cs[i] = *(const f32x4*)(rope + (size_t)(pos * 16 + 8 * (fq & 1) + 2 * i) * 2);
                }
                bf16_t* rowp = QKV + (size_t)row * 768 + colt + wc * 32 + 8 * fq;
#pragma unroll
                for (int bj = 0; bj < 2; ++bj) {
                    const int colb = colt + bj * HALF;
                    const bool is_v = (colb == 640), is_q = (colb < 512);
                    f32x4 v0 = acc[ai][bj][m][0], v1 = acc[ai][bj][m][1];
                    if (latent && !is_v) {
                        f32x4 o0, o1;
#pragma unroll
                        for (int e = 0; e < 4; ++e) { o0[e] = __shfl_xor(v0[e], 32); o1[e] = __shfl_xor(v1[e], 32); }
                        v0[0] = v0[0] * cs[0][0] + sgn * o0[0] * cs[0][1]; v0[1] = v0[1] * cs[0][2] + sgn * o0[1] * cs[0][3];
                        v0[2] = v0[2] * cs[1][0] + sgn * o0[2] * cs[1][1]; v0[3] = v0[3] * cs[1][2] + sgn * o0[3] * cs[1][3];
                        v1[0] = v1[0] * cs[2][0] + sgn * o1[0] * cs[2][1]; v1[1] = v1[1] * cs[2][2] + sgn * o1[1] * cs[2][3];
                        v1[2] = v1[2] * cs[3][0] + sgn * o1[2] * cs[3][1]; v1[3] = v1[3] * cs[3][2] + sgn * o1[3] * cs[3][3];
                    }
                    if (is_q) { v0 = v0 * 0.18033688011112042f; v1 = v1 * 0.18033688011112042f; }
                    u32x4 w; w.x = cvt_pk_bf16(v0[0], v0[1]); w.y = cvt_pk_bf16(v0[2], v0[3]); w.z = cvt_pk_bf16(v1[0], v1[1]); w.w = cvt_pk_bf16(v1[2], v1[3]);
                    *(u32x4*)(rowp + bj * HALF) = w;
                }
            }
    }
};
template <bool FFTROWS, bool BIN, bool BOUT> struct EpiResidualT {
    static constexpr bool PERM = true, AFTER_DRAIN = false;
    const void* base; void* out; const float* gate; int gate_stride;
    __device__ __forceinline__ void operator()(const f32x4 (&acc)[2][2][4][2], const Unit& u, int wr, int wc, int fr, int fq) const {
        const int row0 = u.pm * BM + wr * 64 + fr; const int col0 = u.pn * BM + wc * 32 + 8 * fq;
        const float* gp = gate + (size_t)(u.pm >> 5) * gate_stride + col0;
        f32x4 gv[2][2];
#pragma unroll
        for (int bj = 0; bj < 2; ++bj)
#pragma unroll
            for (int n = 0; n < 2; ++n) gv[bj][n] = *(const f32x4*)(gp + bj * HALF + n * 4);
#pragma unroll
        for (int ai = 0; ai < 2; ++ai)
#pragma unroll
            for (int m = 0; m < 4; ++m) { int row = row0 + ai * HALF + m * 16;
                if (FFTROWS) row = (row & ~8191) | ((row >> 7) & 63) | ((row & 127) << 6);
                const size_t off = (size_t)row * 1024 + col0;
#pragma unroll
                for (int bj = 0; bj < 2; ++bj) {
                    f32x4 b0, b1;
                    if (BIN) { const u32x4 w = *(const u32x4*)((const bf16_t*)base + off + bj * HALF);
                        b0 = (f32x4){__builtin_bit_cast(float, w.x << 16), __builtin_bit_cast(float, w.x & 0xffff0000u), __builtin_bit_cast(float, w.y << 16), __builtin_bit_cast(float, w.y & 0xffff0000u)};
                        b1 = (f32x4){__builtin_bit_cast(float, w.z << 16), __builtin_bit_cast(float, w.z & 0xffff0000u), __builtin_bit_cast(float, w.w << 16), __builtin_bit_cast(float, w.w & 0xffff0000u)}; }
                    else { b0 = *(const f32x4*)((const float*)base + off + bj * HALF); b1 = *(const f32x4*)((const float*)base + off + bj * HALF + 4); }
                    const f32x4 o0 = b0 + gv[bj][0] * acc[ai][bj][m][0], o1 = b1 + gv[bj][1] * acc[ai][bj][m][1];
                    if (BOUT) { u32x4 w; w.x = cvt_pk_bf16(o0[0], o0[1]); w.y = cvt_pk_bf16(o0[2], o0[3]); w.z = cvt_pk_bf16(o1[0], o1[1]); w.w = cvt_pk_bf16(o1[2], o1[3]); *(u32x4*)((bf16_t*)out + off + bj * HALF) = w; }
                    else { *(f32x4*)((float*)out + off + bj * HALF) = o0; *(f32x4*)((float*)out + off + bj * HALF + 4) = o1; }
                } }
    }
};
template <int ACT, bool FFTROWS = false> struct EpiStore {
    static constexpr bool PERM = true, AFTER_DRAIN = false;
    bf16_t* O; int ldc;
    __device__ __forceinline__ void operator()(const f32x4 (&acc)[2][2][4][2], const Unit& u, int wr, int wc, int fr, int fq) const {
        const int row0 = u.pm * BM + wr * 64 + fr; const int col0 = u.pn * BM + wc * 32 + 8 * fq;
#pragma unroll
        for (int ai = 0; ai < 2; ++ai)
#pragma unroll
            for (int m = 0; m < 4; ++m) { int row = row0 + ai * HALF + m * 16;
                if (FFTROWS) { const int g = row & 3, l = (row >> 2) & 8191, b = row >> 15; row = (((b * 128 + (l & 127)) * 4 + g) << 6) | (l >> 7); }
                bf16_t* rowp = O + (size_t)row * ldc + col0;
#pragma unroll
                for (int bj = 0; bj < 2; ++bj) { f32x4 v0 = acc[ai][bj][m][0], v1 = acc[ai][bj][m][1];
                    if (ACT == 2) {
#pragma unroll
                        for (int e = 0; e < 4; ++e) { const float a = fmaxf(v0[e], 0.f), b = fmaxf(v1[e], 0.f); v0[e] = a * a; v1[e] = b * b; }
                    }
                    u32x4 w; w.x = cvt_pk_bf16(v0[0], v0[1]); w.y = cvt_pk_bf16(v0[2], v0[3]); w.z = cvt_pk_bf16(v1[0], v1[1]); w.w = cvt_pk_bf16(v1[2], v1[3]);
                    *(u32x4*)(rowp + bj * HALF) = w; } }
    }
};
template <class Epi, class Sched, bool ALIGN_EPI = false, bool SP2 = false>
__device__ __forceinline__ void gemm_phase(PG8_LAS unsigned char* lds, const Gemm g, const Sched& S, const Epi& E) {
    const int tid = threadIdx.x, wid = __builtin_amdgcn_readfirstlane(tid >> 6), lane = tid & 63, wr = wid >> 2, wc = wid & 3, fr = lane & 15, fq = lane >> 4;
    int K_ = g.K; asm volatile("" : "+s"(K_)); const int K = K_, nt = K / BK;
    unsigned voffA[2], voffB[2];
#pragma unroll
    for (int i = 0; i < 2; ++i) { int R, C; stage_rc(tid * 16 + i * 8192, R, C); const int Rb = Epi::PERM ? ((R & ~31) + perm32(R & 31)) : R;
        voffA[i] = (unsigned)(R * K + C) * 2u; voffB[i] = (unsigned)(Rb * K + C) * 2u; }
    const size_t kstep = (size_t)(BK * 2);
    const size_t hstep = (size_t)HALF * K * 2;
    const size_t tstep = 2 * hstep;
    const unsigned ldsw = (unsigned)wid * 1024u;
    const int aoff = lds_byte(wr * 64 + fr, fq * 8), boff = lds_byte(wc * 32 + fr, fq * 8);
#define PG8_SA(b, h) (((b) * 2 + (h)) * HTB)
#define PG8_SB(b, h) ((4 + (b) * 2 + (h)) * HTB)
#define PG8_STAGE(bufoff, gbase, voff) do { _Pragma("unroll") for (int _i = 0; _i < 2; ++_i) \
        __builtin_amdgcn_global_load_lds((const unsigned*)((const char*)(gbase) + (voff)[_i]), (PG8_LAS unsigned*)(lds + (bufoff) + ldsw + _i * 8192), 16, 0, 0); } while (0)
#define PG8_LDA(dst, b, h) do { _Pragma("unroll") for (int m = 0; m < 4; ++m) _Pragma("unroll") for (int k = 0; k < 2; ++k) dst[m][k] = *(const PG8_LAS bf16x8*)(lds + PG8_SA(b, h) + aoff + m * 2048 + k * 1024); } while (0)
#define PG8_LDB(dst, b, h) do { _Pragma("unroll") for (int n = 0; n < 2; ++n) _Pragma("unroll") for (int k = 0; k < 2; ++k) dst[n][k] = *(const PG8_LAS bf16x8*)(lds + PG8_SB(b, h) + boff + n * 2048 + k * 1024); } while (0)
#define PG8_MMA(ai, bj, At, Bt) do { __builtin_amdgcn_s_setprio(1); _Pragma("unroll") for (int m = 0; m < 4; ++m) _Pragma("unroll") for (int n = 0; n < 2; ++n) _Pragma("unroll") for (int k = 0; k < 2; ++k) \
        acc[ai][bj][m][n] = __builtin_amdgcn_mfma_f32_16x16x32_bf16(Bt[n][k], At[m][k], acc[ai][bj][m][n], 0, 0, 0); __builtin_amdgcn_s_setprio(0); } while (0)
#define PG8_WAIT_V(n) asm volatile("s_waitcnt vmcnt(" #n ")" ::: "memory")
#define PG8_WAIT_L(n) asm volatile("s_waitcnt lgkmcnt(" #n ")" ::: "memory")
#define PG8_BAR __builtin_amdgcn_s_barrier()
#define PG8_SCHED __builtin_amdgcn_sched_barrier(0)
    Unit cur, nxt; int ui = 0;
    if (!S.next(0, cur)) return;
    f32x4 acc[2][2][4][2];
#pragma unroll
    for (int a = 0; a < 2; ++a)
#pragma unroll
        for (int b = 0; b < 2; ++b)
#pragma unroll
            for (int m = 0; m < 4; ++m)
#pragma unroll
                for (int n = 0; n < 2; ++n) acc[a][b][m][n] = (f32x4){0.f, 0.f, 0.f, 0.f};
    bf16x8 At[4][2], B0[2][2], B1[2][2];
    const char* cA = (const char*)g.A + (size_t)cur.pm * tstep; const char* cB = (const char*)g.Bt + (size_t)cur.pn * tstep;
    S.a_ready(cur);
    if constexpr (SP2) {
        PG8_STAGE(PG8_SB(0, 0), cB, voffB); PG8_STAGE(PG8_SB(0, 1), cB + hstep, voffB); PG8_STAGE(PG8_SA(0, 0), cA, voffA); PG8_STAGE(PG8_SA(0, 1), cA + hstep, voffA);
        if (wr == 1) PG8_BAR;
        PG8_WAIT_V(2); PG8_BAR;
        PG8_STAGE(PG8_SB(1, 0), cB + kstep, voffB); PG8_STAGE(PG8_SA(1, 0), cA + kstep, voffA); PG8_STAGE(PG8_SB(1, 1), cB + hstep + kstep, voffB);
        PG8_WAIT_V(6); PG8_BAR;
    } else {
        PG8_STAGE(PG8_SB(0, 0), cB, voffB); PG8_STAGE(PG8_SA(0, 0), cA, voffA); PG8_STAGE(PG8_SB(0, 1), cB + hstep, voffB); PG8_STAGE(PG8_SA(0, 1), cA + hstep, voffA);
        if (wr == 1) PG8_BAR;
        PG8_WAIT_V(4); PG8_BAR;
        PG8_STAGE(PG8_SB(1, 0), cB + kstep, voffB); PG8_STAGE(PG8_SA(1, 0), cA + kstep, voffA); PG8_STAGE(PG8_SB(1, 1), cB + hstep + kstep, voffB);
        PG8_WAIT_V(6); PG8_BAR;
    }
    for (;;) {
        const bool has_next = S.next(ui + 1, nxt);
        const char* nA = has_next ? (const char*)g.A + (size_t)nxt.pm * tstep : cA; const char* nB = has_next ? (const char*)g.Bt + (size_t)nxt.pn * tstep : cB;
        for (int t = 0; t < nt; t += 2) {
            const bool last = (t == nt - 2);
            const char* a1 = cA + (size_t)(t + 1) * kstep;
            const char* a2 = last ? nA : cA + (size_t)(t + 2) * kstep; const char* b2 = last ? nB : cB + (size_t)(t + 2) * kstep;
            const char* a3 = a2 + kstep; const char* b3 = b2 + kstep;
            if (last && has_next) S.a_ready(nxt);
            if constexpr (SP2) {
            PG8_LDB(B0, 0, 0); PG8_LDB(B1, 0, 1); PG8_SCHED; PG8_LDA(At, 0, 0); PG8_STAGE(PG8_SA(1, 1), a1 + hstep, voffA);
            PG8_WAIT_V(8); PG8_WAIT_L(0); PG8_BAR; PG8_MMA(0, 0, At, B0); PG8_MMA(0, 1, At, B1); PG8_BAR; PG8_SCHED;
            PG8_LDA(At, 0, 1); PG8_STAGE(PG8_SB(0, 0), b2, voffB); PG8_STAGE(PG8_SB(0, 1), b2 + hstep, voffB); PG8_STAGE(PG8_SA(0, 0), a2, voffA);
            PG8_WAIT_V(8); PG8_WAIT_L(0); PG8_BAR; PG8_MMA(1, 0, At, B0); PG8_MMA(1, 1, At, B1); PG8_BAR; PG8_SCHED;
            PG8_LDB(B0, 1, 0); PG8_LDB(B1, 1, 1); PG8_SCHED; PG8_LDA(At, 1, 0); PG8_STAGE(PG8_SA(0, 1), a2 + hstep, voffA);
            PG8_WAIT_V(8); PG8_WAIT_L(0); PG8_BAR; PG8_MMA(0, 0, At, B0); PG8_MMA(0, 1, At, B1); PG8_BAR; PG8_SCHED;
            PG8_LDA(At, 1, 1); PG8_STAGE(PG8_SB(1, 0), b3, voffB); PG8_STAGE(PG8_SB(1, 1), b3 + hstep, voffB); PG8_STAGE(PG8_SA(1, 0), a3, voffA);
            PG8_WAIT_V(8); PG8_WAIT_L(0); PG8_BAR; PG8_MMA(1, 0, At, B0); PG8_MMA(1, 1, At, B1); PG8_BAR; PG8_SCHED;
            } else {
            PG8_LDB(B0, 0, 0); PG8_SCHED; PG8_LDA(At, 0, 0); PG8_STAGE(PG8_SA(1, 1), a1 + hstep, voffA);
            PG8_WAIT_L(8); PG8_BAR; PG8_WAIT_L(0); PG8_MMA(0, 0, At, B0); PG8_BAR; PG8_SCHED;
            PG8_LDB(B1, 0, 1); PG8_STAGE(PG8_SB(0, 0), b2, voffB);
            PG8_BAR; PG8_WAIT_L(0); PG8_MMA(0, 1, At, B1); PG8_BAR;
            PG8_LDA(At, 0, 1); PG8_STAGE(PG8_SA(0, 0), a2, voffA);
            PG8_BAR; PG8_WAIT_L(0); PG8_MMA(1, 0, At, B0); PG8_BAR; PG8_SCHED;
            PG8_STAGE(PG8_SB(0, 1), b2 + hstep, voffB);
            PG8_WAIT_V(6); PG8_BAR; PG8_MMA(1, 1, At, B1); PG8_BAR;
            PG8_LDB(B0, 1, 0); PG8_SCHED; PG8_LDA(At, 1, 0); PG8_STAGE(PG8_SA(0, 1), a2 + hstep, voffA);
            PG8_WAIT_L(8); PG8_BAR; PG8_WAIT_L(0); PG8_MMA(0, 0, At, B0); PG8_BAR; PG8_SCHED;
            PG8_LDB(B1, 1, 1); PG8_STAGE(PG8_SB(1, 0), b3, voffB);
            PG8_BAR; PG8_WAIT_L(0); PG8_MMA(0, 1, At, B1); PG8_BAR;
            PG8_LDA(At, 1, 1); PG8_STAGE(PG8_SA(1, 0), a3, voffA);
            PG8_BAR; PG8_WAIT_L(0); PG8_MMA(1, 0, At, B0); PG8_BAR; PG8_SCHED;
            PG8_STAGE(PG8_SB(1, 1), b3 + hstep, voffB);
            PG8_WAIT_V(6); PG8_BAR; PG8_MMA(1, 1, At, B1); PG8_BAR;
            }
        }
        if constexpr (ALIGN_EPI) { if (wr == 0) PG8_BAR; }
        if constexpr (!Epi::AFTER_DRAIN) { E(acc, cur, wr, wc, fr, fq); S.done(cur); }
        if (!has_next) break;
#pragma unroll
        for (int a = 0; a < 2; ++a)
#pragma unroll
            for (int b = 0; b < 2; ++b)
#pragma unroll
                for (int m = 0; m < 4; ++m)
#pragma unroll
                    for (int n = 0; n < 2; ++n) acc[a][b][m][n] = (f32x4){0.f, 0.f, 0.f, 0.f};
        cur = nxt; cA = nA; cB = nB; ++ui;
        if constexpr (ALIGN_EPI) { if (wr == 1) PG8_BAR; }
    }
    PG8_WAIT_V(0);
    if constexpr (!ALIGN_EPI) { if (wr == 0) PG8_BAR; }
    PG8_BAR;
    if constexpr (Epi::AFTER_DRAIN) { E.fused(acc, cur, wr, wc, fr, fq, lds, wid, lane); S.done(cur); }
#undef PG8_SA
#undef PG8_SB
#undef PG8_STAGE
#undef PG8_LDA
#undef PG8_LDB
#undef PG8_MMA
#undef PG8_WAIT_V
#undef PG8_WAIT_L
#undef PG8_BAR
#undef PG8_SCHED
}
}
constexpr int NWAVES = 8;
constexpr int BATCH = 4, SEQ = 8192, DM = 1024, CTXL = 256, FF = 4096;
constexpr int ML = BATCH * SEQ;
constexpr int MC = BATCH * CTXL;
constexpr int MALL = ML + MC;
constexpr int INCOLS = 2560, RWC = 1792;
constexpr float NORM_EPS = 1e-6f, GN_EPS = 64e-5f;
#ifndef MK_N_LAUNCHES
#define MK_N_LAUNCHES 1
#endif
constexpr int N_PHASES = 19;

constexpr size_t MiB = 1u << 20;
constexpr size_t WS_MOD = 0;
constexpr size_t WS_ROPE = 256 * 1024;
constexpr size_t WS_TW = 320 * 1024;
constexpr size_t WS_DFTC = 384 * 1024;
constexpr size_t WS_W2A = 640 * 1024;
constexpr size_t WS_W2B = 704 * 1024;
constexpr size_t WS_LW2 = 768 * 1024;
constexpr size_t WS_LA2 = 896 * 1024;
constexpr size_t WS_LG2 = 1024 * 1024;
constexpr size_t WS_ZERO = 1152 * 1024;
constexpr size_t WS_INVN = 1280 * 1024;
constexpr size_t WS_BAR = 2400 * 1024;
constexpr size_t WS_WIN = 3 * MiB, WS_WOUT = 8 * MiB, WS_WF = 10 * MiB, WS_W1 = 12 * MiB  , WS_W2 = 28 * MiB  ;
constexpr size_t WS_XN = 44 * MiB;
constexpr size_t WS_QT = 44 * MiB;
constexpr size_t WS_QKV = 110 * MiB;
constexpr size_t WS_ZR = 160 * MiB;
constexpr size_t WS_MT = 160 * MiB;
constexpr size_t WS_NN = 226 * MiB;
constexpr size_t WS_LIN = 292 * MiB;
constexpr size_t WS_SS = 301 * MiB;
constexpr size_t WS_ZS = 340 * MiB;
constexpr size_t WS_ATTRW = 439 * MiB;
constexpr size_t WS_XR = 108 * MiB;
constexpr size_t WS_H = 172 * MiB;
constexpr size_t WS_G1 = 160 * MiB;
constexpr size_t WS_Y1 = 288 * MiB;
constexpr size_t WS_F1 = 416 * MiB;
constexpr size_t WS_END = 512 * MiB;
constexpr size_t DO_Y = 0, DO_G = 64 * MiB, DO_SS = 96 * MiB;

constexpr int RING_BYTES = 131072;
constexpr int LDS_BYTES = 151552;
constexpr int MISC_OFF = 150528;

#define GAS __attribute__((address_space(1)))
#define LAS __attribute__((address_space(3)))
typedef unsigned short bf16;
typedef unsigned v4u __attribute__((ext_vector_type(4)));
typedef unsigned v2u __attribute__((ext_vector_type(2)));
typedef float f32x4 __attribute__((ext_vector_type(4)));
typedef float f32x16 __attribute__((ext_vector_type(16)));
typedef short bf16x8 __attribute__((ext_vector_type(8)));
typedef short s16x4 __attribute__((ext_vector_type(4)));
#define LDS_WAIT() asm volatile("s_waitcnt lgkmcnt(0)" ::: "memory")
typedef float f32x2p __attribute__((ext_vector_type(2))); typedef __bf16 bf16x2p __attribute__((ext_vector_type(2)));
__device__ __forceinline__ unsigned pk2(float lo, float hi) { const f32x2p v = {lo, hi}; return __builtin_bit_cast(unsigned, __builtin_convertvector(v, bf16x2p)); }
__device__ __forceinline__ unsigned f2bf(float f) { return pk2(f, 0.f) & 0xffffu; }
__device__ __forceinline__ float bf_lo(unsigned u) { return __builtin_bit_cast(float, u << 16); }
__device__ __forceinline__ float bf_hi(unsigned u) { return __builtin_bit_cast(float, u & 0xffff0000u); }
__device__ __forceinline__ float bf1(bf16 u) { return __builtin_bit_cast(float, (unsigned)u << 16); }
__device__ __forceinline__ float wave_sum(float v) {
#pragma unroll
    for (int o = 1; o < 64; o <<= 1) v += __shfl_xor(v, o);
    return v;
}
template <int CTRL> __device__ __forceinline__ float dppf(float x) { return __builtin_bit_cast(float, __builtin_amdgcn_mov_dpp(__builtin_bit_cast(int, x), CTRL, 0xf, 0xf, true)); }
__device__ __forceinline__ float sum8(float x) { x += dppf<0xB1>(x); x += dppf<0x4E>(x); x += dppf<0x141>(x); return x; }
__device__ __forceinline__ float sigmoidf_(float x) { return __builtin_amdgcn_rcpf(1.f + __expf(-x)); }

typedef GAS unsigned gu32;
typedef GAS unsigned long long gu64;
#define RLX_AGENT __ATOMIC_RELAXED, __HIP_MEMORY_SCOPE_AGENT
#define XB_TMO      128
#define XB_XCNT(j)  (256  + 64 * (j))
#define XB_XSUB(j)  (1280 + 64 * (j))
#define XB_XGEN(j)  (2304 + 64 * (j))
#define XB_TOP      3328
#define XB_TOPGEN   3392
#define XCD_BAR_WORDS 3456
#define XB_SPIN_CAP (1u << 18)

__device__ __forceinline__ unsigned xb_ld(unsigned* p)              { return __hip_atomic_load(p, __ATOMIC_RELAXED, __HIP_MEMORY_SCOPE_AGENT); }
__device__ __forceinline__ unsigned xb_add(unsigned* p, unsigned v) { return __hip_atomic_fetch_add(p, v, __ATOMIC_RELAXED, __HIP_MEMORY_SCOPE_AGENT); }
__device__ __forceinline__ unsigned xb_xcc_id() { return (unsigned)__builtin_amdgcn_s_getreg((3 << 11) | 20) & 0xFu; }
#define XB_SPIN(cond, bar) do { unsigned _sp = 0; while (cond) { __builtin_amdgcn_s_sleep(1); \
    if ((++_sp & 255u) == 0u) { if (xb_ld(&(bar)[XB_TMO])) break; if (_sp > XB_SPIN_CAP) { atomicAdd(&(bar)[XB_TMO], 1u); break; } } } } while (0)

struct XcdBarrier {
    unsigned* bar; unsigned x;
    volatile LAS unsigned* st;
};

__device__ __forceinline__ XcdBarrier xcd_barrier_post(unsigned* bar, volatile LAS unsigned* st) {
    XcdBarrier b; b.bar = bar; b.x = xb_xcc_id(); b.st = st;
    if (threadIdx.x == 0) (void)xb_add(&bar[XB_XCNT(b.x)], 1u);
    return b;
}
__device__ __forceinline__ void xcd_barrier_complete(unsigned* bar, unsigned x, unsigned& nloc, unsigned& nx) {
    const unsigned G = gridDim.x * gridDim.y * gridDim.z;
    unsigned sum, cnt, mine, sp = 0u;
    for (;;) {
        sum = 0u; cnt = 0u; mine = 0u;
#pragma unroll
        for (unsigned j = 0; j < 16; ++j) { const unsigned c = xb_ld(&bar[XB_XCNT(j)]); sum += c; cnt += (c > 0u) ? 1u : 0u; mine = (j == x) ? c : mine; }
        if (sum == G) break;
        __builtin_amdgcn_s_sleep(1);
        if ((++sp & 255u) == 0u) { if (xb_ld(&bar[XB_TMO])) break; if (sp > XB_SPIN_CAP) { atomicAdd(&bar[XB_TMO], 1u); break; } }
    }
    nloc = mine > 0u ? mine : 1u; nx = cnt > 0u ? cnt : 1u;
}

__device__ __forceinline__ void xcd_barrier(const XcdBarrier& b) {
    asm volatile("s_waitcnt vmcnt(0)" ::: "memory");
    __syncthreads();
    if (threadIdx.x == 0) {
        unsigned* bar = b.bar;
        __builtin_amdgcn_s_waitcnt(0);
        unsigned nloc = b.st[0], nx = b.st[1];
        if (nloc == 0u) { xcd_barrier_complete(bar, b.x, nloc, nx); b.st[0] = nloc; b.st[1] = nx; }
        const unsigned old = xb_add(&bar[XB_XSUB(b.x)], 1u);
        const unsigned gen = old / nloc;
        if (old + 1u == (gen + 1u) * nloc) {
            __builtin_amdgcn_fence(__ATOMIC_RELEASE, "agent");
            asm volatile("s_waitcnt vmcnt(0)" ::: "memory");
            const unsigned og = xb_add(&bar[XB_TOP], 1u);
            const unsigned tg = og / nx;
            if (og + 1u == (tg + 1u) * nx) xb_add(&bar[XB_TOPGEN], 1u);
            else XB_SPIN(xb_ld(&bar[XB_TOPGEN]) == tg, bar);
            __builtin_amdgcn_fence(__ATOMIC_ACQUIRE, "agent");
            xb_add(&bar[XB_XGEN(b.x)], 1u);
            asm volatile("s_waitcnt vmcnt(0)" ::: "memory");
        } else {
            XB_SPIN(xb_ld(&bar[XB_XGEN(b.x)]) == gen, bar);
            __builtin_amdgcn_fence(__ATOMIC_ACQUIRE, "agent");
            asm volatile("s_waitcnt vmcnt(0)" ::: "memory");
        }
    }
    __syncthreads();
}

struct Frame {
    LAS unsigned char* lds;
    int tid, lane, wave, vcu, G;
    unsigned char* ws; float* out;
};
struct Args { const float* in[27]; float* out; unsigned char* ws; int ph_lo, ph_hi; };
enum { I_X = 0, I_C, I_CTX, I_CCTX, I_ADAW, I_ADAB, I_N1G, I_N2G, I_WIN, I_WOUT, I_SINK, I_MUP, I_MUN, I_DW0, I_DW2, I_IA0, I_IA2, I_GG2, I_KK, I_KA, I_RK, I_LNG, I_LNB, I_FW, I_W1, I_W2, I_FING };

__device__ __forceinline__ void p0_transpose_item(const float* W, int K, int N, bf16* WT, LAS float* scr, int item, int lane, float scale) {
    const int nblk = N / 32, kb = item / nblk, nb = item % nblk, k0 = 64 * kb, n0 = 32 * nb;
#pragma unroll 8
    for (int i = 0; i < 32; ++i) { const int kk = 2 * i + (lane >> 5); scr[kk * 33 + (lane & 31)] = W[(size_t)(k0 + kk) * N + n0 + (lane & 31)] * scale; }
    LDS_WAIT(); asm volatile("" ::: "memory");
    const int c = lane & 7;
#pragma unroll
    for (int j = 0; j < 4; ++j) { const int n = (lane >> 3) + 8 * j; const LAS float* s = scr + (8 * c) * 33 + n;
        v4u o; o.x = pk2(s[0 * 33], s[1 * 33]); o.y = pk2(s[2 * 33], s[3 * 33]); o.z = pk2(s[4 * 33], s[5 * 33]); o.w = pk2(s[6 * 33], s[7 * 33]);
        *(GAS v4u*)(WT + (size_t)(n0 + n) * K + k0 + 8 * c) = o; }
    LDS_WAIT(); asm volatile("" ::: "memory");
}
__device__ __forceinline__ void p0_prologue(Frame& F, const Args& A_) {
    LAS float* scr = (LAS float*)(F.lds + F.wave * 16384);
    const int gw = F.vcu * NWAVES + F.wave, NGW = F.G * NWAVES;
    constexpr int I_IN = 16 * 80, I_O = 16 * 32, I_U = 16 * 128, I_D = 64 * 32;
    constexpr int I_LW = 2 * 16, I_LG = 2 * 16;
    constexpr int NITEMS = I_IN + 2 * I_O + 2 * I_U + 2 * I_D + 2 * I_LW + I_LG;
    for (int it = gw; it < NITEMS; it += NGW) {
        int r = it;
        if (r < I_IN) { p0_transpose_item(A_.in[I_WIN], 1024, INCOLS, (bf16*)(F.ws + WS_WIN), scr, r, F.lane, 1.f); continue; } r -= I_IN;
        if (r < I_O) { p0_transpose_item(A_.in[I_WOUT], 1024, 1024, (bf16*)(F.ws + WS_WOUT), scr, r, F.lane, 1.f); continue; } r -= I_O;
        if (r < I_O) { p0_transpose_item(A_.in[I_FW], 1024, 1024, (bf16*)(F.ws + WS_WF), scr, r, F.lane, 1.f); continue; } r -= I_O;
        if (r < 2 * I_U) { const int l = r / I_U; p0_transpose_item(A_.in[I_W1] + (size_t)l * 1024 * FF, 1024, FF, (bf16*)(F.ws + WS_W1) + (size_t)l * 1024 * FF, scr, r % I_U, F.lane, 1.f); continue; } r -= 2 * I_U;
        if (r < 2 * I_D) { const int l = r / I_D; p0_transpose_item(A_.in[I_W2] + (size_t)l * 1024 * FF, FF, 1024, (bf16*)(F.ws + WS_W2) + (size_t)l * 1024 * FF, scr, r % I_D, F.lane, 1.f); continue; } r -= 2 * I_D;
        if (r < I_LW) { const int d = r / 16; p0_transpose_item(A_.in[I_DW2] + (size_t)d * 64 * 512, 64, 512, (bf16*)(F.ws + WS_LW2) + (size_t)d * 512 * 64, scr, r % 16, F.lane, 1.f); continue; } r -= I_LW;
        if (r < I_LW) { const int d = r / 16; p0_transpose_item(A_.in[I_IA2] + (size_t)d * 64 * 512, 64, 512, (bf16*)(F.ws + WS_LA2) + (size_t)d * 512 * 64, scr, r % 16, F.lane, 1.f); continue; } r -= I_LW;
        p0_transpose_item(A_.in[I_GG2], 128, 512, (bf16*)(F.ws + WS_LG2), scr, r, F.lane, 1.f);
    }
    const int gt = F.vcu * 512 + F.tid, NGT = F.G * 512;
    const float TWO_PI = 6.283185307179586f;
    for (int i = gt; i < 128 * 16; i += NGT) {
        const int pos = i >> 4, j = i & 15; const float inv = exp2f(-(float)j * (13.287712379549449f / 16.f));
        const float ang = (float)pos * inv; const float rev = ang * 0.15915494309189535f;
        float* o = (float*)(F.ws + WS_ROPE) + 2 * i; o[0] = __builtin_amdgcn_cosf(rev - floorf(rev)); o[1] = __builtin_amdgcn_sinf(rev - floorf(rev));
    }
    for (int i = gt; i < 8192; i += NGT) { const float rev = (float)i * (1.f / 8192.f); float* o = (float*)(F.ws + WS_TW) + 2 * i; o[0] = __builtin_amdgcn_cosf(rev); o[1] = __builtin_amdgcn_sinf(rev); }
    for (int i = gt; i < 512 * 256; i += NGT) {
        const int j = i >> 8, c = i & 255; const int ph = (c * (j & 255)) & 255; const float rev = (float)ph * (1.f / 256.f);
        const float v = (j < 256) ? __builtin_amdgcn_cosf(rev) : -__builtin_amdgcn_sinf(rev);
        ((bf16*)(F.ws + WS_DFTC))[i] = (bf16)f2bf(v * 0.0625f);
    }
    for (int i = gt; i < 128 * 128; i += NGT) {
        const int o = i >> 7, k = i & 127; const int pp = o >> 6, l1p = o & 63, p = k >> 6, l1 = k & 63; const float rev = (float)((l1 * l1p) & 63) * (1.f / 64.f);
        const float cs = __builtin_amdgcn_cosf(rev), sn = __builtin_amdgcn_sinf(rev);
        const float v = (pp == 0) ? (p == 0 ? cs : sn) : (p == 0 ? -sn : cs);
        ((bf16*)(F.ws + WS_W2A))[i] = (bf16)f2bf(v * 0.125f);
    }
    for (int i = gt; i < 128 * 256; i += NGT) {
        const int o = i >> 8, k = i & 255; const int p = k >> 7, l2 = k & 127; const float rev = (float)((l2 * o) & 127) * (1.f / 128.f);
        const float v = (p == 0) ? __builtin_amdgcn_cosf(rev) : __builtin_amdgcn_sinf(rev);
        ((bf16*)(F.ws + WS_W2B))[i] = (bf16)f2bf(v * 0.08838834764831845f);
    }
    for (int i = gt; i < 1024; i += NGT) ((float*)(F.ws + WS_ZERO))[i] = 0.f;
    {
        LAS float* sl = (LAS float*)(F.lds + 0);
        __syncthreads();
        for (int i = F.tid; i < 5 * 1024; i += 512) { const int r = i >> 10, k = i & 1023; const float cv = (r < 4) ? A_.in[I_C][r * 1024 + k] : A_.in[I_CCTX][k]; sl[i] = cv * sigmoidf_(cv); }
        __syncthreads();
        LAS float* red = (LAS float*)(F.lds + 32768);
        for (int item = F.vcu; item < 2 * 96; item += F.G) {
            const int layer = item / 96, n0 = (item % 96) * 64;
            const float* W = A_.in[I_ADAW] + (size_t)layer * 1024 * 6144 + n0 + F.lane;
            float a0 = 0.f, a1 = 0.f, a2 = 0.f, a3 = 0.f, a4 = 0.f;
            const int k0 = F.wave * 128;
#pragma unroll 8
            for (int k = k0; k < k0 + 128; ++k) { const float w = W[(size_t)k * 6144]; a0 += sl[k] * w; a1 += sl[1024 + k] * w; a2 += sl[2048 + k] * w; a3 += sl[3072 + k] * w; a4 += sl[4096 + k] * w; }
            red[(F.wave * 5 + 0) * 64 + F.lane] = a0; red[(F.wave * 5 + 1) * 64 + F.lane] = a1; red[(F.wave * 5 + 2) * 64 + F.lane] = a2; red[(F.wave * 5 + 3) * 64 + F.lane] = a3; red[(F.wave * 5 + 4) * 64 + F.lane] = a4;
            __syncthreads();
            if (F.tid < 320) { const int r = F.tid >> 6, l = F.tid & 63; float s = 0.f;
#pragma unroll
                for (int w = 0; w < 8; ++w) s += red[(w * 5 + r) * 64 + l];
                ((float*)(F.ws + WS_MOD))[(size_t)(layer * 5 + r) * 6144 + n0 + l] = s + A_.in[I_ADAB][layer * 6144 + n0 + l]; }
            __syncthreads();
        }
    }
}

__device__ __forceinline__ void norm_phase(Frame& F, const float* xl, const float* xc, int nrows, const float* g, const float* modl  , int sh_off, bf16* dst) {
    const int gw = F.vcu * NWAVES + F.wave, NGW = F.G * NWAVES;
    f32x4 gg[4];
#pragma unroll
    for (int j = 0; j < 4; ++j) gg[j] = *(const f32x4*)(g + 4 * F.lane + 256 * j);
    for (int m0 = gw; m0 < nrows; m0 += 2 * NGW) {
        const int m1 = m0 + NGW; const bool two = m1 < nrows; const int m1c = two ? m1 : m0;
        const float* xrow0 = (m0 < ML) ? xl + (size_t)m0 * DM : xc + (size_t)(m0 - ML) * DM;
        const float* xrow1 = (m1c < ML) ? xl + (size_t)m1c * DM : xc + (size_t)(m1c - ML) * DM;
        const GAS f32x4* xr0 = (const GAS f32x4*)xrow0 + F.lane; const GAS f32x4* xr1 = (const GAS f32x4*)xrow1 + F.lane;
        f32x4 v0[4], v1[4]; float s0 = 0.f, s1 = 0.f;
#pragma unroll
        for (int j = 0; j < 4; ++j) { v0[j] = xr0[64 * j]; v1[j] = xr1[64 * j]; }
#pragma unroll
        for (int j = 0; j < 4; ++j) { s0 += (v0[j].x * v0[j].x + v0[j].y * v0[j].y) + (v0[j].z * v0[j].z + v0[j].w * v0[j].w); s1 += (v1[j].x * v1[j].x + v1[j].y * v1[j].y) + (v1[j].z * v1[j].z + v1[j].w * v1[j].w); }
        const float rstd0 = 1.f / sqrtf(wave_sum(s0) * (1.f / DM) + NORM_EPS), rstd1 = 1.f / sqrtf(wave_sum(s1) * (1.f / DM) + NORM_EPS);
#pragma unroll
        for (int rr = 0; rr < 2; ++rr) {
            if (rr == 1 && !two) break;
            const int m = rr ? m1 : m0; const int r = (m < ML) ? (m >> 13) : 4; const float rstd = rr ? rstd1 : rstd0;
            const float* sh = modl + (size_t)r * 6144 + sh_off; const float* sc = sh + 1024;
            GAS unsigned long long* o8 = (GAS unsigned long long*)(dst + (size_t)m * DM) + F.lane;
#pragma unroll
            for (int j = 0; j < 4; ++j) { const int c = 4 * F.lane + 256 * j;
                const f32x4 a = *(const f32x4*)(sc + c), b = *(const f32x4*)(sh + c);
                const f32x4 o = ((rr ? v1[j] : v0[j]) * rstd * gg[j]) * (a + 1.f) + b;
                o8[64 * j] = (unsigned long long)pk2(o.x, o.y) | ((unsigned long long)pk2(o.z, o.w) << 32); }
        }
    }
}
__device__ __forceinline__ void norm_bf16_phase(Frame& F, const bf16* xr, const float* g, const float* modl, int sh_off, bf16* dst) {
    const int gw = F.vcu * NWAVES + F.wave, NGW = F.G * NWAVES; const int c0 = 16 * F.lane;
    f32x4 gg[4];
#pragma unroll
    for (int j = 0; j < 4; ++j) gg[j] = *(const f32x4*)(g + c0 + 4 * j);
    for (int m0 = gw; m0 < ML; m0 += 2 * NGW) {
        const int m1 = (m0 + NGW < ML) ? m0 + NGW : m0;
        v4u a0 = *(const v4u*)(xr + (size_t)m0 * DM + c0), a1 = *(const v4u*)(xr + (size_t)m0 * DM + c0 + 8), b0 = *(const v4u*)(xr + (size_t)m1 * DM + c0), b1 = *(const v4u*)(xr + (size_t)m1 * DM + c0 + 8);
#pragma unroll
        for (int rr = 0; rr < 2; ++rr) {
            if (rr == 1 && m1 == m0) break;
            const int m = rr ? m1 : m0; const v4u q0 = rr ? b0 : a0, q1 = rr ? b1 : a1;
            float v[16];
#pragma unroll
            for (int e = 0; e < 4; ++e) { v[2 * e] = bf_lo(q0[e]); v[2 * e + 1] = bf_hi(q0[e]); v[8 + 2 * e] = bf_lo(q1[e]); v[8 + 2 * e + 1] = bf_hi(q1[e]); }
            float s = 0.f;
#pragma unroll
            for (int e = 0; e < 16; ++e) s += v[e] * v[e];
            const float rstd = 1.f / sqrtf(wave_sum(s) * (1.f / DM) + NORM_EPS);
            const float* sh = modl + (size_t)(m >> 13) * 6144 + sh_off + c0; const float* sc = sh + 1024;
            v4u o0, o1;
#pragma unroll
            for (int j = 0; j < 4; ++j) { const f32x4 a = *(const f32x4*)(sc + 4 * j), b = *(const f32x4*)(sh + 4 * j);
                const f32x4 x = {v[4 * j], v[4 * j + 1], v[4 * j + 2], v[4 * j + 3]}; const f32x4 o = (x * rstd * gg[j]) * (a + 1.f) + b;
                if (j < 2) { o0[2 * j] = pk2(o.x, o.y); o0[2 * j + 1] = pk2(o.z, o.w); } else { o1[2 * (j - 2)] = pk2(o.x, o.y); o1[2 * (j - 2) + 1] = pk2(o.z, o.w); } }
            *(v4u*)(dst + (size_t)m * DM + c0) = o0; *(v4u*)(dst + (size_t)m * DM + c0 + 8) = o1;
        }
    }
}
__device__ __forceinline__ void final_norm_bf16_phase(Frame& F, const bf16* xr, float* out, const float* g) {
    const int gw = F.vcu * NWAVES + F.wave, NGW = F.G * NWAVES; const int c0 = 16 * F.lane;
    f32x4 gg[4];
#pragma unroll
    for (int j = 0; j < 4; ++j) gg[j] = *(const f32x4*)(g + c0 + 4 * j);
    for (int m0 = gw; m0 < ML; m0 += 2 * NGW) {
        const int m1 = (m0 + NGW < ML) ? m0 + NGW : m0;
        const v4u a0 = *(const v4u*)(xr + (size_t)m0 * DM + c0), a1 = *(const v4u*)(xr + (size_t)m0 * DM + c0 + 8), b0 = *(const v4u*)(xr + (size_t)m1 * DM + c0), b1 = *(const v4u*)(xr + (size_t)m1 * DM + c0 + 8);
#pragma unroll
        for (int rr = 0; rr < 2; ++rr) {
            if (rr == 1 && m1 == m0) break;
            const int m = rr ? m1 : m0; const v4u q0 = rr ? b0 : a0, q1 = rr ? b1 : a1;
            float v[16];
#pragma unroll
            for (int e = 0; e < 4; ++e) { v[2 * e] = bf_lo(q0[e]); v[2 * e + 1] = bf_hi(q0[e]); v[8 + 2 * e] = bf_lo(q1[e]); v[8 + 2 * e + 1] = bf_hi(q1[e]); }
            float s = 0.f;
#pragma unroll
            for (int e = 0; e < 16; ++e) s += v[e] * v[e];
            const float rstd = 1.f / sqrtf(wave_sum(s) * (1.f / DM) + NORM_EPS);
            GAS f32x4* o = (GAS f32x4*)(out + (size_t)m * DM + c0);
#pragma unroll
            for (int j = 0; j < 4; ++j) { const f32x4 x = {v[4 * j], v[4 * j + 1], v[4 * j + 2], v[4 * j + 3]}; o[j] = x * rstd * gg[j]; }
        }
    }
}
__device__ __forceinline__ void final_norm_phase(Frame& F, float* x, const float* g) {
    const int gw = F.vcu * NWAVES + F.wave, NGW = F.G * NWAVES;
    for (int m = gw; m < ML; m += NGW) {
        GAS f32x4* xr = (GAS f32x4*)(x + (size_t)m * DM) + F.lane;
        f32x4 v[4]; float s = 0.f;
#pragma unroll
        for (int j = 0; j < 4; ++j) { v[j] = xr[64 * j]; s += (v[j].x * v[j].x + v[j].y * v[j].y) + (v[j].z * v[j].z + v[j].w * v[j].w); }
        const float rstd = 1.f / sqrtf(wave_sum(s) * (1.f / DM) + NORM_EPS);
#pragma unroll
        for (int j = 0; j < 4; ++j) { const f32x4 gg = *(const f32x4*)(g + 4 * F.lane + 256 * j); xr[64 * j] = v[j] * rstd * gg; }
    }
}
__device__ __forceinline__ f32x16 mfma32(bf16x8 a, bf16x8 b, f32x16 c) { return __builtin_amdgcn_mfma_f32_32x32x16_bf16(a, b, c, 0, 0, 0); }
__device__ __forceinline__ s16x4 tr_read(const LAS unsigned char* p) { return __builtin_bit_cast(s16x4, __builtin_amdgcn_ds_read_tr16_b64_v4i16((LAS s16x4*)p)); }
__device__ __forceinline__ bf16x8 cat4(s16x4 lo, s16x4 hi) { return (bf16x8){lo[0], lo[1], lo[2], lo[3], hi[0], hi[1], hi[2], hi[3]}; }
typedef float f32x2c __attribute__((ext_vector_type(2))); typedef __bf16 bf16x2c __attribute__((ext_vector_type(2)));
__device__ __forceinline__ unsigned cvtpk(float lo, float hi) { const f32x2c v = {lo, hi}; const bf16x2c b = __builtin_convertvector(v, bf16x2c); return __builtin_bit_cast(unsigned, b); }
__device__ __forceinline__ float swap32(float x) { auto rr = __builtin_amdgcn_permlane32_swap(__float_as_uint(x), __float_as_uint(x), false, false); return __uint_as_float((threadIdx.x & 32) ? rr[0] : rr[1]); }
__device__ __forceinline__ v4u widen2(v2u a, v2u b) { auto r0 = __builtin_amdgcn_permlane32_swap(a.x, b.x, false, false); auto r1 = __builtin_amdgcn_permlane32_swap(a.y, b.y, false, false); return (v4u){r0[0], r1[0], r0[1], r1[1]}; }
__device__ __forceinline__ void store_rows16(bf16* base, v2u g0, v2u g1, v2u g2, v2u g3, int hi) {
    const v4u w0 = widen2(g0, g1), w1 = widen2(g2, g3);
    *(v4u*)(base + (hi ? 8 : 0)) = w0; *(v4u*)(base + 16 + (hi ? 8 : 0)) = w1;
}
__device__ __forceinline__ v2u pk4(float a, float b, float c, float d) { v2u w; w.x = cvtpk(a, b); w.y = cvtpk(c, d); return w; }
__device__ __forceinline__ bf16x8 pack8(const f32x16& p, int b) {
    v4u w; w.x = cvtpk(p[b + 0], p[b + 1]); w.y = cvtpk(p[b + 2], p[b + 3]); w.z = cvtpk(p[b + 4], p[b + 5]); w.w = cvtpk(p[b + 6], p[b + 7]);
    return __builtin_bit_cast(bf16x8, w);
}
constexpr int KP = 144;
__device__ __forceinline__ void attn_phase(Frame& F, const Args& A_, int ufirst, int ustride) {
    const bf16* QKV = (const bf16*)(F.ws + WS_QKV); bf16* O = (bf16*)(F.ws + WS_ATTRW);
    const int lane = F.lane, r32 = lane & 31, hi = lane >> 5;
    const int g = F.wave & 3, half = F.wave >> 2;
    const int skey = F.tid >> 3, sch = F.tid & 7;
    for (int unit = ufirst; unit < 1024; unit += ustride) {
        const int b = unit >> 8, kvh = (unit >> 7) & 1, qb = unit & 127, s0 = qb * 64;
        const int head = kvh * 4 + g; const int tq = s0 + half * 32 + r32;
        const int lo = 4 + (qb < 2 ? 2 - qb : 0), hiT = 8 - (qb > 125 ? qb - 125 : 0);
        const bf16* qrow = QKV + (size_t)(b * SEQ + tq) * 768 + head * 64;
        bf16x8 qf[4];
#pragma unroll
        for (int s = 0; s < 4; ++s) qf[s] = *(const bf16x8*)(qrow + 16 * s + 8 * hi);
        float m = A_.in[I_SINK][head] * 1.4426950408889634f, l = (hi == 0) ? 1.f : 0.f;
        f32x16 o0 = {}, o1 = {};
        const bf16* kvbase = QKV + 512 + kvh * 64 + sch * 8;
#define KROW0(t) (((t) < 4) ? (ML + b * CTXL + (t) * 64) : (b * SEQ + s0 - 128 + ((t) - 4) * 64))
        v4u pk_, pv_;
        { const bf16* kp = kvbase + (size_t)(KROW0(0) + skey) * 768; pk_ = *(const v4u*)kp; pv_ = *(const v4u*)(kp + 128); }
        __syncthreads();
        *(LAS v4u*)(F.lds + skey * KP + sch * 16) = pk_; *(LAS v4u*)(F.lds + 64 * KP + skey * KP + sch * 16) = pv_;
        __syncthreads();
        int buf = 0;
        for (int tile = 0;;) {
            const int nxt = (tile == 3) ? lo : tile + 1; const bool more = tile != hiT;
            if (more) { const bf16* kp = kvbase + (size_t)(KROW0(nxt) + skey) * 768; pk_ = *(const v4u*)kp; pv_ = *(const v4u*)(kp + 128); }
            const LAS unsigned char* Ks = F.lds + buf * (128 * KP); const LAS unsigned char* Vs = Ks + 64 * KP;
            f32x16 p0 = {}, p1 = {};
#pragma unroll
            for (int s = 0; s < 4; ++s) {
                const bf16x8 a0 = *(const LAS bf16x8*)(Ks + r32 * KP + (16 * s + 8 * hi) * 2);
                const bf16x8 a1 = *(const LAS bf16x8*)(Ks + (32 + r32) * KP + (16 * s + 8 * hi) * 2);
                p0 = mfma32(a0, qf[s], p0); p1 = mfma32(a1, qf[s], p1);
            }
            if (tile == 4 || tile == 8) {
                const int ks = s0 - 128 + (tile - 4) * 64;
#pragma unroll
                for (int r = 0; r < 16; ++r) { const int key = (r & 3) + 8 * (r >> 2) + 4 * hi; const int d0 = tq - (ks + key), d1 = d0 - 32;
                    if (d0 > 128 || d0 < -128) p0[r] = -INFINITY; if (d1 > 128 || d1 < -128) p1[r] = -INFINITY; }
            }
            float mx = fmaxf(p0[0], p1[0]);
#pragma unroll
            for (int r = 1; r < 16; ++r) mx = fmaxf(mx, fmaxf(p0[r], p1[r]));
            { auto rr = __builtin_amdgcn_permlane32_swap(__float_as_uint(mx), __float_as_uint(mx), false, false); mx = fmaxf(__uint_as_float(rr[0]), __uint_as_float(rr[1])); }
            const float mn = fmaxf(m, mx), alpha = __builtin_amdgcn_exp2f(m - mn); m = mn;
            float ls = 0.f;
#pragma unroll
            for (int r = 0; r < 16; ++r) { p0[r] = __builtin_amdgcn_exp2f(p0[r] - mn); p1[r] = __builtin_amdgcn_exp2f(p1[r] - mn); ls += p0[r] + p1[r]; }
            l = l * alpha + ls;
            if (__any(alpha != 1.f)) {
#pragma unroll
                for (int r = 0; r < 16; ++r) { o0[r] *= alpha; o1[r] *= alpha; }
            }
            const bf16x8 pb0 = pack8(p0, 0), pb1 = pack8(p0, 8), pb2 = pack8(p1, 0), pb3 = pack8(p1, 8);
            const int i16 = lane & 15, qd = i16 >> 2, pp = i16 & 3, c0 = lane & 16;
            const LAS unsigned char* vb = Vs + (4 * hi + qd) * KP + (c0 + 4 * pp) * 2;
#define PVSTEP(s, pb) do { \
                const bf16x8 va0 = cat4(tr_read(vb + (16 * (s)) * KP), tr_read(vb + (16 * (s) + 8) * KP)); \
                const bf16x8 va1 = cat4(tr_read(vb + (16 * (s)) * KP + 64), tr_read(vb + (16 * (s) + 8) * KP + 64)); \
                o0 = mfma32(va0, pb, o0); o1 = mfma32(va1, pb, o1); } while (0)
            PVSTEP(0, pb0); PVSTEP(1, pb1); PVSTEP(2, pb2); PVSTEP(3, pb3);
#undef PVSTEP
            if (!more) break;
            buf ^= 1;
            *(LAS v4u*)(F.lds + buf * (128 * KP) + skey * KP + sch * 16) = pk_; *(LAS v4u*)(F.lds + buf * (128 * KP) + 64 * KP + skey * KP + sch * 16) = pv_;
            __syncthreads();
            tile = nxt;
        }
#undef KROW0
        { auto rr = __builtin_amdgcn_permlane32_swap(__float_as_uint(l), __float_as_uint(l), false, false); l = __uint_as_float(rr[0]) + __uint_as_float(rr[1]); }
        const float inv = __builtin_amdgcn_rcpf(l);
        bf16* orow = O + (size_t)(b * SEQ + tq) * 1024 + head * 64;
        store_rows16(orow, pk4(o0[0] * inv, o0[1] * inv, o0[2] * inv, o0[3] * inv), pk4(o0[4] * inv, o0[5] * inv, o0[6] * inv, o0[7] * inv), pk4(o0[8] * inv, o0[9] * inv, o0[10] * inv, o0[11] * inv), pk4(o0[12] * inv, o0[13] * inv, o0[14] * inv, o0[15] * inv), hi);
        store_rows16(orow + 32, pk4(o1[0] * inv, o1[1] * inv, o1[2] * inv, o1[3] * inv), pk4(o1[4] * inv, o1[5] * inv, o1[6] * inv, o1[7] * inv), pk4(o1[8] * inv, o1[9] * inv, o1[10] * inv, o1[11] * inv), pk4(o1[12] * inv, o1[13] * inv, o1[14] * inv, o1[15] * inv), hi);
    }
}

constexpr int AP3 = 272;
__device__ __forceinline__ void rwkv_prep_phase(Frame& F, const Args& A_) {
    const bf16* ZR = (const bf16*)(F.ws + WS_ZR); bf16* ZS = (bf16*)(F.ws + WS_ZS); float* INVN = (float*)(F.ws + WS_INVN);
    bf16* LIN = (bf16*)(F.ws + WS_LIN); bf16* GG = (bf16*)((unsigned char*)F.out + DO_G);
    const bf16* G2T = (const bf16*)(F.ws + WS_LG2);
    LAS unsigned char* A3 = F.lds;
    const float* mup = A_.in[I_MUP]; const float* mun = A_.in[I_MUN]; const float* kkw = A_.in[I_KK];
    const int lane = F.lane, r32 = lane & 31, hi = lane >> 5;
    const int pch = F.tid & 255, pth = F.tid >> 8, pcol = pch * 8; const bool pact = pch < 224;
    f32x4 mp0 = {}, mp1 = {}, mn0 = {}, mn1 = {}, kc0 = {}, kc1 = {};
    if (pact) { mp0 = *(const f32x4*)(mup + pcol); mp1 = *(const f32x4*)(mup + pcol + 4); mn0 = *(const f32x4*)(mun + pcol); mn1 = *(const f32x4*)(mun + pcol + 4); }
    if (pch >= 64 && pch < 128) { kc0 = *(const f32x4*)(kkw + pcol - 512); kc1 = *(const f32x4*)(kkw + pcol - 508); }
    bf16x8 g2f0[8], g2f1[8];
#pragma unroll
    for (int s = 0; s < 8; ++s) { g2f0[s] = *(const bf16x8*)(G2T + (size_t)(F.wave * 64 + r32) * 128 + 16 * s + 8 * hi); g2f1[s] = *(const bf16x8*)(G2T + (size_t)(F.wave * 64 + 32 + r32) * 128 + 16 * s + 8 * hi); }
    for (int unit = F.vcu; unit < MALL / 32; unit += F.G) {
        const int R0 = unit * 32;
        __syncthreads();
        {
            const int Rt = R0 + 16 * pth;
            const int seqlen = (R0 < ML) ? SEQ : CTXL; const int pos0 = (R0 < ML) ? (Rt & (SEQ - 1)) : ((Rt - ML) & (CTXL - 1));
            v4u zz[18];
#pragma unroll
            for (int i = 0; i < 18; ++i) { const int p = pos0 + i - 1; zz[i] = (v4u){0u, 0u, 0u, 0u}; if (pact && p >= 0 && p < seqlen) zz[i] = *(const v4u*)(ZR + (size_t)(Rt + i - 1) * RWC + pcol); }
#pragma unroll
            for (int i = 0; i < 16; ++i) {
                const int tk = 16 * pth + i, row = Rt + i, ch = pch, col = pcol;
                const v4u zp = zz[i], zc = zz[i + 1], zn = zz[i + 2];
                float z[8];
#pragma unroll
                for (int e = 0; e < 4; ++e) {
                    const float c0 = bf_lo(zc[e]), c1 = bf_hi(zc[e]), p0 = bf_lo(zp[e]), p1 = bf_hi(zp[e]), n0 = bf_lo(zn[e]), n1 = bf_hi(zn[e]);
                    const float a0 = (2 * e < 4) ? mp0[2 * e] : mp1[2 * e - 4], a1 = (2 * e + 1 < 4) ? mp0[2 * e + 1] : mp1[2 * e - 3];
                    const float b0 = (2 * e < 4) ? mn0[2 * e] : mn1[2 * e - 4], b1 = (2 * e + 1 < 4) ? mn0[2 * e + 1] : mn1[2 * e - 3];
                    z[2 * e] = c0 + a0 * (p0 - c0) + b0 * (n0 - c0); z[2 * e + 1] = c1 + a1 * (p1 - c1) + b1 * (n1 - c1);
                }
                if (ch < 192) {
                    v4u w; w.x = pk2(z[0], z[1]); w.y = pk2(z[2], z[3]); w.z = pk2(z[4], z[5]); w.w = pk2(z[6], z[7]);
                    *(v4u*)(ZS + (size_t)row * 1536 + col) = w;
                }
                {
                    float ss = 0.f;
#pragma unroll
                    for (int e = 0; e < 4; ++e) { const float a = z[e] * kc0[e], b = z[4 + e] * kc1[e]; ss += a * a + b * b; }
                    ss = sum8(ss);
                    if (ch >= 64 && ch < 128 && (ch & 7) == 0) INVN[(size_t)row * 8 + ((ch - 64) >> 3)] = 1.f / sqrtf(ss + 1e-12f);
                }
                if (ch >= 192 && pact) {
                    v4u w;
                    if (ch < 200) {
                        float t[8];
#pragma unroll
                        for (int e = 0; e < 8; ++e) { const float ex = __expf(-2.f * fabsf(z[e])); const float th = (1.f - ex) * __builtin_amdgcn_rcpf(1.f + ex); t[e] = z[e] < 0.f ? -th : th; }
                        w.x = pk2(t[0], t[1]); w.y = pk2(t[2], t[3]); w.z = pk2(t[4], t[5]); w.w = pk2(t[6], t[7]);
                        *(v4u*)(LIN + (size_t)row * 128 + (ch - 192) * 8) = w;
                    } else if (ch < 208) {
                        w.x = pk2(z[0], z[1]); w.y = pk2(z[2], z[3]); w.z = pk2(z[4], z[5]); w.w = pk2(z[6], z[7]);
                        *(v4u*)(LIN + (size_t)row * 128 + 64 + (ch - 200) * 8) = w;
                    } else {
                        float t[8];
#pragma unroll
                        for (int e = 0; e < 8; ++e) t[e] = __builtin_amdgcn_rcpf(1.f + __expf(-z[e]));
                        w.x = pk2(t[0], t[1]); w.y = pk2(t[2], t[3]); w.z = pk2(t[4], t[5]); w.w = pk2(t[6], t[7]);
                        *(LAS v4u*)(A3 + tk * AP3 + (ch - 208) * 16) = w;
                    }
                }
            }
        }
        __syncthreads();
        if (R0 < ML) {
#pragma unroll
            for (int t = 0; t < 2; ++t) {
                const int n0 = F.wave * 64 + t * 32; f32x16 acc = {};
#pragma unroll
                for (int s = 0; s < 8; ++s) acc = mfma32(t ? g2f1[s] : g2f0[s], *(const LAS bf16x8*)(A3 + r32 * AP3 + (16 * s + 8 * hi) * 2), acc);
                store_rows16(GG + (size_t)(R0 + r32) * 512 + n0, pk4(acc[0], acc[1], acc[2], acc[3]), pk4(acc[4], acc[5], acc[6], acc[7]), pk4(acc[8], acc[9], acc[10], acc[11]), pk4(acc[12], acc[13], acc[14], acc[15]), hi);
            }
        }
    }
}

#ifndef AREPMASK
#define AREPMASK 0
#endif
#ifndef AREPS
#define AREPS 5
#endif
#if AREPMASK
#define ALOOP(k) for (int ar_ = 0; ar_ < (((AREPMASK >> (k)) & 1) ? AREPS : 1); ++ar_, __syncthreads())
#else
#define ALOOP(k)
#endif
constexpr int SP = 144, SLOT = 64 * SP;
constexpr int NCHUNK = (CTXL + SEQ) / 64;
#define ROWOF(s) (((s) < CTXL) ? (ML + b * CTXL + (d == 0 ? (s) : CTXL - 1 - (s))) : (b * SEQ + (d == 0 ? ((s) - CTXL) : (SEQ - 1 - ((s) - CTXL)))))
__device__ __forceinline__ bf16x8 ldA(const LAS unsigned char* X, int row0, int ks, int r32, int hi) { return *(const LAS bf16x8*)(X + (row0 + r32) * SP + (16 * ks + 8 * hi) * 2); }
__device__ __forceinline__ bf16x8 ldT(const LAS unsigned char* X, int n0, int ks, int lane) {
    const int hi = lane >> 5, i16 = lane & 15, qd = i16 >> 2, pp = i16 & 3, c0 = lane & 16;
    const LAS unsigned char* p = X + (16 * ks + 8 * hi + qd) * SP + (n0 + c0 + 4 * pp) * 2;
    return cat4(tr_read(p), tr_read(p + 4 * SP));
}
#define KPOS(rb, q4, hi) ((rb) * 32 + (2 * ((q4) & 1) + (hi)) * 8 + ((q4) >> 1) * 4)
__device__ __forceinline__ v2u pack4(float a, float b, float c, float d) { v2u w; w.x = pk2(a, b); w.y = pk2(c, d); return w; }
__device__ __forceinline__ void stT(LAS unsigned char* M, const f32x16& dv, int r0, int c0, int r32, int hi) {
#pragma unroll
    for (int q4 = 0; q4 < 4; ++q4) *(LAS v2u*)(M + (c0 + r32) * SP + (r0 + 8 * q4 + 4 * hi) * 2) = pack4(dv[4 * q4], dv[4 * q4 + 1], dv[4 * q4 + 2], dv[4 * q4 + 3]);
}
__device__ __forceinline__ void rwkv_chunkA_phase(Frame& F, const Args& A_) {
    const bf16* ZS = (const bf16*)(F.ws + WS_ZS); const float* INVN = (const float*)(F.ws + WS_INVN); const bf16* LIN = (const bf16*)(F.ws + WS_LIN);
    const bf16* W2T = (const bf16*)(F.ws + WS_LW2); const bf16* A2T = (const bf16*)(F.ws + WS_LA2);
    bf16* MTg = (bf16*)(F.ws + WS_MT); bf16* NNg = (bf16*)(F.ws + WS_NN); bf16* QTg = (bf16*)(F.ws + WS_QT);
    bf16* Yg = (bf16*)((unsigned char*)F.out + DO_Y);
    LAS unsigned char* L = F.lds;
    LAS unsigned char* sKKt = L, *sBh = L + SLOT, *sKh = L + 2 * SLOT, *sRt = L + 3 * SLOT, *sBp = L + 4 * SLOT, *sKp = L + 5 * SLOT, *sVm = L + 6 * SLOT,
                     *sT = L + 7 * SLOT, *sAkN = L + 8 * SLOT, *sBbT = L + 9 * SLOT, *sHT = L + 10 * SLOT;
    LAS unsigned char* sFT = sBh; LAS unsigned char* sZT = sBbT; LAS unsigned char* sWyT = sBp; LAS unsigned char* sXT = sHT;
    LAS float* AB = (LAS float*)(L + 11 * SLOT);
    LAS unsigned char* sL1 = L + 11 * SLOT; LAS unsigned char* sL2 = L + 12 * SLOT;
    LAS float* LWf = (LAS float*)(L + 7 * SLOT); LAS float* AAf = LWf + 4096;
    LAS unsigned char* sR0 = L + 13 * SLOT, *sK0 = L + 14 * SLOT, *sV0 = L + 15 * SLOT;
    LAS float* SEG = (LAS float*)(L + 16 * SLOT);
    const int lane = F.lane, r32 = lane & 31, hi = lane >> 5, w = F.wave;
    constexpr int IPB = 64 * NCHUNK / 256;
    const int chain = F.vcu / (NCHUNK / IPB), b = chain >> 4, h = (chain >> 1) & 7, d = chain & 1, cfirst = (F.vcu % (NCHUNK / IPB)) * IPB;
    const int lwhich = w >> 2, ltb = (w >> 1) & 1, lcb = w & 1;
    bf16x8 wfrag[4]; float lbias;
    { const int chn = h * 64 + 32 * lcb + r32; const bf16* Bt = (lwhich ? A2T : W2T) + (size_t)(d * 512 + chn) * 64;
#pragma unroll
      for (int ks = 0; ks < 4; ++ks) wfrag[ks] = *(const bf16x8*)(Bt + 16 * ks + 8 * hi);
      lbias = (lwhich ? A_.in[I_IA0] : A_.in[I_DW0])[d * 512 + chn]; }
    const float kkc = A_.in[I_KK][h * 64 + (F.tid & 63)], kac = A_.in[I_KA][h * 64 + (F.tid & 63)];
    v4u pf_l1, pf_l2, pf_r, pf_k, pf_v; float pf_in = 0.f;
    const int ptok = F.tid >> 3, pc16 = F.tid & 7;
#define CHA_PREFETCH(cc) do { const int row_ = ROWOF(64 * (cc) + ptok); \
        pf_l1 = *(const v4u*)(LIN + (size_t)row_ * 128 + pc16 * 8); pf_l2 = *(const v4u*)(LIN + (size_t)row_ * 128 + 64 + pc16 * 8); \
        const bf16* zp_ = ZS + (size_t)row_ * 1536 + h * 64 + pc16 * 8; pf_r = *(const v4u*)zp_; pf_k = *(const v4u*)(zp_ + 512); pf_v = *(const v4u*)(zp_ + 1024); \
        if (F.tid < 64) pf_in = INVN[(size_t)ROWOF(64 * (cc) + F.tid) * 8 + h]; } while (0)
#define CHA_STAGE() do { *(LAS v4u*)(sL1 + ptok * SP + pc16 * 16) = pf_l1; *(LAS v4u*)(sL2 + ptok * SP + pc16 * 16) = pf_l2; \
        *(LAS v4u*)(sR0 + ptok * SP + pc16 * 16) = pf_r; *(LAS v4u*)(sK0 + ptok * SP + pc16 * 16) = pf_k; *(LAS v4u*)(sV0 + ptok * SP + pc16 * 16) = pf_v; \
        if (F.tid < 64) SEG[9 * 64 + F.tid] = pf_in; } while (0)
    __syncthreads();
    CHA_PREFETCH(cfirst); CHA_STAGE();
    CHA_PREFETCH(cfirst + 1);
#pragma unroll 1
    for (int ii = 0; ii < IPB; ++ii) {
        const int c = cfirst + ii, inst = chain * NCHUNK + c;
        const bool latent = c >= CTXL / 64;
        __syncthreads();
        ALOOP(0) { f32x16 acc = {};
#pragma unroll
          for (int ks = 0; ks < 4; ++ks) acc = mfma32(ldA(lwhich ? sL2 : sL1, 32 * ltb, ks, r32, hi), wfrag[ks], acc);
#pragma unroll
          for (int r = 0; r < 16; ++r) { const int tok = 32 * ltb + (r & 3) + 8 * (r >> 2) + 4 * hi; const float x = lbias + acc[r];
              const float sg = __builtin_amdgcn_rcpf(1.f + __expf(-x));
              if (lwhich == 0) LWf[tok * 64 + 32 * lcb + r32] = -0.6065306597126334f * sg; else AAf[tok * 64 + 32 * lcb + r32] = sg; }
        }
        __syncthreads();
        {
            const int ch = F.tid & 63, seg = F.tid >> 6;
            float lw[8], aa[8], rr[8], kx[8], inn[8]; bf16 vraw[8];
#pragma unroll
            for (int e = 0; e < 8; ++e) vraw[e] = *(const LAS bf16*)(sV0 + (8 * seg + e) * SP + ch * 2);
#pragma unroll
            for (int e = 0; e < 8; ++e) { const int tok = 8 * seg + e; lw[e] = LWf[tok * 64 + ch]; aa[e] = AAf[tok * 64 + ch];
                rr[e] = bf1(*(const LAS bf16*)(sR0 + tok * SP + ch * 2)); kx[e] = bf1(*(const LAS bf16*)(sK0 + tok * SP + ch * 2)); inn[e] = SEG[9 * 64 + tok]; }
            float cl[8]; cl[0] = lw[0];
#pragma unroll
            for (int e = 1; e < 8; ++e) cl[e] = cl[e - 1] + lw[e];
            SEG[seg * 64 + ch] = cl[7];
            __syncthreads();
            float pre = 0.f, tot = 0.f;
#pragma unroll
            for (int s = 0; s < 8; ++s) { const float t = SEG[s * 64 + ch]; tot += t; if (s < seg) pre += t; }
            if (seg == 0) SEG[8 * 64 + ch] = tot;
            const float ptot = __expf(tot); float epprev = __expf(pre);
#pragma unroll
            for (int e = 0; e < 8; ++e) {
                const int tok = 8 * seg + e; const float c_ = pre + cl[e];
                const float kk = kx[e] * kkc * inn[e], bb = kk * aa[e], kd = kx[e] * (1.f + (aa[e] - 1.f) * kac);
                const float em = __expf(-c_), ep = __builtin_amdgcn_rcpf(em), ee = ptot * em, e1 = epprev; epprev = ep;
                const int o = tok * SP + ch * 2;
                *(LAS bf16*)(sKKt + o) = (bf16)f2bf(kk * e1); *(LAS bf16*)(sBh + o) = (bf16)f2bf(bb * em); *(LAS bf16*)(sKh + o) = (bf16)f2bf(kd * em); *(LAS bf16*)(sRt + o) = (bf16)f2bf(rr[e] * ep);
                *(LAS bf16*)(sBp + o) = (bf16)f2bf(bb * ee); *(LAS bf16*)(sKp + o) = (bf16)f2bf(kd * ee); *(LAS bf16*)(sVm + o) = vraw[e];
            }
        }
        __syncthreads();
        ALOOP(1)
        if (w < 4) {
            const int rb = (w >> 1) & 1, cb = w & 1;
            f32x16 acc = {};
#pragma unroll
            for (int ks = 0; ks < 4; ++ks) acc = mfma32(ldA(sKKt, 32 * rb, ks, r32, hi), ldA(sBh, 32 * cb, ks, r32, hi), acc);
            const int col = 32 * cb + r32;
#pragma unroll
            for (int r = 0; r < 16; ++r) { const int row = 32 * rb + (r & 3) + 8 * (r >> 2) + 4 * hi; if (!(col < row)) acc[r] = 0.f; }
#pragma unroll
            for (int q4 = 0; q4 < 4; ++q4) *(LAS f32x4*)(AB + col * 68 + 32 * rb + 8 * q4 + 4 * hi) = (f32x4){acc[4 * q4], acc[4 * q4 + 1], acc[4 * q4 + 2], acc[4 * q4 + 3]};
        }
        __syncthreads();
        ALOOP(2) {
            const int gm = 1 + (w >> 2), grb = (w >> 1) & 1, gcb = w & 1;
            f32x16 gacc = {};
            { const LAS unsigned char* GX = (gm == 2) ? sBh : sKKt; const LAS unsigned char* GY = (gm == 1) ? sKh : sRt;
#pragma unroll
              for (int ks = 0; ks < 4; ++ks) gacc = mfma32(ldA(GX, 32 * grb, ks, r32, hi), ldA(GY, 32 * gcb, ks, r32, hi), gacc); }
            const int col = F.tid >> 3, jq = F.tid & 7, blk = col >> 4, cc = col & 15; float t0 = 0.f, t1 = 0.f;
            const LAS float* arow = AB + (16 * blk) * 68 + 16 * blk + 2 * jq;
#pragma unroll
            for (int i = 15; i >= 0; --i) {
                const f32x2c av = *(const LAS f32x2c*)(arow + i * 68);
                float p = av[0] * t0 + av[1] * t1; p = sum8(p);
                const float val = (i == cc) ? 1.f : ((i < cc) ? -p : 0.f);
                if (jq == (i >> 1)) { if ((i & 1) == 0) t0 = val; else t1 = val; }
            }
            { const int gcol = 32 * gcb + r32;
#pragma unroll
              for (int r = 0; r < 16; ++r) { const int row = 32 * grb + (r & 3) + 8 * (r >> 2) + 4 * hi;
                  const bool keep = (gm == 2) ? (row <= gcol) : (gcol < row); float vl = keep ? gacc[r] : 0.f; if (gm == 1) vl = -vl; gacc[r] = vl; }
              stT((gm == 1) ? sAkN : sBbT, gacc, 32 * grb, 32 * gcb, r32, hi); }
            { LAS unsigned char* tp_ = sT + (16 * blk + 2 * jq) * SP + (16 * blk + cc) * 2;
              *(LAS bf16*)(tp_) = (bf16)f2bf(t0); *(LAS bf16*)(tp_ + SP) = (bf16)f2bf(t1); }
            if (F.tid < 64) { const v4u z = {0u, 0u, 0u, 0u}; LAS unsigned char* zp = sT + (32 + (F.tid >> 1)) * SP + (F.tid & 1) * 32; *(LAS v4u*)zp = z; *(LAS v4u*)(zp + 16) = z; }
            else if (F.tid < 96) { const v4u z = {0u, 0u, 0u, 0u}; const int q_ = (F.tid - 64) >> 4, r_ = (F.tid - 64) & 15; LAS unsigned char* zp = sT + (32 * q_ + 16 + r_) * SP + (32 * q_) * 2; *(LAS v4u*)zp = z; *(LAS v4u*)(zp + 16) = z; }
        }
        __syncthreads();
        if (w < 2) {
            const int o = 32 * w;
            const LAS float* ap = AB + (o + r32) * 68 + o + 16 + 8 * hi; const f32x4 a0 = *(const LAS f32x4*)ap, a1 = *(const LAS f32x4*)(ap + 4);
            v4u aw; aw.x = pk2(a0[0], a0[1]); aw.y = pk2(a0[2], a0[3]); aw.z = pk2(a1[0], a1[1]); aw.w = pk2(a1[2], a1[3]);
            const int i16 = lane & 15, qd = i16 >> 2, pp = i16 & 3, c0 = lane & 16;
            const LAS unsigned char* tp = sT + (o + 16 + 8 * hi + qd) * SP + (o + 16 + c0 + 4 * pp) * 2;
            f32x16 x = {}; x = mfma32(__builtin_bit_cast(bf16x8, aw), cat4(tr_read(tp), tr_read(tp + 4 * SP)), x);
            stT(sXT, x, 0, o, r32, hi);
            f32x16 tr = {}; tr = mfma32(*(const LAS bf16x8*)(sT + (o + r32) * SP + (o + 8 * hi) * 2), *(const LAS bf16x8*)(sXT + (o + r32) * SP + (8 * hi) * 2), tr);
            if (r32 < 16) {
#pragma unroll
                for (int r = 0; r < 8; ++r) { const int i = (r & 3) + 8 * (r >> 2) + 4 * hi; *(LAS bf16*)(sT + (o + i) * SP + (o + 16 + r32) * 2) = (bf16)f2bf(-tr[r]); }
            }
        }
        __syncthreads();
        if (w == 0) {
            f32x16 x = {};
#pragma unroll
            for (int ks = 0; ks < 2; ++ks) { const LAS float* ap = AB + r32 * 68 + 32 + 16 * ks + 8 * hi; const f32x4 a0 = *(const LAS f32x4*)ap, a1 = *(const LAS f32x4*)(ap + 4);
                v4u aw; aw.x = pk2(a0[0], a0[1]); aw.y = pk2(a0[2], a0[3]); aw.z = pk2(a1[0], a1[1]); aw.w = pk2(a1[2], a1[3]);
                const int i16 = lane & 15, qd = i16 >> 2, pp = i16 & 3, c0 = lane & 16;
                const LAS unsigned char* tp = sT + (32 + 16 * ks + 8 * hi + qd) * SP + (32 + c0 + 4 * pp) * 2;
                x = mfma32(__builtin_bit_cast(bf16x8, aw), cat4(tr_read(tp), tr_read(tp + 4 * SP)), x); }
            stT(sXT, x, 0, 0, r32, hi);
            f32x16 tr = {};
#pragma unroll
            for (int ks = 0; ks < 2; ++ks) tr = mfma32(ldA(sT, 0, ks, r32, hi), ldA(sXT, 0, ks, r32, hi), tr);
#pragma unroll
            for (int r = 0; r < 16; ++r) { const int i = (r & 3) + 8 * (r >> 2) + 4 * hi; *(LAS bf16*)(sT + i * SP + (32 + r32) * 2) = (bf16)f2bf(-tr[r]); }
        }
        __syncthreads();
        ALOOP(3) { const int which = w >> 2, rb = (w >> 1) & 1, cb = w & 1; f32x16 acc = {};
#pragma unroll
          for (int ks = 0; ks < 4; ++ks) acc = mfma32(ldA(sT, 32 * rb, ks, r32, hi), which ? ldT(sBp, 32 * cb, ks, lane) : ldA(sBbT, 32 * cb, ks, r32, hi), acc);
          stT(which ? sHT : sFT, acc, 32 * rb, 32 * cb, r32, hi); }
        __syncthreads();
        if (ii + 1 < IPB) { CHA_STAGE(); if (ii + 2 < IPB) CHA_PREFETCH(c + 2); }
        const size_t ioff = (size_t)(c * 64 + chain) * 4096; const size_t qoff = (size_t)((c - 4) * 64 + chain) * 4096;
        ALOOP(4)
#pragma unroll 1
        for (int q = w; q < 16; q += 8) {
            const int kind = q >> 2, rb = (q >> 1) & 1, cb = q & 1; const int col = 32 * cb + r32;
            if (!latent && (kind == 1 || kind == 3)) continue;
            f32x16 acc = {};
            if (kind == 3) {
#pragma unroll
                for (int ks = 0; ks < 4; ++ks) acc = mfma32(ldA(sKh, 32 * rb, ks, r32, hi), ldA(sRt, 32 * cb, ks, r32, hi), acc);
#pragma unroll
                for (int r = 0; r < 16; ++r) { const int row = 32 * rb + (r & 3) + 8 * (r >> 2) + 4 * hi; if (row > col) acc[r] = 0.f; }
            }
#pragma unroll
            for (int ks = 0; ks < 4; ++ks) {
                const bf16x8 a = (kind < 2) ? ldT(sKKt, 32 * rb, ks, lane) : ldA(sAkN, 32 * rb, ks, r32, hi);
                const bf16x8 bq = (kind == 0 || kind == 2) ? ldA(sHT, 32 * cb, ks, r32, hi) : ldA(sFT, 32 * cb, ks, r32, hi);
                acc = mfma32(a, bq, acc);
            }
            if (kind == 0) {
                const float pc = __expf(SEG[8 * 64 + col]); v2u pq[4];
#pragma unroll
                for (int q4 = 0; q4 < 4; ++q4) { const int r0 = 32 * rb + 8 * q4 + 4 * hi; float o[4];
#pragma unroll
                    for (int e = 0; e < 4; ++e) o[e] = ((r0 + e == col) ? pc : 0.f) - acc[4 * q4 + e];
                    pq[q4] = pk4(o[0], o[1], o[2], o[3]); }
                bf16* dp = MTg + ioff + (size_t)col * 64 + rb * 32;
                *(v4u*)(dp + hi * 8) = (v4u){pq[0].x, pq[0].y, pq[2].x, pq[2].y}; *(v4u*)(dp + (2 + hi) * 8) = (v4u){pq[1].x, pq[1].y, pq[3].x, pq[3].y};
            } else if (kind == 1) {
                v2u pq[4];
#pragma unroll
                for (int q4 = 0; q4 < 4; ++q4) { const int r0 = 32 * rb + 8 * q4 + 4 * hi; const v2u rv = *(const LAS v2u*)(sRt + col * SP + r0 * 2);
                    pq[q4] = pk4(bf_lo(rv.x) - acc[4 * q4], bf_hi(rv.x) - acc[4 * q4 + 1], bf_lo(rv.y) - acc[4 * q4 + 2], bf_hi(rv.y) - acc[4 * q4 + 3]); }
                bf16* dp = QTg + qoff + (size_t)col * 64 + rb * 32;
                *(v4u*)(dp + hi * 8) = (v4u){pq[0].x, pq[0].y, pq[2].x, pq[2].y}; *(v4u*)(dp + (2 + hi) * 8) = (v4u){pq[1].x, pq[1].y, pq[3].x, pq[3].y};
            } else if (kind == 2) {
#pragma unroll
                for (int r = 0; r < 16; ++r) { const int row = 32 * rb + (r & 3) + 8 * (r >> 2) + 4 * hi; acc[r] += bf1(*(const LAS bf16*)(sKp + row * SP + col * 2)); }
                stT(sZT, acc, 32 * rb, 32 * cb, r32, hi);
            } else stT(sWyT, acc, 32 * rb, 32 * cb, r32, hi);
        }
        __syncthreads();
        ALOOP(5) { const int which = w >> 2, rb = (w >> 1) & 1, cb = w & 1; const int col = 32 * cb + r32;
          if (which == 0 || latent) {
            f32x16 acc = {};
#pragma unroll
            for (int ks = 0; ks < 4; ++ks) acc = which ? mfma32(ldT(sVm, 32 * rb, ks, lane), ldA(sWyT, 32 * cb, ks, r32, hi), acc) : mfma32(ldA(sZT, 32 * rb, ks, r32, hi), ldT(sVm, 32 * cb, ks, lane), acc);
            const v2u q0 = pk4(acc[0], acc[1], acc[2], acc[3]), q1 = pk4(acc[4], acc[5], acc[6], acc[7]), q2 = pk4(acc[8], acc[9], acc[10], acc[11]), q3 = pk4(acc[12], acc[13], acc[14], acc[15]);
            if (which) store_rows16(Yg + ((size_t)d * ML + ROWOF(64 * c + col)) * 512 + h * 64 + 32 * rb, q0, q1, q2, q3, hi);
            else { bf16* dp = NNg + ioff + (size_t)col * 64 + 8 * rb;
                *(v4u*)(dp + hi * 16) = (v4u){q0.x, q0.y, q2.x, q2.y}; *(v4u*)(dp + (2 + hi) * 16) = (v4u){q1.x, q1.y, q3.x, q3.y}; }
          } }
    }
}

typedef float f32x4_t __attribute__((ext_vector_type(4)));
__device__ __forceinline__ f32x4_t mfma16(bf16x8 a, bf16x8 b, f32x4_t c) { return __builtin_amdgcn_mfma_f32_16x16x32_bf16(a, b, c, 0, 0, 0); }
__device__ __forceinline__ bf16* ss_ptr(Frame& F, int cl, int chain) { return ((cl < 64) ? (bf16*)(F.ws + WS_SS) : (bf16*)((unsigned char*)F.out + DO_SS)) + (size_t)((cl & 63) * 64 + chain) * 4096; }
__device__ __forceinline__ void st16_asm(void* p, v4u v) { asm volatile("global_store_dwordx4 %0, %1, off\n\ts_nop 1" :: "v"(p), "v"(v) : "memory"); }
struct ChunkOps { v4u m[8]; v4u n[2]; };
__device__ __forceinline__ void chB_load(ChunkOps& o, const bf16* mt, const bf16* nn) {
#pragma unroll
    for (int tn = 0; tn < 4; ++tn) { o.m[2 * tn] = *(const v4u*)(mt + tn * 1024); o.m[2 * tn + 1] = *(const v4u*)(mt + tn * 1024 + 32); }
    o.n[0] = *(const v4u*)nn; o.n[1] = *(const v4u*)(nn + 8);
}
__device__ __forceinline__ void rwkv_chunkB_phase(Frame& F, const Args& A_, int mode = 0) {
    if ((F.vcu & 31) >= 8) return;
    const int chain = (F.vcu >> 5) * 8 + (F.vcu & 31), vb = F.wave & 3; const bool comp = F.wave < 4;
    const int l15 = F.lane & 15, g = F.lane >> 4;
    const int lt = F.tid & 255;
    const bf16* mtg = (const bf16*)(F.ws + WS_MT) + (size_t)chain * 4096 + lt * 8;
    const bf16* nng = (const bf16*)(F.ws + WS_NN) + (size_t)chain * 4096 + lt * 8;
    const int ssoff = (16 * vb + l15) * 64 + 8 * g;
    const int wr = lt >> 3, wp = lt & 7; const int woff = wr * 128 + ((wp ^ (wr & 7)) << 4);
    LAS unsigned char* img = F.lds;
    bf16x8 S0 = {}, S1 = {};
    struct R4 { v4u a, b, c, d; };
    R4 r0, r1, r2, r3, r4, r5;
#define B_LD(r, cc) do { r.a = *(const v4u*)(mtg + (size_t)(cc) * 262144); r.b = *(const v4u*)(mtg + (size_t)(cc) * 262144 + 2048); r.c = *(const v4u*)(nng + (size_t)(cc) * 262144); r.d = *(const v4u*)(nng + (size_t)(cc) * 262144 + 2048); } while (0)
#define B_ST(r, cc) do { LAS unsigned char* d_ = img + ((cc) & 1) * 16384 + woff; *(LAS v4u*)d_ = r.a; *(LAS v4u*)(d_ + 4096) = r.b; *(LAS v4u*)(d_ + 8192) = r.c; *(LAS v4u*)(d_ + 12288) = r.d; } while (0)
    if (!comp) { B_LD(r0, 0); B_LD(r1, 1); B_LD(r2, 2); B_LD(r3, 3); B_LD(r4, 4); B_LD(r5, 5); }
    __syncthreads();
    if (!comp) { B_ST(r0, 0); B_LD(r0, 6); }
    __syncthreads();
#define B_ITER(Rn, cc) do { \
        if (!comp) { if ((cc) + 1 < NCHUNK && mode != 2) { B_ST(Rn, (cc) + 1); if ((cc) + 7 < NCHUNK) B_LD(Rn, (cc) + 7); } } \
        else if (mode != 1) { \
            const LAS unsigned char* si_ = img + ((cc) & 1) * 16384; \
            if ((cc) >= 4) { bf16* sp_ = ss_ptr(F, (cc) - 4, chain) + ssoff; *(v4u*)sp_ = __builtin_bit_cast(v4u, S0); *(v4u*)(sp_ + 32) = __builtin_bit_cast(v4u, S1); } \
            const int vr_ = 16 * vb + l15; \
            const v4u n0_ = *(const LAS v4u*)(si_ + 8192 + vr_ * 128 + (((2 * g) ^ (vr_ & 7)) << 4)), n1_ = *(const LAS v4u*)(si_ + 8192 + vr_ * 128 + (((2 * g + 1) ^ (vr_ & 7)) << 4)); \
            f32x4_t dn_[4]; \
            _Pragma("unroll") for (int tn = 0; tn < 4; ++tn) { const int nr_ = 16 * tn + l15; \
                const bf16x8 a0_ = *(const LAS bf16x8*)(si_ + nr_ * 128 + ((g ^ (nr_ & 7)) << 4)), a1_ = *(const LAS bf16x8*)(si_ + nr_ * 128 + (((4 + g) ^ (nr_ & 7)) << 4)); \
                const v4u nq_ = (tn >> 1) ? n1_ : n0_; const unsigned nx_ = (tn & 1) ? nq_.z : nq_.x, ny_ = (tn & 1) ? nq_.w : nq_.y; \
                const f32x4_t ci_ = {bf_lo(nx_), bf_hi(nx_), bf_lo(ny_), bf_hi(ny_)}; \
                dn_[tn] = mfma16(a0_, S0, ci_); dn_[tn] = mfma16(a1_, S1, dn_[tn]); } \
            v4u w0_, w1_; w0_.x = cvtpk(dn_[0][0], dn_[0][1]); w0_.y = cvtpk(dn_[0][2], dn_[0][3]); w0_.z = cvtpk(dn_[1][0], dn_[1][1]); w0_.w = cvtpk(dn_[1][2], dn_[1][3]); \
            w1_.x = cvtpk(dn_[2][0], dn_[2][1]); w1_.y = cvtpk(dn_[2][2], dn_[2][3]); w1_.z = cvtpk(dn_[3][0], dn_[3][1]); w1_.w = cvtpk(dn_[3][2], dn_[3][3]); \
            S0 = __builtin_bit_cast(bf16x8, w0_); S1 = __builtin_bit_cast(bf16x8, w1_); } \
        __syncthreads(); } while (0)
#pragma unroll 1
    for (int c = 0; c < NCHUNK; c += 6) { B_ITER(r1, c); B_ITER(r2, c + 1); B_ITER(r3, c + 2); B_ITER(r4, c + 3); B_ITER(r5, c + 4); B_ITER(r0, c + 5); }
#undef B_LD
#undef B_ST
#undef B_ITER
}
__device__ __forceinline__ void rwkv_chunkC_phase(Frame& F, const Args& A_, bool do_store) {
    const bf16* QTg = (const bf16*)(F.ws + WS_QT); bf16* Yg = (bf16*)((unsigned char*)F.out + DO_Y);
    const int lane = F.lane, r32 = lane & 31, hi = lane >> 5;
    const int gw = F.vcu * NWAVES + F.wave, NGW = F.G * NWAVES;
#pragma unroll 1
    for (int q = gw; q < 64 * (NCHUNK - 4); q += NGW) {
        const int cl = q >> 6, chain = q & 63, c = cl + 4, b = chain >> 4, h = (chain >> 1) & 7, d = chain & 1;
        const bf16* sp = ss_ptr(F, cl, chain); const bf16* qp = QTg + (size_t)q * 4096;
        bf16x8 af[2][4], bq[2][4];
#pragma unroll
        for (int t = 0; t < 2; ++t)
#pragma unroll
            for (int ks = 0; ks < 4; ++ks) { af[t][ks] = *(const bf16x8*)(sp + (size_t)(32 * t + r32) * 64 + 16 * ks + 8 * hi); bq[t][ks] = *(const bf16x8*)(qp + (size_t)(32 * t + r32) * 64 + 16 * ks + 8 * hi); }
#pragma unroll
        for (int ct = 0; ct < 2; ++ct) {
            bf16* yrow = Yg + ((size_t)d * ML + ROWOF(64 * c + 32 * ct + r32)) * 512 + h * 64;
#pragma unroll
            for (int rt = 0; rt < 2; ++rt) {
                f32x16 acc;
                { const v4u w0 = *(const v4u*)(yrow + 32 * rt + (hi ? 8 : 0)), w1 = *(const v4u*)(yrow + 32 * rt + 16 + (hi ? 8 : 0));
                  const v4u u0 = widen2((v2u){w0.x, w0.y}, (v2u){w0.z, w0.w}), u1 = widen2((v2u){w1.x, w1.y}, (v2u){w1.z, w1.w});
                  acc[0] = bf_lo(u0.x); acc[1] = bf_hi(u0.x); acc[2] = bf_lo(u0.y); acc[3] = bf_hi(u0.y); acc[4] = bf_lo(u0.z); acc[5] = bf_hi(u0.z); acc[6] = bf_lo(u0.w); acc[7] = bf_hi(u0.w);
                  acc[8] = bf_lo(u1.x); acc[9] = bf_hi(u1.x); acc[10] = bf_lo(u1.y); acc[11] = bf_hi(u1.y); acc[12] = bf_lo(u1.z); acc[13] = bf_hi(u1.z); acc[14] = bf_lo(u1.w); acc[15] = bf_hi(u1.w); }
#pragma unroll
                for (int ks = 0; ks < 4; ++ks) acc = mfma32(af[rt][ks], bq[ct][ks], acc);
                if (do_store) store_rows16(yrow + 32 * rt, pk4(acc[0], acc[1], acc[2], acc[3]), pk4(acc[4], acc[5], acc[6], acc[7]), pk4(acc[8], acc[9], acc[10], acc[11]), pk4(acc[12], acc[13], acc[14], acc[15]), hi);
                else asm volatile("" :: "v"(acc));
            }
        }
    }
}

__device__ __forceinline__ void rwkv_readout_phase(Frame& F, const Args& A_) {
    const bf16* ZS = (const bf16*)(F.ws + WS_ZS); const bf16* Y0 = (const bf16*)((unsigned char*)F.out + DO_Y); const bf16* Y1 = Y0 + (size_t)ML * 512;
    const bf16* GG = (const bf16*)((unsigned char*)F.out + DO_G); bf16* O = (bf16*)(F.ws + WS_ATTRW);
    const int gw = F.vcu * NWAVES + F.wave, NGW = F.G * NWAVES, ch = F.lane * 8;
    float rk[8], lg[8], lb[8];
#pragma unroll
    for (int e = 0; e < 8; ++e) { rk[e] = A_.in[I_RK][ch + e]; lg[e] = A_.in[I_LNG][ch + e]; lb[e] = A_.in[I_LNB][ch + e]; }
    for (int row = gw; row < ML; row += NGW) {
        const v4u y0 = *(const v4u*)(Y0 + (size_t)row * 512 + ch), y1 = *(const v4u*)(Y1 + (size_t)row * 512 + ch);
        const v4u rr = *(const v4u*)(ZS + (size_t)row * 1536 + ch), kk = *(const v4u*)(ZS + (size_t)row * 1536 + 512 + ch), vv = *(const v4u*)(ZS + (size_t)row * 1536 + 1024 + ch);
        const v4u gg = *(const v4u*)(GG + (size_t)row * 512 + ch);
        float y[8], s = 0.f, bs = 0.f;
#pragma unroll
        for (int e = 0; e < 4; ++e) { y[2 * e] = bf_lo(y0[e]) + bf_lo(y1[e]); y[2 * e + 1] = bf_hi(y0[e]) + bf_hi(y1[e]); s += y[2 * e] + y[2 * e + 1];
            bs += bf_lo(rr[e]) * bf_lo(kk[e]) * rk[2 * e] + bf_hi(rr[e]) * bf_hi(kk[e]) * rk[2 * e + 1]; }
        const float mean = sum8(s) * (1.f / 64.f); bs = sum8(bs);
        float q = 0.f;
#pragma unroll
        for (int e = 0; e < 8; ++e) { y[e] -= mean; q += y[e] * y[e]; }
        const float rstd = 1.f / sqrtf(sum8(q) * (1.f / 64.f) + GN_EPS);
        float o[8];
#pragma unroll
        for (int e = 0; e < 4; ++e) {
            o[2 * e] = (y[2 * e] * rstd * lg[2 * e] + lb[2 * e] + bs * bf_lo(vv[e])) * bf_lo(gg[e]);
            o[2 * e + 1] = (y[2 * e + 1] * rstd * lg[2 * e + 1] + lb[2 * e + 1] + bs * bf_hi(vv[e])) * bf_hi(gg[e]);
        }
        v4u w; w.x = pk2(o[0], o[1]); w.y = pk2(o[2], o[3]); w.z = pk2(o[4], o[5]); w.w = pk2(o[6], o[7]);
        *(v4u*)(O + (size_t)row * 1024 + 512 + ch) = w;
    }
}
#ifndef FFT_ABL
#define FFT_ABL 0
#endif
template <bool PASS_A> __device__ __forceinline__ void fft_col_phase(Frame& F, bool real_run = true) {
    const int abl = real_run ? 0 : FFT_ABL;
    constexpr int KC = PASS_A ? 64 : 128, K2 = 2 * KC, NU = 2048;
    constexpr int TCOLS = PASS_A ? 512 : 256, FP = TCOLS * 2 + 16, WP = K2 * 2 + 16, NT = PASS_A ? 4 : 2;
    const bf16* In = (const bf16*)(F.ws + (PASS_A ? WS_G1 : WS_Y1)); bf16* Out = (bf16*)(F.ws + (PASS_A ? WS_Y1 : WS_F1));
    const bf16* W = (const bf16*)(F.ws + (PASS_A ? WS_W2A : WS_W2B)); const float* tw = (const float*)(F.ws + WS_TW);
    LAS unsigned char* T = F.lds; LAS unsigned char* WL = F.lds + KC * FP;
    const int lane = F.lane, r32 = lane & 31, hi = lane >> 5, i16 = lane & 15, qd = i16 >> 2, pp = i16 & 3, c0 = lane & 16;
#ifndef WLDS
#define WLDS 2
#endif
    constexpr bool USE_WL = (WLDS >> (PASS_A ? 0 : 1)) & 1;
    __syncthreads();
    if (USE_WL) for (int it = F.tid; it < 128 * (K2 / 8); it += 512) { const int r = it / (K2 / 8), ch = it % (K2 / 8); *(LAS v4u*)(WL + r * WP + ch * 16) = *(const v4u*)(W + (size_t)r * K2 + ch * 8); }
    const int cw = PASS_A ? 32 * F.wave : 32 * (F.wave & 3), t0 = PASS_A ? 0 : 2 * (F.wave >> 2);
#ifndef FFT_PF
#define FFT_PF 3
#endif
    constexpr bool PF = (FFT_PF >> (PASS_A ? 0 : 1)) & 1;
    v4u pf[8];
#define FFT_DEC(u_, b, g, fix, half) do { b = (u_) >> 9; g = ((u_) >> 7) & 3; if (PASS_A) { fix = (u_) & 127; half = 0; } else { fix = ((u_) >> 1) & 63; half = (u_) & 1; } } while (0)
#define FFT_LD(u_) do { int b_, g_, f_, h_; FFT_DEC(u_, b_, g_, f_, h_); \
        _Pragma("unroll") for (int i = 0; i < 8; ++i) { const int it = F.tid + 512 * i; \
            if (PASS_A) { const int k = it >> 6, c16 = it & 63; pf[i] = *(const v4u*)(In + ((size_t)((b_ * 128 + f_) * 4 + g_) * 64 + k) * 512 + c16 * 8); } \
            else { const int k = it >> 5, c16 = it & 31, part = c16 >> 4, cc = c16 & 15; pf[i] = *(const v4u*)(In + ((size_t)((b_ * 64 + f_) * 4 + g_) * 128 + k) * 512 + part * 256 + h_ * 128 + cc * 8); } } } while (0)
#define FFT_ST() do { _Pragma("unroll") for (int i = 0; i < 8; ++i) { const int it = F.tid + 512 * i; const int k = PASS_A ? (it >> 6) : (it >> 5), c16 = PASS_A ? (it & 63) : (it & 31); *(LAS v4u*)(T + k * FP + c16 * 16) = pf[i]; } } while (0)
    if (F.vcu < NU) { FFT_LD(F.vcu); FFT_ST(); }
    for (int unit = F.vcu; unit < NU; unit += F.G) {
        int b, g, fix, half; FFT_DEC(unit, b, g, fix, half);
        const bool more = unit + F.G < NU;
        __syncthreads();
        if (PF && more && abl != 2) FFT_LD(unit + F.G);
        f32x16 acc[NT] = {};
        if (abl == 1) {} else if (!USE_WL) {
#pragma unroll 1
            for (int t = 0; t < NT; ++t) {
                bf16x8 wfr[K2 / 16];
#pragma unroll
                for (int ks = 0; ks < K2 / 16; ++ks) wfr[ks] = *(const bf16x8*)(W + (size_t)(32 * (t0 + t) + r32) * K2 + 16 * ks + 8 * hi);
                f32x16 a = {};
#pragma unroll
                for (int ks = 0; ks < K2 / 16; ++ks) {
                    const int part = (16 * ks) / KC, kb = (16 * ks) % KC;
                    const LAS unsigned char* tb = T + (kb + 8 * hi + qd) * FP + (part * (TCOLS / 2) + cw + c0 + 4 * pp) * 2;
                    a = mfma32(cat4(tr_read(tb), tr_read(tb + 4 * FP)), wfr[ks], a);
                }
                if (t == 0) acc[0] = a; else if (t == 1) acc[1] = a; else if (t == 2) acc[NT > 2 ? 2 : 0] = a; else acc[NT > 3 ? 3 : 0] = a;
            }
        } else {
#pragma unroll 8
        for (int ks = 0; ks < K2 / 16; ++ks) {
            const int part = (16 * ks) / KC, kb = (16 * ks) % KC;
            const LAS unsigned char* tb = T + (kb + 8 * hi + qd) * FP + (part * (TCOLS / 2) + cw + c0 + 4 * pp) * 2;
            const bf16x8 af = cat4(tr_read(tb), tr_read(tb + 4 * FP));
#pragma unroll
            for (int t = 0; t < NT; ++t) { const bf16x8 wf = *(const LAS bf16x8*)(WL + (32 * (t0 + t) + r32) * WP + (16 * ks + 8 * hi) * 2); acc[t] = mfma32(af, wf, acc[t]); }
        }
        }
        __syncthreads();
        constexpr int OP = PASS_A ? 1040 : 272;
        if (PASS_A) {
#pragma unroll
            for (int t = 0; t < 2; ++t) { const int l1p = 32 * t + r32; const int ti = (fix * l1p) & 8191; const float cs = tw[2 * ti], sn = tw[2 * ti + 1];
                LAS unsigned char* op = T + l1p * OP + cw * 2;
#pragma unroll
                for (int q4 = 0; q4 < 4; ++q4) { float re[4], im[4];
#pragma unroll
                    for (int e = 0; e < 4; ++e) { const float a = acc[t][4 * q4 + e], bq = acc[(t + 2) % NT][4 * q4 + e]; re[e] = a * cs + bq * sn; im[e] = bq * cs - a * sn; }
                    *(LAS v2u*)(op + (8 * q4 + 4 * hi) * 2) = pk4(re[0], re[1], re[2], re[3]); *(LAS v2u*)(op + 512 + (8 * q4 + 4 * hi) * 2) = pk4(im[0], im[1], im[2], im[3]); } }
        } else {
#pragma unroll
            for (int t = 0; t < 2; ++t) { LAS unsigned char* op = T + (32 * (t0 + t) + r32) * OP + cw * 2;
#pragma unroll
                for (int q4 = 0; q4 < 4; ++q4) *(LAS v2u*)(op + (8 * q4 + 4 * hi) * 2) = pk4(acc[t][4 * q4], acc[t][4 * q4 + 1], acc[t][4 * q4 + 2], acc[t][4 * q4 + 3]); }
        }
        __syncthreads();
        if (abl != 3) {
            if (PASS_A) {
#pragma unroll
                for (int i = 0; i < 8; ++i) { const int it = F.tid + 512 * i; const int row = it >> 6, c16 = it & 63;
                    *(v4u*)(Out + ((size_t)((b * 64 + row) * 4 + g) * 128 + fix) * 512 + c16 * 8) = *(const LAS v4u*)(T + row * OP + c16 * 16); }
            } else {
#pragma unroll
                for (int i = 0; i < 4; ++i) { const int it = F.tid + 512 * i; const int row = it >> 4, c16 = it & 15;
                    *(v4u*)(Out + ((size_t)((b * 64 + fix) * 128 + row) * 4 + g) * 256 + half * 128 + c16 * 8) = *(const LAS v4u*)(T + row * OP + c16 * 16); }
            }
        }
        __syncthreads();
        if (more) { if (!PF && abl != 2) FFT_LD(unit + F.G); FFT_ST(); }
    }
#undef FFT_DEC
#undef FFT_LD
#undef FFT_ST
}

__device__ __forceinline__ void fft_passA_fused_phase(Frame& F) {
    constexpr int XP = 528, TP = 1040, WP = 272, XO = 0, TO = 64 * XP, WO = TO + 64 * TP, NU = 2048;
    const bf16* XN = (const bf16*)(F.ws + WS_XN); bf16* Out = (bf16*)(F.ws + WS_Y1);
    const bf16* DFTC = (const bf16*)(F.ws + WS_DFTC); const bf16* W = (const bf16*)(F.ws + WS_W2A); const float* tw = (const float*)(F.ws + WS_TW);
    LAS unsigned char* X = F.lds + XO; LAS unsigned char* T = F.lds + TO; LAS unsigned char* WL = F.lds + WO;
    const int lane = F.lane, r32 = lane & 31, hi = lane >> 5, i16 = lane & 15, qd = i16 >> 2, pp = i16 & 3, c0 = lane & 16, w = F.wave, cw = 32 * w;
    __syncthreads();
    for (int it = F.tid; it < 128 * 16; it += 512) { const int r = it >> 4, ch = it & 15; *(LAS v4u*)(WL + r * WP + ch * 16) = *(const v4u*)(W + (size_t)r * 128 + ch * 8); }
    bf16x8 dfr[2][16];
#pragma unroll
    for (int t = 0; t < 2; ++t)
#pragma unroll
        for (int ks = 0; ks < 16; ++ks) dfr[t][ks] = *(const bf16x8*)(DFTC + (size_t)(64 * w + 32 * t + r32) * 256 + 16 * ks + 8 * hi);
    v4u px[4];
#define FA_LD(u_) do { const int b_ = (u_) >> 9, g_ = ((u_) >> 7) & 3, f_ = (u_) & 127; \
        _Pragma("unroll") for (int i = 0; i < 4; ++i) { const int it = F.tid + 512 * i; const int k = it >> 5, c16 = it & 31; px[i] = *(const v4u*)(XN + (size_t)(b_ * SEQ + k * 128 + f_) * 1024 + g_ * 256 + c16 * 8); } } while (0)
#define FA_ST() do { _Pragma("unroll") for (int i = 0; i < 4; ++i) { const int it = F.tid + 512 * i; const int k = it >> 5, c16 = it & 31; *(LAS v4u*)(X + k * XP + c16 * 16) = px[i]; } } while (0)
    if (F.vcu < NU) { FA_LD(F.vcu); FA_ST(); }
    for (int unit = F.vcu; unit < NU; unit += F.G) {
        const int b = unit >> 9, g = (unit >> 7) & 3, fix = unit & 127; const bool more = unit + F.G < NU;
        __syncthreads();
        if (more) FA_LD(unit + F.G);
        {
            f32x16 a2[2][2] = {};
#pragma unroll
            for (int ks = 0; ks < 16; ++ks) {
                const bf16x8 x0 = *(const LAS bf16x8*)(X + r32 * XP + (16 * ks + 8 * hi) * 2), x1 = *(const LAS bf16x8*)(X + (32 + r32) * XP + (16 * ks + 8 * hi) * 2);
#pragma unroll
                for (int t = 0; t < 2; ++t) { a2[t][0] = mfma32(dfr[t][ks], x0, a2[t][0]); a2[t][1] = mfma32(dfr[t][ks], x1, a2[t][1]); }
            }
#pragma unroll
            for (int t = 0; t < 2; ++t)
#pragma unroll
                for (int ct = 0; ct < 2; ++ct) { LAS unsigned char* tp = T + (32 * ct + r32) * TP + (64 * w + 32 * t) * 2;
#pragma unroll
                    for (int q4 = 0; q4 < 4; ++q4) *(LAS v2u*)(tp + (8 * q4 + 4 * hi) * 2) = pk4(a2[t][ct][4 * q4], a2[t][ct][4 * q4 + 1], a2[t][ct][4 * q4 + 2], a2[t][ct][4 * q4 + 3]); }
        }
        __syncthreads();
        if (more) FA_ST();
        f32x16 acc[4] = {};
#pragma unroll 2
        for (int ks = 0; ks < 8; ++ks) {
            const int part = ks >> 2, kb = (16 * ks) & 63;
            const LAS unsigned char* tb = T + (kb + 8 * hi + qd) * TP + (part * 256 + cw + c0 + 4 * pp) * 2;
            const bf16x8 af = cat4(tr_read(tb), tr_read(tb + 4 * TP));
#pragma unroll
            for (int t = 0; t < 4; ++t) acc[t] = mfma32(af, *(const LAS bf16x8*)(WL + (32 * t + r32) * WP + (16 * ks + 8 * hi) * 2), acc[t]);
        }
        __syncthreads();
#pragma unroll
        for (int t = 0; t < 2; ++t) { const int l1p = 32 * t + r32; const int ti = (fix * l1p) & 8191; const float cs = tw[2 * ti], sn = tw[2 * ti + 1];
            LAS unsigned char* op = T + l1p * TP + cw * 2;
#pragma unroll
            for (int q4 = 0; q4 < 4; ++q4) { float re[4], im[4];
#pragma unroll
                for (int e = 0; e < 4; ++e) { const float a = acc[t][4 * q4 + e], bq = acc[t + 2][4 * q4 + e]; re[e] = a * cs + bq * sn; im[e] = bq * cs - a * sn; }
                *(LAS v2u*)(op + (8 * q4 + 4 * hi) * 2) = pk4(re[0], re[1], re[2], re[3]); *(LAS v2u*)(op + 512 + (8 * q4 + 4 * hi) * 2) = pk4(im[0], im[1], im[2], im[3]); } }
        __syncthreads();
#pragma unroll
        for (int i = 0; i < 8; ++i) { const int it = F.tid + 512 * i; const int row = it >> 6, c16 = it & 63;
            *(v4u*)(Out + ((size_t)((b * 64 + row) * 4 + g) * 128 + fix) * 512 + c16 * 8) = *(const LAS v4u*)(T + row * TP + c16 * 16); }
    }
#undef FA_LD
#undef FA_ST
}

__global__ void __launch_bounds__(NWAVES * 64, 2) skel_fwd(Args A_) {
    extern __shared__ __attribute__((aligned(16))) unsigned char lds[];
    Frame F;
    F.lds = (LAS unsigned char*)lds;
    F.tid = threadIdx.x; F.lane = F.tid & 63; F.wave = __builtin_amdgcn_readfirstlane(F.tid >> 6);
    F.G = gridDim.x; { const int bx = blockIdx.x; F.vcu = (F.G % 8 == 0) ? (bx % 8) * (F.G / 8) + bx / 8 : bx; }
    F.ws = A_.ws; F.out = A_.out;
    cg::grid_group grid = cg::this_grid();
    { volatile LAS unsigned* misc = (volatile LAS unsigned*)(F.lds + MISC_OFF); if (F.tid < 16) misc[F.tid] = 0u; }
    __syncthreads();
    XcdBarrier bar = xcd_barrier_post((unsigned*)(F.ws + WS_BAR), (volatile LAS unsigned*)(F.lds + MISC_OFF));
#ifndef USE_CG
#define GSYNC() xcd_barrier(bar)
#else
#define GSYNC() grid.sync()
#endif
    const int lo = A_.ph_lo, hi = A_.ph_hi;
#ifndef PHMASK
#define PHMASK 0x7ffff
#endif
#define IN(k) (((PHMASK >> (k)) & 1) && lo <= (k) && (k) < hi)
#define SEAM(k) do { if (IN(k) && IN((k) + 1)) { if ((k) == 0) grid.sync(); else GSYNC(); } } while (0)
#ifndef REPMASK
#define REPMASK 0
#endif
#ifndef REPS
#define REPS 2
#endif
#define NREP(k) (((REPMASK >> (k)) & 1) ? REPS : 1)
#define PH(k) if (IN(k)) for (int rep_ = 0; rep_ < NREP(k); ++rep_, (rep_ < NREP(k) ? GSYNC() : (void)0))
#define LASTREP(k) (rep_ == NREP(k) - 1)
    const float* zero_gate = (const float*)(F.ws + WS_ZERO);
    const float* mod0 = (const float*)(F.ws + WS_MOD); const float* mod1 = mod0 + 5 * 6144;
    bf16* XN = (bf16*)(F.ws + WS_XN); bf16* XR = (bf16*)(F.ws + WS_XR);

    PH(0) { p0_prologue(F, A_); } SEAM(0);
    PH(1) { norm_phase(F, A_.in[I_X], A_.in[I_CTX], MALL, A_.in[I_N1G], mod0, 0, XN); } SEAM(1);
    PH(2) {
        pg8::Gemm g{XN, (const bf16*)(F.ws + WS_WIN), MALL, INCOLS, DM}; pg8::StaticOrder S; S.init(MALL, INCOLS, F.G, (int)blockIdx.x);
        pg8::EpiInProj E{(bf16*)(F.ws + WS_QKV), (bf16*)(F.ws + WS_ZR), (const float*)(F.ws + WS_ROPE)};
        pg8::gemm_phase<pg8::EpiInProj, pg8::StaticOrder, true, true>(F.lds, g, S, E);
    } SEAM(2);
    PH(3) { rwkv_prep_phase(F, A_); } SEAM(3);
    PH(4) { rwkv_chunkA_phase(F, A_); } if (IN(4)) GSYNC();
#ifndef TM
#define TM 0
#endif
#if TM == 3
    for (int i_ = 0; i_ < 20; ++i_) GSYNC();
#endif
#if TM == 4
    if (IN(4)) { if ((F.vcu & 31) >= 8) attn_phase(F, A_, (F.vcu >> 5) * 24 + (F.vcu & 31) - 8, (F.G >> 5) * 24); GSYNC(); }
#endif
#if TM == 6 || TM == 7
    if (IN(4)) { if ((F.vcu & 31) < 8) rwkv_chunkB_phase(F, A_, TM - 5); GSYNC(); }
#endif
#if TM == 5
    if (IN(4)) { if ((F.vcu & 31) < 8) rwkv_chunkB_phase(F, A_); GSYNC(); }
#endif
#if TM == 1
    if (IN(4)) { if ((F.vcu & 31) < 8) rwkv_chunkB_phase(F, A_); else attn_phase(F, A_, (F.vcu >> 5) * 24 + (F.vcu & 31) - 8, (F.G >> 5) * 24); GSYNC(); }
#endif
    if (IN(4)) { if ((F.vcu & 31) < 8) rwkv_chunkB_phase(F, A_); else attn_phase(F, A_, (F.vcu >> 5) * 24 + (F.vcu & 31) - 8, (F.G >> 5) * 24); GSYNC(); }
#if TM == 2
    if (IN(4)) { rwkv_chunkC_phase(F, A_, A_.ph_lo == 12345); GSYNC(); }
#endif
    if (IN(4)) { rwkv_chunkC_phase(F, A_, true); } SEAM(4);
    PH(5) { rwkv_readout_phase(F, A_); } SEAM(5);
    PH(6) {
        pg8::Gemm g{(const bf16*)(F.ws + WS_ATTRW), (const bf16*)(F.ws + WS_WOUT), ML, DM, DM}; pg8::StaticOrder S; S.init(ML, DM, F.G, (int)blockIdx.x);
        pg8::EpiResidualT<false, false, true> E{A_.in[I_X], XR, mod0 + 2048, 6144};
        pg8::gemm_phase<pg8::EpiResidualT<false, false, true>, pg8::StaticOrder, true, true>(F.lds, g, S, E);
    } SEAM(6);
    PH(7) { norm_bf16_phase(F, XR, A_.in[I_N2G], mod0, 3072, XN); } SEAM(7);
    PH(8) {
        pg8::Gemm g{XN, (const bf16*)(F.ws + WS_W1), ML, FF, DM}; pg8::StaticOrder S; S.init(ML, FF, F.G, (int)blockIdx.x);
        pg8::EpiStore<2> E{(bf16*)(F.ws + WS_H), FF};
        pg8::gemm_phase<pg8::EpiStore<2>, pg8::StaticOrder, true, true>(F.lds, g, S, E);
    } SEAM(8);
    PH(9) {
        pg8::Gemm g{(const bf16*)(F.ws + WS_H), (const bf16*)(F.ws + WS_W2), ML, DM, FF}; pg8::StaticOrder S; S.init(ML, DM, F.G, (int)blockIdx.x);
        pg8::EpiResidualT<false, true, true> E{XR, XR, LASTREP(9) ? mod0 + 5120 : zero_gate, LASTREP(9) ? 6144 : 0};
        pg8::gemm_phase<pg8::EpiResidualT<false, true, true>, pg8::StaticOrder, true, true>(F.lds, g, S, E);
    } SEAM(9);
    PH(10) { norm_bf16_phase(F, XR, A_.in[I_N1G] + DM, mod1, 0, XN); } SEAM(10);
    PH(12) { fft_passA_fused_phase(F); } SEAM(12);
    PH(13) { fft_col_phase<false>(F, LASTREP(13)); } SEAM(13);
    PH(14) {
        pg8::Gemm g{(const bf16*)(F.ws + WS_F1), (const bf16*)(F.ws + WS_WF), ML, DM, DM}; pg8::StaticOrder S; S.init(ML, DM, F.G, (int)blockIdx.x);
        pg8::EpiResidualT<true, true, true> E{XR, XR, LASTREP(14) ? mod1 + 2048 : zero_gate, LASTREP(14) ? 6144 : 0};
        pg8::gemm_phase<pg8::EpiResidualT<true, true, true>, pg8::StaticOrder, true, true>(F.lds, g, S, E);
    } SEAM(14);
    PH(15) { norm_bf16_phase(F, XR, A_.in[I_N2G] + DM, mod1, 3072, XN); } SEAM(15);
    PH(16) {
        pg8::Gemm g{XN, (const bf16*)(F.ws + WS_W1) + (size_t)DM * FF, ML, FF, DM}; pg8::StaticOrder S; S.init(ML, FF, F.G, (int)blockIdx.x);
        pg8::EpiStore<2> E{(bf16*)(F.ws + WS_H), FF};
        pg8::gemm_phase<pg8::EpiStore<2>, pg8::StaticOrder, true, true>(F.lds, g, S, E);
    } SEAM(16);
    PH(17) {
        pg8::Gemm g{(const bf16*)(F.ws + WS_H), (const bf16*)(F.ws + WS_W2) + (size_t)DM * FF, ML, DM, FF}; pg8::StaticOrder S; S.init(ML, DM, F.G, (int)blockIdx.x);
        pg8::EpiResidualT<false, true, true> E{XR, XR, LASTREP(17) ? mod1 + 5120 : zero_gate, LASTREP(17) ? 6144 : 0};
        pg8::gemm_phase<pg8::EpiResidualT<false, true, true>, pg8::StaticOrder, true, true>(F.lds, g, S, E);
    } SEAM(17);
    PH(18) { final_norm_bf16_phase(F, XR, F.out, A_.in[I_FING]); }
#undef IN
#undef SEAM
}

extern "C" void kernel_launch(void* const* d_in, const int* in_sizes, int n_in, void* d_out, int out_size, void* d_ws, size_t ws_size, hipStream_t stream) {
    static int grid = 0;
    if (grid == 0) {
        if (n_in != 27 || out_size != ML * DM || ws_size < WS_END) { fprintf(stderr, "kernel_launch: unexpected shapes: n_in %d out %d ws %zu\n", n_in, out_size, ws_size); grid = -1; return; }
        int dev = 0, cus = 0, per_cu = 0;
        (void)hipGetDevice(&dev); (void)hipDeviceGetAttribute(&cus, hipDeviceAttributeMultiprocessorCount, dev);
        (void)hipFuncSetAttribute((const void*)skel_fwd, hipFuncAttributeMaxDynamicSharedMemorySize, LDS_BYTES);
        (void)hipOccupancyMaxActiveBlocksPerMultiprocessor(&per_cu, (const void*)skel_fwd, NWAVES * 64, LDS_BYTES);
        (void)hipGetLastError();
        if (per_cu < 1) { fprintf(stderr, "kernel_launch: occupancy query reports %d\n", per_cu); }
        grid = cus;
    }
    if (grid < 0) return;
    if (hipMemsetAsync((char*)d_ws + WS_BAR, 0, 16384, stream) != hipSuccess) { fprintf(stderr, "kernel_launch: memset failed\n"); return; }
    Args a{};
    for (int i = 0; i < 27; ++i) a.in[i] = (const float*)d_in[i];
    a.out = (float*)d_out; a.ws = (unsigned char*)d_ws;
    if (MK_N_LAUNCHES == 1) {
        a.ph_lo = 0; a.ph_hi = N_PHASES;
        void* kargs[] = {&a};
        hipError_t e = hipLaunchCooperativeKernel((const void*)skel_fwd, dim3(grid), dim3(NWAVES * 64), kargs, LDS_BYTES, stream);
        if (e != hipSuccess) fprintf(stderr, "cooperative launch failed: %s (grid %d)\n", hipGetErrorString(e), grid);
    } else {
        for (int p = 0; p < N_PHASES; ++p) { a.ph_lo = p; a.ph_hi = p + 1; hipLaunchKernelGGL(skel_fwd, dim3(grid), dim3(NWAVES * 64), LDS_BYTES, stream, a); }
    }
}
```

```cpp
#include <hip/hip_runtime.h>
#include <hip/hip_cooperative_groups.h>
#include <cstdio>
#include <cstdint>
namespace cg = cooperative_groups;
namespace pg8 {
#define PG8_LAS __attribute__((address_space(3)))
typedef unsigned short bf16_t;
typedef short bf16x8 __attribute__((ext_vector_type(8)));
typedef float f32x4 __attribute__((ext_vector_type(4)));
typedef unsigned u32x4 __attribute__((ext_vector_type(4)));
constexpr int BM = 256, BK = 64, HALF = 128, HTB = HALF * BK * 2  , STAGE_BYTES = 8 * HTB, NXCD = 8, WGM = 8;

__host__ __device__ __forceinline__ int lds_byte(int r, int c) { const int st = (r >> 4) * 2 + (c >> 5), rr = r & 15, cc = c & 31, ob = rr * 64 + cc * 2; return st * 1024 + (ob ^ (((ob >> 9) & 1) << 5)); }
__host__ __device__ __forceinline__ void stage_rc(int b, int& R, int& C) { const int st = b / 1024, sb = b % 1024, swz = sb ^ (((sb >> 9) & 1) << 5); R = (st >> 1) * 16 + swz / 64; C = (st & 1) * 32 + (swz % 64) / 2; }
__host__ __device__ __forceinline__ int perm32(int rho) { const int n = rho >> 4, i = rho & 15; return 8 * (i >> 2) + 4 * n + (i & 3); }

struct Unit { int pm, pn; };
struct Gemm { const bf16_t* A; const bf16_t* Bt; int M, N, K; };

struct StaticOrder {
    int nM, nN, nwg, G, c; bool rev = false;
    __host__ __device__ void init(int M, int N, int G_, int c_) { nM = M / BM; nN = N / BM; nwg = nM * nN; G = G_; c = c_; }
    __host__ __device__ bool next(int i, Unit& u) const {
        const int nr = nwg / G; if (rev && nwg % G == 0 && i < nr) i = nr - 1 - i;
        const long L = (long)i * G + c; if (L >= nwg) return false;
        int wgid = (int)L; { const int q = nwg / NXCD, r = nwg % NXCD, xcd = wgid % NXCD, off = wgid / NXCD; wgid = (xcd < r ? xcd * (q + 1) : r * (q + 1) + (xcd - r) * q) + off; }
        const int nig = WGM * nN, gid = wgid / nig, fm = gid * WGM, gsz = (nM - fm) < WGM ? (nM - fm) : WGM;
        u.pm = fm + ((wgid % nig) % gsz); u.pn = (wgid % nig) / gsz; return true;
    }
    __device__ __forceinline__ void a_ready(const Unit&) const {}
    __device__ __forceinline__ void done(const Unit&) const {}
};

__device__ __forceinline__ unsigned cvt_pk_bf16(float lo, float hi) { unsigned r; asm volatile("v_cvt_pk_bf16_f32 %0, %1, %2" : "=v"(r) : "v"(lo), "v"(hi)); return r; }
typedef float f32x2 __attribute__((ext_vector_type(2)));
__device__ __forceinline__ f32x2 gelu_pk(f32x2 v) {
    const f32x2 av = __builtin_elementwise_abs(v), d = av * 0.2316418882f + 1.0f;
    f32x2 t; t.x = __builtin_amdgcn_rcpf(d.x); t.y = __builtin_amdgcn_rcpf(d.y);
    f32x2 q = t * 0.5307027145f + (-0.7265760135f); q = q * t + 0.7107068705f; q = q * t + (-0.142248368f); q = q * t + 0.127414796f; q = q * t;
    const f32x2 s = (v * v) * (-0.72134752044f);
    f32x2 e; e.x = __builtin_amdgcn_exp2f(s.x); e.y = __builtin_amdgcn_exp2f(s.y);
    const f32x2 m = v * (q * e), r = v - m;
    f32x2 o; o.x = v.x < 0.f ? m.x : r.x; o.y = v.y < 0.f ? m.y : r.y; return o;
}

template <int ACT  > struct EpiBf16 {
    static constexpr bool PERM = true, AFTER_DRAIN = false; static_assert(ACT == 0 || ACT == 1, "EpiBf16: ACT is 0 (none) or 1 (gelu_pk)");
    bf16_t* O; int ldc; const float* bias; int split_cols; size_t split_stride; float scale0;
    __device__ __forceinline__ void operator()(const f32x4 (&acc)[2][2][4][2], const Unit& u, int wr, int wc, int fr, int fq) const {
        const int row0 = u.pm * BM + wr * 64 + fr; int colt = u.pn * BM; bf16_t* base = O;
        float sc = 1.f; if (split_cols) { const int t = colt / split_cols; base += (size_t)t * split_stride; colt -= t * split_cols; if (t == 0) sc = scale0; }
        const int col0 = colt + wc * 32 + 8 * fq, bcol0 = u.pn * BM + wc * 32 + 8 * fq;
        f32x4 bv[2][2];
#pragma unroll
        for (int bj = 0; bj < 2; ++bj)
#pragma unroll
            for (int n = 0; n < 2; ++n) bv[bj][n] = bias ? *(const f32x4*)(bias + bcol0 + bj * HALF + 4 * n) : (f32x4){0.f, 0.f, 0.f, 0.f};
#pragma unroll
        for (int ai = 0; ai < 2; ++ai)
#pragma unroll
            for (int m = 0; m < 4; ++m) { bf16_t* rowp = base + (size_t)(row0 + ai * HALF + m * 16) * ldc + col0;
#pragma unroll
                for (int bj = 0; bj < 2; ++bj) { f32x4 v0 = acc[ai][bj][m][0] + bv[bj][0], v1 = acc[ai][bj][m][1] + bv[bj][1];
                    if (ACT == 1) { f32x2 a = gelu_pk((f32x2){v0[0], v0[1]}), b = gelu_pk((f32x2){v0[2], v0[3]}), c = gelu_pk((f32x2){v1[0], v1[1]}), d = gelu_pk((f32x2){v1[2], v1[3]});
                        v0 = (f32x4){a.x, a.y, b.x, b.y}; v1 = (f32x4){c.x, c.y, d.x, d.y}; }
                    v0 = v0 * sc; v1 = v1 * sc; u32x4 w; w.x = cvt_pk_bf16(v0[0], v0[1]); w.y = cvt_pk_bf16(v0[2], v0[3]); w.z = cvt_pk_bf16(v1[0], v1[1]); w.w = cvt_pk_bf16(v1[2], v1[3]);
                    *(u32x4*)(rowp + bj * HALF) = w; } }
    }
};
typedef float f32x2e __attribute__((ext_vector_type(2)));
struct EpiInProj {
    static constexpr bool PERM = true, AFTER_DRAIN = false;
    bf16_t* QKV; bf16_t* ZR; const float* rope;
    __device__ __forceinline__ void operator()(const f32x4 (&acc)[2][2][4][2], const Unit& u, int wr, int wc, int fr, int fq) const {
        const int row0 = u.pm * BM + wr * 64 + fr; const int colt = u.pn * BM;
        if (colt >= 768) {
#pragma unroll
            for (int ai = 0; ai < 2; ++ai)
#pragma unroll
                for (int m = 0; m < 4; ++m) { bf16_t* rowp = ZR + (size_t)(row0 + ai * HALF + m * 16) * 1792 + (colt - 768) + wc * 32 + 8 * fq;
#pragma unroll
                    for (int bj = 0; bj < 2; ++bj) { const f32x4 v0 = acc[ai][bj][m][0], v1 = acc[ai][bj][m][1];
                        u32x4 w; w.x = cvt_pk_bf16(v0[0], v0[1]); w.y = cvt_pk_bf16(v0[2], v0[3]); w.z = cvt_pk_bf16(v1[0], v1[1]); w.w = cvt_pk_bf16(v1[2], v1[3]);
                        *(u32x4*)(rowp + bj * HALF) = w; } }
            return;
        }
        const bool latent = u.pm < 128;
        const int axis = wc & 1;
        const float sgn = (fq < 2) ? -1.f : 1.f;
#pragma unroll
        for (int ai = 0; ai < 2; ++ai)
#pragma unroll
            for (int m = 0; m < 4; ++m) {
                const int row = row0 + ai * HALF + m * 16; const int t = row & 8191; const int pos = axis ? (t & 63) : (t >> 6);
                f32x4 cs[4];
                if (latent) {
#pragma unroll
                    for (int i = 0; i < 4; ++i) cs[i] = *(const f32x4*)(rope + (size_t)(pos * 16 + 8 * (fq & 1) + 2 * i) * 2);
                }
                bf16_t* rowp = QKV + (size_t)row * 768 + colt + wc * 32 + 8 * fq;
#pragma unroll
                for (int bj = 0; bj < 2; ++bj) {
                    const int colb = colt + bj * HALF;
                    const bool is_v = (colb == 640), is_q = (colb < 512);
                    f32x4 v0 = acc[ai][bj][m][0], v1 = acc[ai][bj][m][1];
                    if (latent && !is_v) {
                        f32x4 o0, o1;
#pragma unroll
                        for (int e = 0; e < 4; ++e) { o0[e] = __shfl_xor(v0[e], 32); o1[e] = __shfl_xor(v1[e], 32); }
                        v0[0] = v0[0] * cs[0][0] + sgn * o0[0] * cs[0][1]; v0[1] = v0[1] * cs[0][2] + sgn * o0[1] * cs[0][3];
                        v0[2] = v0[2] * cs[1][0] + sgn * o0[2] * cs[1][1]; v0[3] = v0[3] * cs[1][2] + sgn * o0[3] * cs[1][3];
                        v1[0] = v1[0] * cs[2][0] + sgn * o1[0] * cs[2][1]; v1[1] = v1[1] * cs[2][2] + sgn * o1[1] * cs[2][3];
                        v1[2] = v1[2] * cs[3][0] + sgn * o1[2] * cs[3][1]; v1[3] = v1[3] * cs[3][2] + sgn * o1[3] * cs[3][3];
                    }
                    if (is_q) { v0 = v0 * 0.18033688011112042f; v1 = v1 * 0.18033688011112042f; }
                    u32x4 w; w.x = cvt_pk_bf16(v0[0], v0[1]); w.y = cvt_pk_bf16(v0[2], v0[3]); w.z = cvt_pk_bf16(v1[0], v1[1]); w.w = cvt_pk_bf16(v1[2], v1[3]);
                    *(u32x4*)(rowp + bj * HALF) = w;
                }
            }
    }
};
template <bool FFTROWS, bool BIN, bool BOUT> struct EpiResidualT {
    static constexpr bool PERM = true, AFTER_DRAIN = false;
    const void* base; void* out; const float* gate; int gate_stride;
    unsigned long long* ssq = nullptr;
    __device__ __forceinline__ void operator()(const f32x4 (&acc)[2][2][4][2], const Unit& u, int wr, int wc, int fr, int fq) const {
        const int row0 = u.pm * BM + wr * 64 + fr; const int col0 = u.pn * BM + wc * 32 + 8 * fq;
        const float* gp = gate + (size_t)(u.pm >> 5) * gate_stride + col0;
        f32x4 gv[2][2];
#pragma unroll
        for (int bj = 0; bj < 2; ++bj)
#pragma unroll
            for (int n = 0; n < 2; ++n) gv[bj][n] = *(const f32x4*)(gp + bj * HALF + n * 4);
#ifndef EPI_NB
#define EPI_NB 8
#endif
        constexpr int NB = BIN ? EPI_NB : 4;
        static_assert(16 % NB == 0, "batch");
#pragma unroll
        for (int i0 = 0; i0 < 16; i0 += NB) {
            u32x4 bw[NB]; f32x4 bf0[BIN ? 1 : NB], bf1[BIN ? 1 : NB];
#define EPI_OFF(r0_, i_) ([&]() { int row_ = (r0_) + ((i_) >> 3) * HALF + (((i_) >> 1) & 3) * 16; if (FFTROWS) row_ = (row_ & ~8191) | ((row_ >> 7) & 63) | ((row_ & 127) << 6); return (size_t)row_ * 1024 + col0 + ((i_) & 1) * HALF; }())
#pragma unroll
            for (int j = 0; j < NB; ++j) { const size_t off = EPI_OFF(row0, i0 + j);
                if (BIN) bw[j] = *(const u32x4*)((const bf16_t*)base + off);
                else { bf0[j] = *(const f32x4*)((const float*)base + off); bf1[j] = *(const f32x4*)((const float*)base + off + 4); } }
            float rowq = 0.f;
            int row0s = row0; asm volatile("" : "+v"(row0s));
#pragma unroll
            for (int j = 0; j < NB; ++j) { const int i = i0 + j, ai = i >> 3, m = (i >> 1) & 3, bj = i & 1; const size_t off = EPI_OFF(row0s, i);
                f32x4 b0, b1;
                if (BIN) { const u32x4 w = bw[j];
                    b0 = (f32x4){__builtin_bit_cast(float, w.x << 16), __builtin_bit_cast(float, w.x & 0xffff0000u), __builtin_bit_cast(float, w.y << 16), __builtin_bit_cast(float, w.y & 0xffff0000u)};
                    b1 = (f32x4){__builtin_bit_cast(float, w.z << 16), __builtin_bit_cast(float, w.z & 0xffff0000u), __builtin_bit_cast(float, w.w << 16), __builtin_bit_cast(float, w.w & 0xffff0000u)}; }
                else { b0 = bf0[j]; b1 = bf1[j]; }
                const f32x4 o0 = b0 + gv[bj][0] * acc[ai][bj][m][0], o1 = b1 + gv[bj][1] * acc[ai][bj][m][1];
                if (BOUT) { u32x4 w; w.x = cvt_pk_bf16(o0[0], o0[1]); w.y = cvt_pk_bf16(o0[2], o0[3]); w.z = cvt_pk_bf16(o1[0], o1[1]); w.w = cvt_pk_bf16(o1[2], o1[3]); *(u32x4*)((bf16_t*)out + off) = w;
                    if (ssq) {
                        float q = 0.f;
#pragma unroll
                        for (int t = 0; t < 4; ++t) { const unsigned u_ = (t == 0) ? w.x : (t == 1) ? w.y : (t == 2) ? w.z : w.w; const float lo = __builtin_bit_cast(float, u_ << 16), hi_ = __builtin_bit_cast(float, u_ & 0xffff0000u); q += lo * lo + hi_ * hi_; }
                        if (bj == 0) rowq = q; else { float t_ = rowq + q; t_ += __shfl_xor(t_, 16); t_ += __shfl_xor(t_, 32); if (fq == 0) atomicAdd(ssq + (off >> 10), (unsigned long long)(t_ * 1048576.f + 0.5f)); }
                    } }
                else { *(f32x4*)((float*)out + off) = o0; *(f32x4*)((float*)out + off + 4) = o1; }
            }
#undef EPI_OFF
        }
    }
};
template <int ACT, bool FFTROWS = false> struct EpiStore {
    static constexpr bool PERM = true, AFTER_DRAIN = false;
    bf16_t* O; int ldc; bool dostore = true;
    __device__ __forceinline__ void operator()(const f32x4 (&acc)[2][2][4][2], const Unit& u, int wr, int wc, int fr, int fq) const {
#ifdef NOST
        if (!dostore) return;
#endif
        const int row0 = u.pm * BM + wr * 64 + fr; const int col0 = u.pn * BM + wc * 32 + 8 * fq;
#pragma unroll
        for (int ai = 0; ai < 2; ++ai)
#pragma unroll
            for (int m = 0; m < 4; ++m) { int row = row0 + ai * HALF + m * 16;
                if (FFTROWS) { const int g = row & 3, l = (row >> 2) & 8191, b = row >> 15; row = (((b * 128 + (l & 127)) * 4 + g) << 6) | (l >> 7); }
                bf16_t* rowp = O + (size_t)row * ldc + col0;
#pragma unroll
                for (int bj = 0; bj < 2; ++bj) { f32x4 v0 = acc[ai][bj][m][0], v1 = acc[ai][bj][m][1];
                    if (ACT == 2) {
#pragma unroll
                        for (int e = 0; e < 4; ++e) { const float a = fmaxf(v0[e], 0.f), b = fmaxf(v1[e], 0.f); v0[e] = a * a; v1[e] = b * b; }
                    }
                    u32x4 w; w.x = cvt_pk_bf16(v0[0], v0[1]); w.y = cvt_pk_bf16(v0[2], v0[3]); w.z = cvt_pk_bf16(v1[0], v1[1]); w.w = cvt_pk_bf16(v1[2], v1[3]);
                    *(u32x4*)(rowp + bj * HALF) = w; } }
    }
};
template <class Epi, class Sched, bool ALIGN_EPI = false, bool SP2 = false>
__device__ __forceinline__ void gemm_phase(PG8_LAS unsigned char* lds, const Gemm g, const Sched& S, const Epi& E) {
    const int tid = threadIdx.x, wid = __builtin_amdgcn_readfirstlane(tid >> 6), lane = tid & 63, wr = wid >> 2, wc = wid & 3, fr = lane & 15, fq = lane >> 4;
    int K_ = g.K; asm volatile("" : "+s"(K_)); const int K = K_, nt = K / BK;
    unsigned voffA[2], voffB[2];
#pragma unroll
    for (int i = 0; i < 2; ++i) { int R, C; stage_rc(tid * 16 + i * 8192, R, C); const int Rb = Epi::PERM ? ((R & ~31) + perm32(R & 31)) : R;
        voffA[i] = (unsigned)(R * K + C) * 2u; voffB[i] = (unsigned)(Rb * K + C) * 2u; }
    const size_t kstep = (size_t)(BK * 2);
    const size_t hstep = (size_t)HALF * K * 2;
    const size_t tstep = 2 * hstep;
    const unsigned ldsw = (unsigned)wid * 1024u;
    const int aoff = lds_byte(wr * 64 + fr, fq * 8), boff = lds_byte(wc * 32 + fr, fq * 8);
#define PG8_SA(b, h) (((b) * 2 + (h)) * HTB)
#define PG8_SB(b, h) ((4 + (b) * 2 + (h)) * HTB)
#define PG8_STAGE(bufoff, gbase, voff) do { _Pragma("unroll") for (int _i = 0; _i < 2; ++_i) \
        __builtin_amdgcn_global_load_lds((const unsigned*)((const char*)(gbase) + (voff)[_i]), (PG8_LAS unsigned*)(lds + (bufoff) + ldsw + _i * 8192), 16, 0, 0); } while (0)
#define PG8_LDA(dst, b, h) do { _Pragma("unroll") for (int m = 0; m < 4; ++m) _Pragma("unroll") for (int k = 0; k < 2; ++k) dst[m][k] = *(const PG8_LAS bf16x8*)(lds + PG8_SA(b, h) + aoff + m * 2048 + k * 1024); } while (0)
#define PG8_LDB(dst, b, h) do { _Pragma("unroll") for (int n = 0; n < 2; ++n) _Pragma("unroll") for (int k = 0; k < 2; ++k) dst[n][k] = *(const PG8_LAS bf16x8*)(lds + PG8_SB(b, h) + boff + n * 2048 + k * 1024); } while (0)
#define PG8_MMA(ai, bj, At, Bt) do { __builtin_amdgcn_s_setprio(1); _Pragma("unroll") for (int m = 0; m < 4; ++m) _Pragma("unroll") for (int n = 0; n < 2; ++n) _Pragma("unroll") for (int k = 0; k < 2; ++k) \
        acc[ai][bj][m][n] = __builtin_amdgcn_mfma_f32_16x16x32_bf16(Bt[n][k], At[m][k], acc[ai][bj][m][n], 0, 0, 0); __builtin_amdgcn_s_setprio(0); } while (0)
#define PG8_WAIT_V(n) asm volatile("s_waitcnt vmcnt(" #n ")" ::: "memory")
#define PG8_WAIT_L(n) asm volatile("s_waitcnt lgkmcnt(" #n ")" ::: "memory")
#define PG8_BAR __builtin_amdgcn_s_barrier()
#define PG8_SCHED __builtin_amdgcn_sched_barrier(0)
    Unit cur, nxt; int ui = 0;
    if (!S.next(0, cur)) return;
    f32x4 acc[2][2][4][2];
#pragma unroll
    for (int a = 0; a < 2; ++a)
#pragma unroll
        for (int b = 0; b < 2; ++b)
#pragma unroll
            for (int m = 0; m < 4; ++m)
#pragma unroll
                for (int n = 0; n < 2; ++n) acc[a][b][m][n] = (f32x4){0.f, 0.f, 0.f, 0.f};
    bf16x8 At[4][2], B0[2][2], B1[2][2];
    const char* cA = (const char*)g.A + (size_t)cur.pm * tstep; const char* cB = (const char*)g.Bt + (size_t)cur.pn * tstep;
    S.a_ready(cur);
    if constexpr (SP2) {
        PG8_STAGE(PG8_SB(0, 0), cB, voffB); PG8_STAGE(PG8_SB(0, 1), cB + hstep, voffB); PG8_STAGE(PG8_SA(0, 0), cA, voffA); PG8_STAGE(PG8_SA(0, 1), cA + hstep, voffA);
        if (wr == 1) PG8_BAR;
        PG8_WAIT_V(2); PG8_BAR;
        PG8_STAGE(PG8_SB(1, 0), cB + kstep, voffB); PG8_STAGE(PG8_SA(1, 0), cA + kstep, voffA); PG8_STAGE(PG8_SB(1, 1), cB + hstep + kstep, voffB);
        PG8_WAIT_V(6); PG8_BAR;
    } else {
        PG8_STAGE(PG8_SB(0, 0), cB, voffB); PG8_STAGE(PG8_SA(0, 0), cA, voffA); PG8_STAGE(PG8_SB(0, 1), cB + hstep, voffB); PG8_STAGE(PG8_SA(0, 1), cA + hstep, voffA);
        if (wr == 1) PG8_BAR;
        PG8_WAIT_V(4); PG8_BAR;
        PG8_STAGE(PG8_SB(1, 0), cB + kstep, voffB); PG8_STAGE(PG8_SA(1, 0), cA + kstep, voffA); PG8_STAGE(PG8_SB(1, 1), cB + hstep + kstep, voffB);
        PG8_WAIT_V(6); PG8_BAR;
    }
    for (;;) {
        const bool has_next = S.next(ui + 1, nxt);
        const char* nA = has_next ? (const char*)g.A + (size_t)nxt.pm * tstep : cA; const char* nB = has_next ? (const char*)g.Bt + (size_t)nxt.pn * tstep : cB;
        for (int t = 0; t < nt; t += 2) {
            const bool last = (t == nt - 2);
            const char* a1 = cA + (size_t)(t + 1) * kstep;
            const char* a2 = last ? nA : cA + (size_t)(t + 2) * kstep; const char* b2 = last ? nB : cB + (size_t)(t + 2) * kstep;
            const char* a3 = a2 + kstep; const char* b3 = b2 + kstep;
            if (last && has_next) S.a_ready(nxt);
            if constexpr (SP2) {
            PG8_LDB(B0, 0, 0); PG8_LDB(B1, 0, 1); PG8_SCHED; PG8_LDA(At, 0, 0); PG8_STAGE(PG8_SA(1, 1), a1 + hstep, voffA);
            PG8_WAIT_V(8); PG8_WAIT_L(0); PG8_BAR; PG8_MMA(0, 0, At, B0); PG8_MMA(0, 1, At, B1); PG8_BAR; PG8_SCHED;
            PG8_LDA(At, 0, 1); PG8_STAGE(PG8_SB(0, 0), b2, voffB); PG8_STAGE(PG8_SB(0, 1), b2 + hstep, voffB); PG8_STAGE(PG8_SA(0, 0), a2, voffA);
            PG8_WAIT_V(8); PG8_WAIT_L(0); PG8_BAR; PG8_MMA(1, 0, At, B0); PG8_MMA(1, 1, At, B1); PG8_BAR; PG8_SCHED;
            PG8_LDB(B0, 1, 0); PG8_LDB(B1, 1, 1); PG8_SCHED; PG8_LDA(At, 1, 0); PG8_STAGE(PG8_SA(0, 1), a2 + hstep, voffA);
            PG8_WAIT_V(8); PG8_WAIT_L(0); PG8_BAR; PG8_MMA(0, 0, At, B0); PG8_MMA(0, 1, At, B1); PG8_BAR; PG8_SCHED;
            PG8_LDA(At, 1, 1); PG8_STAGE(PG8_SB(1, 0), b3, voffB); PG8_STAGE(PG8_SB(1, 1), b3 + hstep, voffB); PG8_STAGE(PG8_SA(1, 0), a3, voffA);
            PG8_WAIT_V(8); PG8_WAIT_L(0); PG8_BAR; PG8_MMA(1, 0, At, B0); PG8_MMA(1, 1, At, B1); PG8_BAR; PG8_SCHED;
            } else {
            PG8_LDB(B0, 0, 0); PG8_SCHED; PG8_LDA(At, 0, 0); PG8_STAGE(PG8_SA(1, 1), a1 + hstep, voffA);
            PG8_WAIT_L(8); PG8_BAR; PG8_WAIT_L(0); PG8_MMA(0, 0, At, B0); PG8_BAR; PG8_SCHED;
            PG8_LDB(B1, 0, 1); PG8_STAGE(PG8_SB(0, 0), b2, voffB);
            PG8_BAR; PG8_WAIT_L(0); PG8_MMA(0, 1, At, B1); PG8_BAR;
            PG8_LDA(At, 0, 1); PG8_STAGE(PG8_SA(0, 0), a2, voffA);
            PG8_BAR; PG8_WAIT_L(0); PG8_MMA(1, 0, At, B0); PG8_BAR; PG8_SCHED;
            PG8_STAGE(PG8_SB(0, 1), b2 + hstep, voffB);
            PG8_WAIT_V(6); PG8_BAR; PG8_MMA(1, 1, At, B1); PG8_BAR;
            PG8_LDB(B0, 1, 0); PG8_SCHED; PG8_LDA(At, 1, 0); PG8_STAGE(PG8_SA(0, 1), a2 + hstep, voffA);
            PG8_WAIT_L(8); PG8_BAR; PG8_WAIT_L(0); PG8_MMA(0, 0, At, B0); PG8_BAR; PG8_SCHED;
            PG8_LDB(B1, 1, 1); PG8_STAGE(PG8_SB(1, 0), b3, voffB);
            PG8_BAR; PG8_WAIT_L(0); PG8_MMA(0, 1, At, B1); PG8_BAR;
            PG8_LDA(At, 1, 1); PG8_STAGE(PG8_SA(1, 0), a3, voffA);
            PG8_BAR; PG8_WAIT_L(0); PG8_MMA(1, 0, At, B0); PG8_BAR; PG8_SCHED;
            PG8_STAGE(PG8_SB(1, 1), b3 + hstep, voffB);
            PG8_WAIT_V(6); PG8_BAR; PG8_MMA(1, 1, At, B1); PG8_BAR;
            }
        }
        if constexpr (ALIGN_EPI) { if (wr == 0) PG8_BAR; }
        if constexpr (!Epi::AFTER_DRAIN) { E(acc, cur, wr, wc, fr, fq); S.done(cur); }
        if (!has_next) break;
#pragma unroll
        for (int a = 0; a < 2; ++a)
#pragma unroll
            for (int b = 0; b < 2; ++b)
#pragma unroll
                for (int m = 0; m < 4; ++m)
#pragma unroll
                    for (int n = 0; n < 2; ++n) acc[a][b][m][n] = (f32x4){0.f, 0.f, 0.f, 0.f};
        cur = nxt; cA = nA; cB = nB; ++ui;
        if constexpr (ALIGN_EPI) { if (wr == 1) PG8_BAR; }
    }
    PG8_WAIT_V(0);
    if constexpr (!ALIGN_EPI) { if (wr == 0) PG8_BAR; }
    PG8_BAR;
    if constexpr (Epi::AFTER_DRAIN) { E.fused(acc, cur, wr, wc, fr, fq, lds, wid, lane); S.done(cur); }
#undef PG8_SA
#undef PG8_SB
#undef PG8_STAGE
#undef PG8_LDA
#undef PG8_LDB
#undef PG8_MMA
#undef PG8_WAIT_V
#undef PG8_WAIT_L
#undef PG8_BAR
#undef PG8_SCHED
}
}
constexpr int NWAVES = 8;
constexpr int BATCH = 4, SEQ = 8192, DM = 1024, CTXL = 256, FF = 4096;
constexpr int ML = BATCH * SEQ;
constexpr int MC = BATCH * CTXL;
constexpr int MALL = ML + MC;
constexpr int INCOLS = 2560, RWC = 1792;
constexpr float NORM_EPS = 1e-6f, GN_EPS = 64e-5f;
#ifndef MK_N_LAUNCHES
#define MK_N_LAUNCHES 1
#endif
constexpr int N_PHASES = 19;

constexpr size_t MiB = 1u << 20;
constexpr size_t WS_MOD = 0;
constexpr size_t WS_ROPE = 256 * 1024;
constexpr size_t WS_TW = 320 * 1024;
constexpr size_t WS_DFTC = 384 * 1024;
constexpr size_t WS_W2A = 640 * 1024;
constexpr size_t WS_W2B = 704 * 1024;
constexpr size_t WS_LW2 = 768 * 1024;
constexpr size_t WS_LA2 = 896 * 1024;
constexpr size_t WS_LG2 = 1024 * 1024;
constexpr size_t WS_ZERO = 1152 * 1024;
constexpr size_t WS_INVN = 1280 * 1024;
constexpr size_t WS_BAR = 2400 * 1024;
constexpr size_t WS_WIN = 3 * MiB, WS_WOUT = 8 * MiB, WS_WF = 10 * MiB, WS_W1 = 12 * MiB  , WS_W2 = 28 * MiB  ;
constexpr size_t WS_XN = 44 * MiB;
constexpr size_t WS_QT = 44 * MiB;
constexpr size_t WS_QKV = 110 * MiB;
constexpr size_t WS_ZR = 160 * MiB;
constexpr size_t WS_MT = 160 * MiB;
constexpr size_t WS_NN = 226 * MiB;
constexpr size_t WS_LIN = 292 * MiB;
constexpr size_t WS_SS = 301 * MiB;
constexpr size_t WS_ZS = 340 * MiB;
constexpr size_t WS_ATTRW = 439 * MiB;
constexpr size_t WS_XR = 108 * MiB;
constexpr size_t WS_H = 172 * MiB;
constexpr size_t WS_G1 = 160 * MiB;
constexpr size_t WS_Y1 = 288 * MiB;
constexpr size_t WS_F1 = 416 * MiB;
constexpr size_t WS_S128 = 504 * MiB;
constexpr size_t WS_SSQ = 2432 * 1024;
constexpr size_t WS_ZERO_BYTES = (2432 + 256 - 2400) * 1024;
constexpr size_t WS_BS = 505 * MiB;
constexpr size_t WS_END = 512 * MiB;
constexpr size_t DO_Y = 0, DO_G = 64 * MiB, DO_SS = 96 * MiB;

constexpr int RING_BYTES = 131072;
constexpr int LDS_BYTES = 151552;
constexpr int MISC_OFF = 150528;

#define GAS __attribute__((address_space(1)))
#define LAS __attribute__((address_space(3)))
typedef unsigned short bf16;
typedef unsigned v4u __attribute__((ext_vector_type(4)));
typedef unsigned v2u __attribute__((ext_vector_type(2)));
typedef float f32x4 __attribute__((ext_vector_type(4)));
typedef float f32x16 __attribute__((ext_vector_type(16)));
typedef short bf16x8 __attribute__((ext_vector_type(8)));
typedef short s16x4 __attribute__((ext_vector_type(4)));
#define LDS_WAIT() asm volatile("s_waitcnt lgkmcnt(0)" ::: "memory")
typedef float f32x2p __attribute__((ext_vector_type(2))); typedef __bf16 bf16x2p __attribute__((ext_vector_type(2)));
__device__ __forceinline__ unsigned pk2(float lo, float hi) { const f32x2p v = {lo, hi}; return __builtin_bit_cast(unsigned, __builtin_convertvector(v, bf16x2p)); }
__device__ __forceinline__ unsigned f2bf(float f) { return pk2(f, 0.f) & 0xffffu; }
__device__ __forceinline__ float bf_lo(unsigned u) { return __builtin_bit_cast(float, u << 16); }
__device__ __forceinline__ float bf_hi(unsigned u) { return __builtin_bit_cast(float, u & 0xffff0000u); }
__device__ __forceinline__ float bf1(bf16 u) { return __builtin_bit_cast(float, (unsigned)u << 16); }
__device__ __forceinline__ float wave_sum(float v) {
#pragma unroll
    for (int o = 1; o < 64; o <<= 1) v += __shfl_xor(v, o);
    return v;
}
template <int CTRL> __device__ __forceinline__ float dppf(float x) { return __builtin_bit_cast(float, __builtin_amdgcn_mov_dpp(__builtin_bit_cast(int, x), CTRL, 0xf, 0xf, true)); }
__device__ __forceinline__ float sum8(float x) { x += dppf<0xB1>(x); x += dppf<0x4E>(x); x += dppf<0x141>(x); return x; }
__device__ __forceinline__ float sigmoidf_(float x) { return __builtin_amdgcn_rcpf(1.f + __expf(-x)); }

typedef GAS unsigned gu32;
typedef GAS unsigned long long gu64;
#define RLX_AGENT __ATOMIC_RELAXED, __HIP_MEMORY_SCOPE_AGENT
#define XB_TMO      128
#define XB_XCNT(j)  (256  + 64 * (j))
#define XB_XSUB(j)  (1280 + 64 * (j))
#define XB_XGEN(j)  (2304 + 64 * (j))
#define XB_TOP      3328
#define XB_TOPGEN   3392
#define XCD_BAR_WORDS 3456
#define XB_SPIN_CAP (1u << 18)

__device__ __forceinline__ unsigned xb_ld(unsigned* p)              { return __hip_atomic_load(p, __ATOMIC_RELAXED, __HIP_MEMORY_SCOPE_AGENT); }
__device__ __forceinline__ unsigned xb_add(unsigned* p, unsigned v) { return __hip_atomic_fetch_add(p, v, __ATOMIC_RELAXED, __HIP_MEMORY_SCOPE_AGENT); }
__device__ __forceinline__ unsigned xb_xcc_id() { return (unsigned)__builtin_amdgcn_s_getreg((3 << 11) | 20) & 0xFu; }
#define XB_SPIN(cond, bar) do { unsigned _sp = 0; while (cond) { __builtin_amdgcn_s_sleep(1); \
    if ((++_sp & 255u) == 0u) { if (xb_ld(&(bar)[XB_TMO])) break; if (_sp > XB_SPIN_CAP) { atomicAdd(&(bar)[XB_TMO], 1u); break; } } } } while (0)

struct XcdBarrier {
    unsigned* bar; unsigned x;
    volatile LAS unsigned* st;
};

__device__ __forceinline__ XcdBarrier xcd_barrier_post(unsigned* bar, volatile LAS unsigned* st) {
    XcdBarrier b; b.bar = bar; b.x = xb_xcc_id(); b.st = st;
    if (threadIdx.x == 0) (void)xb_add(&bar[XB_XCNT(b.x)], 1u);
    return b;
}
__device__ __forceinline__ void xcd_barrier_complete(unsigned* bar, unsigned x, unsigned& nloc, unsigned& nx) {
    const unsigned G = gridDim.x * gridDim.y * gridDim.z;
    unsigned sum, cnt, mine, sp = 0u;
    for (;;) {
        sum = 0u; cnt = 0u; mine = 0u;
#pragma unroll
        for (unsigned j = 0; j < 16; ++j) { const unsigned c = xb_ld(&bar[XB_XCNT(j)]); sum += c; cnt += (c > 0u) ? 1u : 0u; mine = (j == x) ? c : mine; }
        if (sum == G) break;
        __builtin_amdgcn_s_sleep(1);
        if ((++sp & 255u) == 0u) { if (xb_ld(&bar[XB_TMO])) break; if (sp > XB_SPIN_CAP) { atomicAdd(&bar[XB_TMO], 1u); break; } }
    }
    nloc = mine > 0u ? mine : 1u; nx = cnt > 0u ? cnt : 1u;
}

__device__ __forceinline__ void xcd_barrier(const XcdBarrier& b) {
    asm volatile("s_waitcnt vmcnt(0)" ::: "memory");
    __syncthreads();
    if (threadIdx.x == 0) {
        unsigned* bar = b.bar;
        __builtin_amdgcn_s_waitcnt(0);
        unsigned nloc = b.st[0], nx = b.st[1];
        if (nloc == 0u) { xcd_barrier_complete(bar, b.x, nloc, nx); b.st[0] = nloc; b.st[1] = nx; }
        const unsigned old = xb_add(&bar[XB_XSUB(b.x)], 1u);
        const unsigned gen = old / nloc;
        if (old + 1u == (gen + 1u) * nloc) {
            __builtin_amdgcn_fence(__ATOMIC_RELEASE, "agent");
            asm volatile("s_waitcnt vmcnt(0)" ::: "memory");
            const unsigned og = xb_add(&bar[XB_TOP], 1u);
            const unsigned tg = og / nx;
            if (og + 1u == (tg + 1u) * nx) xb_add(&bar[XB_TOPGEN], 1u);
            else XB_SPIN(xb_ld(&bar[XB_TOPGEN]) == tg, bar);
            __builtin_amdgcn_fence(__ATOMIC_ACQUIRE, "agent");
            xb_add(&bar[XB_XGEN(b.x)], 1u);
            asm volatile("s_waitcnt vmcnt(0)" ::: "memory");
        } else {
            XB_SPIN(xb_ld(&bar[XB_XGEN(b.x)]) == gen, bar);
            __builtin_amdgcn_fence(__ATOMIC_ACQUIRE, "agent");
            asm volatile("s_waitcnt vmcnt(0)" ::: "memory");
        }
    }
    __syncthreads();
}

struct Frame {
    LAS unsigned char* lds;
    int tid, lane, wave, vcu, G;
    unsigned char* ws; float* out;
};
struct Args { const float* in[27]; float* out; unsigned char* ws; int ph_lo, ph_hi; };
enum { I_X = 0, I_C, I_CTX, I_CCTX, I_ADAW, I_ADAB, I_N1G, I_N2G, I_WIN, I_WOUT, I_SINK, I_MUP, I_MUN, I_DW0, I_DW2, I_IA0, I_IA2, I_GG2, I_KK, I_KA, I_RK, I_LNG, I_LNB, I_FW, I_W1, I_W2, I_FING };

__device__ __forceinline__ void p0_transpose_item(const float* W, int K, int N, bf16* WT, LAS float* scr, int item, int lane, float scale) {
    const int nblk = N / 32, kb = item / nblk, nb = item % nblk, k0 = 64 * kb, n0 = 32 * nb;
    f32x4 v[8]; const int c4 = lane & 7, kr = lane >> 3;
#pragma unroll
    for (int i = 0; i < 8; ++i) v[i] = __builtin_nontemporal_load((const f32x4*)(W + (size_t)(k0 + 8 * i + kr) * N + n0 + 4 * c4));
#pragma unroll
    for (int i = 0; i < 8; ++i) { LAS float* d = scr + (8 * i + kr) * 33 + 4 * c4; d[0] = v[i].x * scale; d[1] = v[i].y * scale; d[2] = v[i].z * scale; d[3] = v[i].w * scale; }
    LDS_WAIT(); asm volatile("" ::: "memory");
    const int c = lane & 7;
#pragma unroll
    for (int j = 0; j < 4; ++j) { const int n = (lane >> 3) + 8 * j; const LAS float* s = scr + (8 * c) * 33 + n;
        v4u o; o.x = pk2(s[0 * 33], s[1 * 33]); o.y = pk2(s[2 * 33], s[3 * 33]); o.z = pk2(s[4 * 33], s[5 * 33]); o.w = pk2(s[6 * 33], s[7 * 33]);
        *(GAS v4u*)(WT + (size_t)(n0 + n) * K + k0 + 8 * c) = o; }
    LDS_WAIT(); asm volatile("" ::: "memory");
}
__device__ __forceinline__ void p0_prologue(Frame& F, const Args& A_) {
    LAS float* scr = (LAS float*)(F.lds + F.wave * 16384);
    const int gw = F.vcu * NWAVES + F.wave, NGW = F.G * NWAVES;
    constexpr int I_IN = 16 * 80, I_O = 16 * 32, I_U = 16 * 128, I_D = 64 * 32;
    constexpr int I_LW = 2 * 16, I_LG = 2 * 16;
    constexpr int NITEMS = I_IN + 2 * I_O + 2 * I_U + 2 * I_D + 2 * I_LW + I_LG;
    for (int it = gw; it < NITEMS; it += NGW) {
        int r = it;
        if (r < I_IN) { p0_transpose_item(A_.in[I_WIN], 1024, INCOLS, (bf16*)(F.ws + WS_WIN), scr, r, F.lane, 1.f); continue; } r -= I_IN;
        if (r < I_O) { p0_transpose_item(A_.in[I_WOUT], 1024, 1024, (bf16*)(F.ws + WS_WOUT), scr, r, F.lane, 1.f); continue; } r -= I_O;
        if (r < I_O) { p0_transpose_item(A_.in[I_FW], 1024, 1024, (bf16*)(F.ws + WS_WF), scr, r, F.lane, 1.f); continue; } r -= I_O;
        if (r < 2 * I_U) { const int l = r / I_U; p0_transpose_item(A_.in[I_W1] + (size_t)l * 1024 * FF, 1024, FF, (bf16*)(F.ws + WS_W1) + (size_t)l * 1024 * FF, scr, r % I_U, F.lane, 1.f); continue; } r -= 2 * I_U;
        if (r < 2 * I_D) { const int l = r / I_D; p0_transpose_item(A_.in[I_W2] + (size_t)l * 1024 * FF, FF, 1024, (bf16*)(F.ws + WS_W2) + (size_t)l * 1024 * FF, scr, r % I_D, F.lane, 1.f); continue; } r -= 2 * I_D;
        if (r < I_LW) { const int d = r / 16; p0_transpose_item(A_.in[I_DW2] + (size_t)d * 64 * 512, 64, 512, (bf16*)(F.ws + WS_LW2) + (size_t)d * 512 * 64, scr, r % 16, F.lane, 1.f); continue; } r -= I_LW;
        if (r < I_LW) { const int d = r / 16; p0_transpose_item(A_.in[I_IA2] + (size_t)d * 64 * 512, 64, 512, (bf16*)(F.ws + WS_LA2) + (size_t)d * 512 * 64, scr, r % 16, F.lane, 1.f); continue; } r -= I_LW;
        p0_transpose_item(A_.in[I_GG2], 128, 512, (bf16*)(F.ws + WS_LG2), scr, r, F.lane, 1.f);
    }
    const int gt = F.vcu * 512 + F.tid, NGT = F.G * 512;
    const float TWO_PI = 6.283185307179586f;
    for (int i = gt; i < 128 * 16; i += NGT) {
        const int pos = i >> 4, j = i & 15; const float inv = exp2f(-(float)j * (13.287712379549449f / 16.f));
        const float ang = (float)pos * inv; const float rev = ang * 0.15915494309189535f;
        float* o = (float*)(F.ws + WS_ROPE) + 2 * i; o[0] = __builtin_amdgcn_cosf(rev - floorf(rev)); o[1] = __builtin_amdgcn_sinf(rev - floorf(rev));
    }
    for (int i = gt; i < 8192; i += NGT) { const float rev = (float)i * (1.f / 8192.f); float* o = (float*)(F.ws + WS_TW) + 2 * i; o[0] = __builtin_amdgcn_cosf(rev); o[1] = __builtin_amdgcn_sinf(rev); }
    for (int i = gt; i < 512 * 256; i += NGT) {
        const int j = i >> 8, c = i & 255; const int ph = (c * (j & 255)) & 255; const float rev = (float)ph * (1.f / 256.f);
        const float v = (j < 256) ? __builtin_amdgcn_cosf(rev) : -__builtin_amdgcn_sinf(rev);
        ((bf16*)(F.ws + WS_DFTC))[i] = (bf16)f2bf(v * 0.0625f);
    }
    for (int i = gt; i < 128 * 128; i += NGT) {
        const int o = i >> 7, k = i & 127; const int pp = o >> 6, l1p = o & 63, p = k >> 6, l1 = k & 63; const float rev = (float)((l1 * l1p) & 63) * (1.f / 64.f);
        const float cs = __builtin_amdgcn_cosf(rev), sn = __builtin_amdgcn_sinf(rev);
        const float v = (pp == 0) ? (p == 0 ? cs : sn) : (p == 0 ? -sn : cs);
        ((bf16*)(F.ws + WS_W2A))[i] = (bf16)f2bf(v * 0.125f);
    }
    for (int i = gt; i < 128 * 256; i += NGT) {
        const int o = i >> 8, k = i & 255; const int p = k >> 7, l2 = k & 127; const float rev = (float)((l2 * o) & 127) * (1.f / 128.f);
        const float v = (p == 0) ? __builtin_amdgcn_cosf(rev) : __builtin_amdgcn_sinf(rev);
        ((bf16*)(F.ws + WS_W2B))[i] = (bf16)f2bf(v * 0.08838834764831845f);
    }
    for (int i = gt; i < 1024; i += NGT) ((float*)(F.ws + WS_ZERO))[i] = 0.f;
    {
        LAS float* sl = (LAS float*)(F.lds + 0);
        __syncthreads();
        for (int i = F.tid; i < 5 * 1024; i += 512) { const int r = i >> 10, k = i & 1023; const float cv = (r < 4) ? A_.in[I_C][r * 1024 + k] : A_.in[I_CCTX][k]; sl[i] = cv * sigmoidf_(cv); }
        __syncthreads();
        LAS float* red = (LAS float*)(F.lds + 32768);
        for (int item = F.vcu; item < 2 * 96; item += F.G) {
            const int layer = item / 96, n0 = (item % 96) * 64;
            const float* W = A_.in[I_ADAW] + (size_t)layer * 1024 * 6144 + n0 + F.lane;
            float a0 = 0.f, a1 = 0.f, a2 = 0.f, a3 = 0.f, a4 = 0.f;
            const int k0 = F.wave * 128;
#pragma unroll 32
            for (int k = k0; k < k0 + 128; ++k) { const float w = __builtin_nontemporal_load(W + (size_t)k * 6144); a0 += sl[k] * w; a1 += sl[1024 + k] * w; a2 += sl[2048 + k] * w; a3 += sl[3072 + k] * w; a4 += sl[4096 + k] * w; }
            red[(F.wave * 5 + 0) * 64 + F.lane] = a0; red[(F.wave * 5 + 1) * 64 + F.lane] = a1; red[(F.wave * 5 + 2) * 64 + F.lane] = a2; red[(F.wave * 5 + 3) * 64 + F.lane] = a3; red[(F.wave * 5 + 4) * 64 + F.lane] = a4;
            __syncthreads();
            if (F.tid < 320) { const int r = F.tid >> 6, l = F.tid & 63; float s = 0.f;
#pragma unroll
                for (int w = 0; w < 8; ++w) s += red[(w * 5 + r) * 64 + l];
                ((float*)(F.ws + WS_MOD))[(size_t)(layer * 5 + r) * 6144 + n0 + l] = s + A_.in[I_ADAB][layer * 6144 + n0 + l]; }
            __syncthreads();
        }
    }
}

__device__ __forceinline__ void norm_phase(Frame& F, const float* xl, const float* xc, int nrows, const float* g, const float* modl  , int sh_off, bf16* dst) {
    const int gw = F.vcu * NWAVES + F.wave, NGW = F.G * NWAVES;
    f32x4 gg[4];
#pragma unroll
    for (int j = 0; j < 4; ++j) gg[j] = *(const f32x4*)(g + 4 * F.lane + 256 * j);
    for (int m0 = gw; m0 < nrows; m0 += 2 * NGW) {
        const int m1 = m0 + NGW; const bool two = m1 < nrows; const int m1c = two ? m1 : m0;
        const float* xrow0 = (m0 < ML) ? xl + (size_t)m0 * DM : xc + (size_t)(m0 - ML) * DM;
        const float* xrow1 = (m1c < ML) ? xl + (size_t)m1c * DM : xc + (size_t)(m1c - ML) * DM;
        const GAS f32x4* xr0 = (const GAS f32x4*)xrow0 + F.lane; const GAS f32x4* xr1 = (const GAS f32x4*)xrow1 + F.lane;
        f32x4 v0[4], v1[4]; float s0 = 0.f, s1 = 0.f;
#pragma unroll
        for (int j = 0; j < 4; ++j) { v0[j] = __builtin_nontemporal_load(xr0 + 64 * j); v1[j] = __builtin_nontemporal_load(xr1 + 64 * j); }
#pragma unroll
        for (int j = 0; j < 4; ++j) { s0 += (v0[j].x * v0[j].x + v0[j].y * v0[j].y) + (v0[j].z * v0[j].z + v0[j].w * v0[j].w); s1 += (v1[j].x * v1[j].x + v1[j].y * v1[j].y) + (v1[j].z * v1[j].z + v1[j].w * v1[j].w); }
        const float rstd0 = 1.f / sqrtf(wave_sum(s0) * (1.f / DM) + NORM_EPS), rstd1 = 1.f / sqrtf(wave_sum(s1) * (1.f / DM) + NORM_EPS);
#pragma unroll
        for (int rr = 0; rr < 2; ++rr) {
            if (rr == 1 && !two) break;
            const int m = rr ? m1 : m0; const int r = (m < ML) ? (m >> 13) : 4; const float rstd = rr ? rstd1 : rstd0;
            const float* sh = modl + (size_t)r * 6144 + sh_off; const float* sc = sh + 1024;
            GAS unsigned long long* o8 = (GAS unsigned long long*)(dst + (size_t)m * DM) + F.lane;
#pragma unroll
            for (int j = 0; j < 4; ++j) { const int c = 4 * F.lane + 256 * j;
                const f32x4 a = *(const f32x4*)(sc + c), b = *(const f32x4*)(sh + c);
                const f32x4 o = ((rr ? v1[j] : v0[j]) * rstd * gg[j]) * (a + 1.f) + b;
                o8[64 * j] = (unsigned long long)pk2(o.x, o.y) | ((unsigned long long)pk2(o.z, o.w) << 32); }
        }
    }
}
template <bool FINAL> __device__ __forceinline__ void norm_rows_bf16(Frame& F, const bf16* xr, const float* g, const float* modl, int sh_off, bf16* dst, float* dstf) {
    const int gw = F.vcu * NWAVES + F.wave, NGW = F.G * NWAVES; const int c0 = 8 * F.lane;
    f32x4 gg[2][2];
#pragma unroll
    for (int j = 0; j < 2; ++j) { gg[j][0] = *(const f32x4*)(g + c0 + 512 * j); gg[j][1] = *(const f32x4*)(g + c0 + 512 * j + 4); }
    for (int ch = gw; ch < ML / 16; ch += NGW) {
        const int m0 = 16 * ch;
        f32x4 ca[2][2], cb[2][2];
#pragma unroll
        for (int j = 0; j < 2; ++j)
#pragma unroll
            for (int e = 0; e < 2; ++e) {
                if (FINAL) { ca[j][e] = gg[j][e]; cb[j][e] = (f32x4){0.f, 0.f, 0.f, 0.f}; }
                else { const float* sh = modl + (size_t)(m0 >> 13) * 6144 + sh_off + c0 + 512 * j + 4 * e; ca[j][e] = gg[j][e] * (*(const f32x4*)(sh + 1024) + 1.f); cb[j][e] = *(const f32x4*)sh; } }
        v4u qa[4][2], qb[4][2];
        const bf16* p = xr + (size_t)m0 * DM + c0; size_t ro = (size_t)m0 * DM + c0;
#define NR_LOAD(q_, p_) do { _Pragma("unroll") for (int i = 0; i < 4; ++i) { q_[i][0] = __builtin_nontemporal_load((const v4u*)((p_) + i * DM)); q_[i][1] = __builtin_nontemporal_load((const v4u*)((p_) + i * DM + 512)); } } while (0)
#define NR_PROC(q_, ro_) do { float s[4]; \
            _Pragma("unroll") for (int i = 0; i < 4; ++i) { s[i] = 0.f; \
                _Pragma("unroll") for (int j = 0; j < 2; ++j) \
                    _Pragma("unroll") for (int e = 0; e < 4; ++e) { const unsigned w = q_[i][j][e]; const float lo = bf_lo(w), hi = bf_hi(w); s[i] += lo * lo + hi * hi; } } \
            _Pragma("unroll") for (int i = 0; i < 4; ++i) s[i] = wave_sum(s[i]); \
            _Pragma("unroll") for (int i = 0; i < 4; ++i) { \
                const float rstd = 1.f / sqrtf(s[i] * (1.f / DM) + NORM_EPS); \
                _Pragma("unroll") for (int j = 0; j < 2; ++j) { \
                    const v4u w_ = q_[i][j]; \
                    const f32x4 x0 = {bf_lo(w_.x), bf_hi(w_.x), bf_lo(w_.y), bf_hi(w_.y)}, x1 = {bf_lo(w_.z), bf_hi(w_.z), bf_lo(w_.w), bf_hi(w_.w)}; \
                    const f32x4 o0 = (x0 * rstd) * ca[j][0] + cb[j][0], o1 = (x1 * rstd) * ca[j][1] + cb[j][1]; \
                    if (FINAL) { *(f32x4*)(dstf + (ro_) + i * DM + 512 * j) = o0; *(f32x4*)(dstf + (ro_) + i * DM + 512 * j + 4) = o1; } \
                    else { v4u w; w.x = pk2(o0.x, o0.y); w.y = pk2(o0.z, o0.w); w.z = pk2(o1.x, o1.y); w.w = pk2(o1.z, o1.w); *(v4u*)(dst + (ro_) + i * DM + 512 * j) = w; } } } } while (0)
        NR_LOAD(qa, p);
#pragma unroll 1
        for (int it = 0; it < 2; ++it) {
            NR_LOAD(qb, p + 4 * DM);
            NR_PROC(qa, ro);
            if (it == 0) NR_LOAD(qa, p + 8 * DM);
            NR_PROC(qb, ro + 4 * DM);
            p += 8 * DM; ro += 8 * DM;
        }
#undef NR_LOAD
#undef NR_PROC
    }
}
__device__ __forceinline__ void norm_bf16_phase(Frame& F, const bf16* xr, const float* g, const float* modl, int sh_off, bf16* dst) { norm_rows_bf16<false>(F, xr, g, modl, sh_off, dst, nullptr); }
__device__ __forceinline__ void final_norm_bf16_phase(Frame& F, const bf16* xr, float* out, const float* g) { norm_rows_bf16<true>(F, xr, g, nullptr, 0, nullptr, out); }
__device__ __forceinline__ void final_norm_phase(Frame& F, float* x, const float* g) {
    const int gw = F.vcu * NWAVES + F.wave, NGW = F.G * NWAVES;
    for (int m = gw; m < ML; m += NGW) {
        GAS f32x4* xr = (GAS f32x4*)(x + (size_t)m * DM) + F.lane;
        f32x4 v[4]; float s = 0.f;
#pragma unroll
        for (int j = 0; j < 4; ++j) { v[j] = xr[64 * j]; s += (v[j].x * v[j].x + v[j].y * v[j].y) + (v[j].z * v[j].z + v[j].w * v[j].w); }
        const float rstd = 1.f / sqrtf(wave_sum(s) * (1.f / DM) + NORM_EPS);
#pragma unroll
        for (int j = 0; j < 4; ++j) { const f32x4 gg = *(const f32x4*)(g + 4 * F.lane + 256 * j); xr[64 * j] = v[j] * rstd * gg; }
    }
}
__device__ __forceinline__ f32x16 mfma32(bf16x8 a, bf16x8 b, f32x16 c) { return __builtin_amdgcn_mfma_f32_32x32x16_bf16(a, b, c, 0, 0, 0); }
__device__ __forceinline__ s16x4 tr_read(const LAS unsigned char* p) { return __builtin_bit_cast(s16x4, __builtin_amdgcn_ds_read_tr16_b64_v4i16((LAS s16x4*)p)); }
__device__ __forceinline__ bf16x8 cat4(s16x4 lo, s16x4 hi) { return (bf16x8){lo[0], lo[1], lo[2], lo[3], hi[0], hi[1], hi[2], hi[3]}; }
typedef float f32x2c __attribute__((ext_vector_type(2))); typedef __bf16 bf16x2c __attribute__((ext_vector_type(2)));
__device__ __forceinline__ unsigned cvtpk(float lo, float hi) { const f32x2c v = {lo, hi}; const bf16x2c b = __builtin_convertvector(v, bf16x2c); return __builtin_bit_cast(unsigned, b); }
__device__ __forceinline__ float swap32(float x) { auto rr = __builtin_amdgcn_permlane32_swap(__float_as_uint(x), __float_as_uint(x), false, false); return __uint_as_float((threadIdx.x & 32) ? rr[0] : rr[1]); }
__device__ __forceinline__ v4u widen2(v2u a, v2u b) { auto r0 = __builtin_amdgcn_permlane32_swap(a.x, b.x, false, false); auto r1 = __builtin_amdgcn_permlane32_swap(a.y, b.y, false, false); return (v4u){r0[0], r1[0], r0[1], r1[1]}; }
__device__ __forceinline__ void store_rows16(bf16* base, v2u g0, v2u g1, v2u g2, v2u g3, int hi) {
    const v4u w0 = widen2(g0, g1), w1 = widen2(g2, g3);
    *(v4u*)(base + (hi ? 8 : 0)) = w0; *(v4u*)(base + 16 + (hi ? 8 : 0)) = w1;
}
__device__ __forceinline__ v2u pk4(float a, float b, float c, float d) { v2u w; w.x = cvtpk(a, b); w.y = cvtpk(c, d); return w; }
__device__ __forceinline__ bf16x8 pack8(const f32x16& p, int b) {
    v4u w; w.x = cvtpk(p[b + 0], p[b + 1]); w.y = cvtpk(p[b + 2], p[b + 3]); w.z = cvtpk(p[b + 4], p[b + 5]); w.w = cvtpk(p[b + 6], p[b + 7]);
    return __builtin_bit_cast(bf16x8, w);
}
constexpr int KP = 144;
__device__ __forceinline__ void attn_phase(Frame& F, const Args& A_, int ufirst, int ustride, int uend = 1024) {
    const bf16* QKV = (const bf16*)(F.ws + WS_QKV); bf16* O = (bf16*)(F.ws + WS_ATTRW);
    const int lane = F.lane, r32 = lane & 31, hi = lane >> 5;
    const int g = F.wave & 3, half = F.wave >> 2;
    const int skey = F.tid >> 3, sch = F.tid & 7;
    for (int unit = ufirst; unit < uend; unit += ustride) {
        const int b = unit >> 8, kvh = (unit >> 7) & 1, qb = unit & 127, s0 = qb * 64;
        const int head = kvh * 4 + g; const int tq = s0 + half * 32 + r32;
        const int lo = 4 + (qb < 2 ? 2 - qb : 0), hiT = 8 - (qb > 125 ? qb - 125 : 0);
        const bf16* qrow = QKV + (size_t)(b * SEQ + tq) * 768 + head * 64;
        bf16x8 qf[4];
#pragma unroll
        for (int s = 0; s < 4; ++s) qf[s] = *(const bf16x8*)(qrow + 16 * s + 8 * hi);
        float m = A_.in[I_SINK][head] * 1.4426950408889634f, l = (hi == 0) ? 1.f : 0.f;
        f32x16 o0 = {}, o1 = {};
        const bf16* kvbase = QKV + 512 + kvh * 64 + sch * 8;
#define KROW0(t) (((t) < 4) ? (ML + b * CTXL + (t) * 64) : (b * SEQ + s0 - 128 + ((t) - 4) * 64))
        v4u pk_, pv_;
        { const bf16* kp = kvbase + (size_t)(KROW0(0) + skey) * 768; pk_ = *(const v4u*)kp; pv_ = *(const v4u*)(kp + 128); }
        __syncthreads();
        *(LAS v4u*)(F.lds + skey * KP + sch * 16) = pk_; *(LAS v4u*)(F.lds + 64 * KP + skey * KP + sch * 16) = pv_;
        __syncthreads();
        asm volatile("" :: "v"(qf[0]), "v"(qf[1]), "v"(qf[2]), "v"(qf[3]), "v"(m));
        int buf = 0;
        for (int tile = 0;;) {
            const int nxt = (tile == 3) ? lo : tile + 1; const bool more = tile != hiT;
            if (more) { const bf16* kp = kvbase + (size_t)(KROW0(nxt) + skey) * 768; pk_ = *(const v4u*)kp; pv_ = *(const v4u*)(kp + 128); }
            const LAS unsigned char* Ks = F.lds + buf * (128 * KP); const LAS unsigned char* Vs = Ks + 64 * KP;
            f32x16 p0, p1;
#pragma unroll
            for (int r = 0; r < 16; ++r) { p0[r] = -m; p1[r] = -m; }
            __builtin_amdgcn_s_setprio(1);
#pragma unroll
            for (int s = 0; s < 4; ++s) {
                const bf16x8 a0 = *(const LAS bf16x8*)(Ks + r32 * KP + (16 * s + 8 * hi) * 2);
                const bf16x8 a1 = *(const LAS bf16x8*)(Ks + (32 + r32) * KP + (16 * s + 8 * hi) * 2);
                p0 = mfma32(a0, qf[s], p0); p1 = mfma32(a1, qf[s], p1);
            }
            __builtin_amdgcn_s_setprio(0);
            if (tile == 4 || tile == 8) {
                const int ks = s0 - 128 + (tile - 4) * 64;
#pragma unroll
                for (int r = 0; r < 16; ++r) { const int key = (r & 3) + 8 * (r >> 2) + 4 * hi; const int d0 = tq - (ks + key), d1 = d0 - 32;
                    if (d0 > 128 || d0 < -128) p0[r] = -INFINITY; if (d1 > 128 || d1 < -128) p1[r] = -INFINITY; }
            }
            float mx = fmaxf(p0[0], p1[0]);
#pragma unroll
            for (int r = 1; r < 16; ++r) mx = fmaxf(mx, fmaxf(p0[r], p1[r]));
            { auto rr = __builtin_amdgcn_permlane32_swap(__float_as_uint(mx), __float_as_uint(mx), false, false); mx = fmaxf(__uint_as_float(rr[0]), __uint_as_float(rr[1])); }
            if (__any(mx > 8.f)) {
                const float d = fmaxf(mx, 0.f), alpha = __builtin_amdgcn_exp2f(-d); m += d; l *= alpha;
#pragma unroll
                for (int r = 0; r < 16; ++r) { p0[r] -= d; p1[r] -= d; o0[r] *= alpha; o1[r] *= alpha; }
            }
            float ls = 0.f;
#pragma unroll
            for (int r = 0; r < 16; ++r) { p0[r] = __builtin_amdgcn_exp2f(p0[r]); p1[r] = __builtin_amdgcn_exp2f(p1[r]); ls += p0[r] + p1[r]; }
            l += ls;
            const bf16x8 pb0 = pack8(p0, 0), pb1 = pack8(p0, 8), pb2 = pack8(p1, 0), pb3 = pack8(p1, 8);
            const int i16 = lane & 15, qd = i16 >> 2, pp = i16 & 3, c0 = lane & 16;
            const LAS unsigned char* vb = Vs + (4 * hi + qd) * KP + (c0 + 4 * pp) * 2;
#define PVSTEP(s, pb) do { \
                const bf16x8 va0 = cat4(tr_read(vb + (16 * (s)) * KP), tr_read(vb + (16 * (s) + 8) * KP)); \
                const bf16x8 va1 = cat4(tr_read(vb + (16 * (s)) * KP + 64), tr_read(vb + (16 * (s) + 8) * KP + 64)); \
                o0 = mfma32(va0, pb, o0); o1 = mfma32(va1, pb, o1); } while (0)
            __builtin_amdgcn_s_setprio(1);
            PVSTEP(0, pb0); PVSTEP(1, pb1); PVSTEP(2, pb2); PVSTEP(3, pb3);
            __builtin_amdgcn_s_setprio(0);
#undef PVSTEP
            if (!more) break;
            buf ^= 1;
            *(LAS v4u*)(F.lds + buf * (128 * KP) + skey * KP + sch * 16) = pk_; *(LAS v4u*)(F.lds + buf * (128 * KP) + 64 * KP + skey * KP + sch * 16) = pv_;
            __syncthreads();
            tile = nxt;
        }
#undef KROW0
        { auto rr = __builtin_amdgcn_permlane32_swap(__float_as_uint(l), __float_as_uint(l), false, false); l = __uint_as_float(rr[0]) + __uint_as_float(rr[1]); }
        const float inv = __builtin_amdgcn_rcpf(l);
        bf16* orow = O + (size_t)(b * SEQ + tq) * 1024 + head * 64;
        store_rows16(orow, pk4(o0[0] * inv, o0[1] * inv, o0[2] * inv, o0[3] * inv), pk4(o0[4] * inv, o0[5] * inv, o0[6] * inv, o0[7] * inv), pk4(o0[8] * inv, o0[9] * inv, o0[10] * inv, o0[11] * inv), pk4(o0[12] * inv, o0[13] * inv, o0[14] * inv, o0[15] * inv), hi);
        store_rows16(orow + 32, pk4(o1[0] * inv, o1[1] * inv, o1[2] * inv, o1[3] * inv), pk4(o1[4] * inv, o1[5] * inv, o1[6] * inv, o1[7] * inv), pk4(o1[8] * inv, o1[9] * inv, o1[10] * inv, o1[11] * inv), pk4(o1[12] * inv, o1[13] * inv, o1[14] * inv, o1[15] * inv), hi);
    }
}

constexpr int AP3 = 272;
__device__ __forceinline__ void rwkv_prep_phase(Frame& F, const Args& A_) {
    const bf16* ZR = (const bf16*)(F.ws + WS_ZR); bf16* ZS = (bf16*)(F.ws + WS_ZS); float* INVN = (float*)(F.ws + WS_INVN);
    bf16* LIN = (bf16*)(F.ws + WS_LIN); bf16* SGL = (bf16*)((unsigned char*)F.out + DO_G);
    const float* mup = A_.in[I_MUP]; const float* mun = A_.in[I_MUN]; const float* kkw = A_.in[I_KK];
    const int lane = F.lane, r32 = lane & 31, hi = lane >> 5;
    const int pch = F.tid & 255, pth = F.tid >> 8, pcol = pch * 8; const bool pact = pch < 224;
    f32x4 mp0 = {}, mp1 = {}, mn0 = {}, mn1 = {}, kc0 = {}, kc1 = {};
    if (pact) { mp0 = *(const f32x4*)(mup + pcol); mp1 = *(const f32x4*)(mup + pcol + 4); mn0 = *(const f32x4*)(mun + pcol); mn1 = *(const f32x4*)(mun + pcol + 4); }
    if (pch >= 64 && pch < 128) { kc0 = *(const f32x4*)(kkw + pcol - 512); kc1 = *(const f32x4*)(kkw + pcol - 508); }
    asm volatile("" :: "v"(mp0), "v"(mp1), "v"(mn0), "v"(mn1), "v"(kc0), "v"(kc1));
    auto prep_token = [&](const v4u zp, const v4u zc, const v4u zn, const int tk, const int row) __attribute__((always_inline)) {
        const int ch = pch, col = pcol;
                float z[8];
#pragma unroll
                for (int e = 0; e < 4; ++e) {
                    const float c0 = bf_lo(zc[e]), c1 = bf_hi(zc[e]), p0 = bf_lo(zp[e]), p1 = bf_hi(zp[e]), n0 = bf_lo(zn[e]), n1 = bf_hi(zn[e]);
                    const float a0 = (2 * e < 4) ? mp0[2 * e] : mp1[2 * e - 4], a1 = (2 * e + 1 < 4) ? mp0[2 * e + 1] : mp1[2 * e - 3];
                    const float b0 = (2 * e < 4) ? mn0[2 * e] : mn1[2 * e - 4], b1 = (2 * e + 1 < 4) ? mn0[2 * e + 1] : mn1[2 * e - 3];
                    z[2 * e] = c0 + a0 * (p0 - c0) + b0 * (n0 - c0); z[2 * e + 1] = c1 + a1 * (p1 - c1) + b1 * (n1 - c1);
                }
                if (ch < 192) {
                    v4u w; w.x = pk2(z[0], z[1]); w.y = pk2(z[2], z[3]); w.z = pk2(z[4], z[5]); w.w = pk2(z[6], z[7]);
                    *(v4u*)(ZS + (size_t)row * 1536 + col) = w;
                }
                {
                    float ss = 0.f;
#pragma unroll
                    for (int e = 0; e < 4; ++e) { const float a = z[e] * kc0[e], b = z[4 + e] * kc1[e]; ss += a * a + b * b; }
                    ss = sum8(ss);
                    if (ch >= 64 && ch < 128 && (ch & 7) == 0) INVN[(size_t)row * 8 + ((ch - 64) >> 3)] = 1.f / sqrtf(ss + 1e-12f);
                }
                if (ch >= 192 && pact) {
                    v4u w;
                    if (ch < 200) {
                        float t[8];
#pragma unroll
                        for (int e = 0; e < 8; ++e) { const float ex = __expf(-2.f * fabsf(z[e])); const float th = (1.f - ex) * __builtin_amdgcn_rcpf(1.f + ex); t[e] = z[e] < 0.f ? -th : th; }
                        w.x = pk2(t[0], t[1]); w.y = pk2(t[2], t[3]); w.z = pk2(t[4], t[5]); w.w = pk2(t[6], t[7]);
                        *(v4u*)(LIN + (size_t)row * 128 + (ch - 192) * 8) = w;
                    } else if (ch < 208) {
                        w.x = pk2(z[0], z[1]); w.y = pk2(z[2], z[3]); w.z = pk2(z[4], z[5]); w.w = pk2(z[6], z[7]);
                        *(v4u*)(LIN + (size_t)row * 128 + 64 + (ch - 200) * 8) = w;
                    } else {
                        float t[8];
#pragma unroll
                        for (int e = 0; e < 8; ++e) t[e] = __builtin_amdgcn_rcpf(1.f + __expf(-z[e]));
                        w.x = pk2(t[0], t[1]); w.y = pk2(t[2], t[3]); w.z = pk2(t[4], t[5]); w.w = pk2(t[6], t[7]);
                        if (row < ML) *(v4u*)(SGL + ((size_t)((row >> 5) * 8 + ((ch - 208) >> 1)) * 64 + (((ch - 208) & 1) * 32 + (row & 31))) * 8) = w;
                    }
                }
    };
    for (int unit = F.vcu; unit < ML / 32; unit += F.G) {
        const int R0 = unit * 32;
        const int Rt = R0 + 16 * pth;
        const int pos0 = Rt & (SEQ - 1);
        v4u zz[18];
#pragma unroll
        for (int i = 0; i < 18; ++i) { const int p = pos0 + i - 1; zz[i] = (v4u){0u, 0u, 0u, 0u}; if (pact && p >= 0 && p < SEQ) zz[i] = __builtin_nontemporal_load((const v4u*)(ZR + (size_t)(Rt + i - 1) * RWC + pcol)); }
#pragma unroll
        for (int i = 0; i < 16; ++i) prep_token(zz[i], zz[i + 1], zz[i + 2], 16 * pth + i, Rt + i);
    }
    for (int su = F.vcu; su < MC / 4; su += F.G) {
        const int Rt = ML + 4 * su + 2 * pth; const int pos0 = (Rt - ML) & (CTXL - 1);
        v4u zc4[4];
#pragma unroll
        for (int i = 0; i < 4; ++i) { const int p = pos0 + i - 1; zc4[i] = (v4u){0u, 0u, 0u, 0u}; if (pact && p >= 0 && p < CTXL) zc4[i] = __builtin_nontemporal_load((const v4u*)(ZR + (size_t)(Rt + i - 1) * RWC + pcol)); }
#pragma unroll
        for (int i = 0; i < 2; ++i) prep_token(zc4[i], zc4[i + 1], zc4[i + 2], 2 * pth + i, Rt + i);
    }
}

__device__ __forceinline__ int frag_pos(int row, int chunk) { return ((((row >> 5) * 4 + (chunk >> 1)) * 64) + ((chunk & 1) * 32 + (row & 31))) * 8; }
#ifndef AREPMASK
#define AREPMASK 0
#endif
#ifndef AREPS
#define AREPS 5
#endif
#if AREPMASK
#define ALOOP(k) for (int ar_ = 0; ar_ < (((AREPMASK >> (k)) & 1) ? AREPS : 1); ++ar_, __syncthreads())
#else
#define ALOOP(k)
#endif
constexpr int SP = 144, SLOT = 64 * SP;
constexpr int NCHUNK = (CTXL + SEQ) / 64;
#define ROWOF(s) (((s) < CTXL) ? (ML + b * CTXL + (d == 0 ? (s) : CTXL - 1 - (s))) : (b * SEQ + (d == 0 ? ((s) - CTXL) : (SEQ - 1 - ((s) - CTXL)))))
__device__ __forceinline__ bf16x8 ldA(const LAS unsigned char* X, int row0, int ks, int r32, int hi) { return *(const LAS bf16x8*)(X + (row0 + r32) * SP + (16 * ks + 8 * hi) * 2); }
__device__ __forceinline__ bf16x8 ldT(const LAS unsigned char* X, int n0, int ks, int lane) {
    const int hi = lane >> 5, i16 = lane & 15, qd = i16 >> 2, pp = i16 & 3, c0 = lane & 16;
    const LAS unsigned char* p = X + (16 * ks + 8 * hi + qd) * SP + (n0 + c0 + 4 * pp) * 2;
    return cat4(tr_read(p), tr_read(p + 4 * SP));
}
#define KPOS(rb, q4, hi) ((rb) * 32 + (2 * ((q4) & 1) + (hi)) * 8 + ((q4) >> 1) * 4)
__device__ __forceinline__ v2u pack4(float a, float b, float c, float d) { v2u w; w.x = pk2(a, b); w.y = pk2(c, d); return w; }
__device__ __forceinline__ void stT(LAS unsigned char* M, const f32x16& dv, int r0, int c0, int r32, int hi) {
#pragma unroll
    for (int q4 = 0; q4 < 4; ++q4) *(LAS v2u*)(M + (c0 + r32) * SP + (r0 + 8 * q4 + 4 * hi) * 2) = pack4(dv[4 * q4], dv[4 * q4 + 1], dv[4 * q4 + 2], dv[4 * q4 + 3]);
}
__device__ __forceinline__ void rwkv_chunkA_phase(Frame& F, const Args& A_) {
    const bf16* ZS = (const bf16*)(F.ws + WS_ZS); const float* INVN = (const float*)(F.ws + WS_INVN); const bf16* LIN = (const bf16*)(F.ws + WS_LIN);
    const bf16* W2T = (const bf16*)(F.ws + WS_LW2); const bf16* A2T = (const bf16*)(F.ws + WS_LA2);
    bf16* MTg = (bf16*)(F.ws + WS_MT); bf16* NNg = (bf16*)(F.ws + WS_NN); bf16* QTg = (bf16*)(F.ws + WS_QT);
    bf16* Yg = (bf16*)((unsigned char*)F.out + DO_Y);
    LAS unsigned char* L = F.lds;
    LAS unsigned char* sKKt = L, *sBh = L + SLOT, *sKh = L + 2 * SLOT, *sRt = L + 3 * SLOT, *sBp = L + 4 * SLOT, *sKp = L + 5 * SLOT, *sVm = L + 6 * SLOT,
                     *sT = L + 7 * SLOT, *sAkN = L + 8 * SLOT, *sBbT = L + 9 * SLOT, *sHT = L + 10 * SLOT;
    LAS unsigned char* sFT = sBh; LAS unsigned char* sZT = sBbT; LAS unsigned char* sWyT = sBp; LAS unsigned char* sXT = sHT;
    LAS float* AB = (LAS float*)(L + 11 * SLOT);
    LAS unsigned char* sL1 = L + 11 * SLOT; LAS unsigned char* sL2 = L + 12 * SLOT;
    LAS float* LWf = (LAS float*)(L + 7 * SLOT); LAS float* AAf = LWf + 4096;
    LAS unsigned char* sR0 = L + 13 * SLOT, *sK0 = L + 14 * SLOT, *sV0 = L + 15 * SLOT;
    LAS float* SEG = (LAS float*)(L + 16 * SLOT);
    const int lane = F.lane, r32 = lane & 31, hi = lane >> 5, w = F.wave;
    constexpr int IPB = 64 * NCHUNK / 256;
    const int chain = F.vcu / (NCHUNK / IPB), b = chain >> 4, h = (chain >> 1) & 7, d = chain & 1, cfirst = (F.vcu % (NCHUNK / IPB)) * IPB;
    const int lwhich = w >> 2, ltb = (w >> 1) & 1, lcb = w & 1;
    bf16x8 wfrag[4]; float lbias;
    { const int chn = h * 64 + 32 * lcb + r32; const bf16* Bt = (lwhich ? A2T : W2T) + (size_t)(d * 512 + chn) * 64;
#pragma unroll
      for (int ks = 0; ks < 4; ++ks) wfrag[ks] = *(const bf16x8*)(Bt + 16 * ks + 8 * hi);
      lbias = (lwhich ? A_.in[I_IA0] : A_.in[I_DW0])[d * 512 + chn]; }
    const float rkc0 = A_.in[I_RK][h * 64 + 2 * (F.tid & 31)], rkc1 = A_.in[I_RK][h * 64 + 2 * (F.tid & 31) + 1];
    const float kkc0 = A_.in[I_KK][h * 64 + 2 * (F.tid & 31)], kkc1 = A_.in[I_KK][h * 64 + 2 * (F.tid & 31) + 1], kac0 = A_.in[I_KA][h * 64 + 2 * (F.tid & 31)], kac1 = A_.in[I_KA][h * 64 + 2 * (F.tid & 31) + 1];
    v4u pf_l1, pf_l2, pf_r, pf_k, pf_v; float pf_in = 0.f;
    const int ptok = F.tid >> 3, pc16 = F.tid & 7;
#define CHA_PREFETCH(cc) do { const int row_ = ROWOF(64 * (cc) + ptok); \
        pf_l1 = *(const v4u*)(LIN + (size_t)row_ * 128 + pc16 * 8); pf_l2 = *(const v4u*)(LIN + (size_t)row_ * 128 + 64 + pc16 * 8); \
        const bf16* zp_ = ZS + (size_t)row_ * 1536 + h * 64 + pc16 * 8; pf_r = *(const v4u*)zp_; pf_k = *(const v4u*)(zp_ + 512); pf_v = *(const v4u*)(zp_ + 1024); \
        if (F.tid < 64) pf_in = INVN[(size_t)ROWOF(64 * (cc) + F.tid) * 8 + h]; } while (0)
#define CHA_STAGE() do { *(LAS v4u*)(sL1 + ptok * SP + pc16 * 16) = pf_l1; *(LAS v4u*)(sL2 + ptok * SP + pc16 * 16) = pf_l2; \
        *(LAS v4u*)(sR0 + ptok * SP + pc16 * 16) = pf_r; *(LAS v4u*)(sK0 + ptok * SP + pc16 * 16) = pf_k; *(LAS v4u*)(sV0 + ptok * SP + pc16 * 16) = pf_v; \
        if (F.tid < 64) SEG[9 * 64 + F.tid] = pf_in; } while (0)
    __syncthreads();
    CHA_PREFETCH(cfirst); CHA_STAGE();
    CHA_PREFETCH(cfirst + 1);
#pragma unroll 1
    for (int ii = 0; ii < IPB; ++ii) {
        const int c = cfirst + ii, inst = chain * NCHUNK + c;
        const bool latent = c >= CTXL / 64;
        __syncthreads();
        ALOOP(0) { f32x16 acc = {};
#pragma unroll
          for (int ks = 0; ks < 4; ++ks) acc = mfma32(ldA(lwhich ? sL2 : sL1, 32 * ltb, ks, r32, hi), wfrag[ks], acc);
#pragma unroll
          for (int r = 0; r < 16; ++r) { const int tok = 32 * ltb + (r & 3) + 8 * (r >> 2) + 4 * hi; const float x = lbias + acc[r];
              const float sg = __builtin_amdgcn_rcpf(1.f + __expf(-x));
              if (lwhich == 0) LWf[tok * 64 + 32 * lcb + r32] = -0.6065306597126334f * sg; else AAf[tok * 64 + 32 * lcb + r32] = sg; }
        }
        __syncthreads();
        ALOOP(6) {
            const int cp = F.tid & 31, sg = F.tid >> 5, ch = 2 * cp;
            LAS float* SEGT = (LAS float*)(L + 7 * SLOT + 32768);
            float cl[4][2], aa[4][2], rr[4][2], kx[4][2], inn[4]; unsigned vraw[4];
#pragma unroll
            for (int e = 0; e < 4; ++e) { const int tok = 4 * sg + e;
                vraw[e] = *(const LAS unsigned*)(sV0 + tok * SP + ch * 2);
                const f32x2c l2 = *(const LAS f32x2c*)(LWf + tok * 64 + ch), a2 = *(const LAS f32x2c*)(AAf + tok * 64 + ch);
                const unsigned r2 = *(const LAS unsigned*)(sR0 + tok * SP + ch * 2), k2 = *(const LAS unsigned*)(sK0 + tok * SP + ch * 2);
                cl[e][0] = l2.x; cl[e][1] = l2.y; aa[e][0] = a2.x; aa[e][1] = a2.y; rr[e][0] = bf_lo(r2); rr[e][1] = bf_hi(r2); kx[e][0] = bf_lo(k2); kx[e][1] = bf_hi(k2); inn[e] = SEG[9 * 64 + tok]; }
#pragma unroll
            for (int e = 1; e < 4; ++e) { cl[e][0] += cl[e - 1][0]; cl[e][1] += cl[e - 1][1]; }
            *(LAS f32x2c*)(SEGT + sg * 64 + ch) = (f32x2c){cl[3][0], cl[3][1]};
            __syncthreads();
            float pre[2] = {0.f, 0.f}, tot[2] = {0.f, 0.f};
#pragma unroll
            for (int s_ = 0; s_ < 16; ++s_) { const f32x2c t = *(const LAS f32x2c*)(SEGT + s_ * 64 + ch); tot[0] += t.x; tot[1] += t.y; if (s_ < sg) { pre[0] += t.x; pre[1] += t.y; } }
            if (sg == 0) *(LAS f32x2c*)(SEG + 8 * 64 + ch) = (f32x2c){tot[0], tot[1]};
            if (d == 0 && latent) {
                float* BSg = (float*)(F.ws + WS_BS);
#pragma unroll
                for (int e = 0; e < 4; ++e) { float t_ = rr[e][0] * kx[e][0] * rkc0 + rr[e][1] * kx[e][1] * rkc1;
                    t_ = sum8(t_); t_ += dppf<0x140>(t_); t_ += dppf<0x142>(t_);
                    if ((F.lane & 31) == 31) BSg[(size_t)ROWOF(64 * c + 4 * sg + e) * 8 + h] = t_; }
            }
            float o[7][4][2];
#pragma unroll
            for (int c = 0; c < 2; ++c) {
                const float ptot = __expf(tot[c]); float epprev = __expf(pre[c]); const float kkc_ = c ? kkc1 : kkc0, kac_ = c ? kac1 : kac0;
#pragma unroll
                for (int e = 0; e < 4; ++e) {
                    const float c_ = pre[c] + cl[e][c];
                    const float kk = kx[e][c] * kkc_ * inn[e], bb = kk * aa[e][c], kd = kx[e][c] * (1.f + (aa[e][c] - 1.f) * kac_);
                    const float em = __expf(-c_), ep = __builtin_amdgcn_rcpf(em), ee = ptot * em, e1 = epprev; epprev = ep;
                    o[0][e][c] = kk * e1; o[1][e][c] = bb * em; o[2][e][c] = kd * em; o[3][e][c] = rr[e][c] * ep; o[4][e][c] = bb * ee; o[5][e][c] = kd * ee;
                }
            }
#pragma unroll
            for (int e = 0; e < 4; ++e) { const int off = (4 * sg + e) * SP + ch * 2;
                *(LAS unsigned*)(sKKt + off) = pk2(o[0][e][0], o[0][e][1]); *(LAS unsigned*)(sBh + off) = pk2(o[1][e][0], o[1][e][1]); *(LAS unsigned*)(sKh + off) = pk2(o[2][e][0], o[2][e][1]);
                *(LAS unsigned*)(sRt + off) = pk2(o[3][e][0], o[3][e][1]); *(LAS unsigned*)(sBp + off) = pk2(o[4][e][0], o[4][e][1]); *(LAS unsigned*)(sKp + off) = pk2(o[5][e][0], o[5][e][1]);
                *(LAS unsigned*)(sVm + off) = vraw[e]; }
        }
        __syncthreads();
        ALOOP(1)
        if (w < 4) {
            const int rb = (w >> 1) & 1, cb = w & 1;
            f32x16 acc = {};
#pragma unroll
            for (int ks = 0; ks < 4; ++ks) acc = mfma32(ldA(sKKt, 32 * rb, ks, r32, hi), ldA(sBh, 32 * cb, ks, r32, hi), acc);
            const int col = 32 * cb + r32;
#pragma unroll
            for (int r = 0; r < 16; ++r) { const int row = 32 * rb + (r & 3) + 8 * (r >> 2) + 4 * hi; if (!(col < row)) acc[r] = 0.f; }
#pragma unroll
            for (int q4 = 0; q4 < 4; ++q4) *(LAS f32x4*)(AB + col * 68 + 32 * rb + 8 * q4 + 4 * hi) = (f32x4){acc[4 * q4], acc[4 * q4 + 1], acc[4 * q4 + 2], acc[4 * q4 + 3]};
        }
        __syncthreads();
        ALOOP(2) {
            const int gm = 1 + (w >> 2), grb = (w >> 1) & 1, gcb = w & 1;
            f32x16 gacc = {};
            { const LAS unsigned char* GX = (gm == 2) ? sBh : sKKt; const LAS unsigned char* GY = (gm == 1) ? sKh : sRt;
#pragma unroll
              for (int ks = 0; ks < 4; ++ks) gacc = mfma32(ldA(GX, 32 * grb, ks, r32, hi), ldA(GY, 32 * gcb, ks, r32, hi), gacc); }
            const int col = F.tid >> 3, jq = F.tid & 7, blk = col >> 4, cc = col & 15; float t0 = 0.f, t1 = 0.f;
            const LAS float* arow = AB + (16 * blk) * 68 + 16 * blk + 2 * jq;
#pragma unroll
            for (int i = 15; i >= 0; --i) {
                const f32x2c av = *(const LAS f32x2c*)(arow + i * 68);
                float p = av[0] * t0 + av[1] * t1; p = sum8(p);
                const float val = (i == cc) ? 1.f : ((i < cc) ? -p : 0.f);
                if (jq == (i >> 1)) { if ((i & 1) == 0) t0 = val; else t1 = val; }
            }
            { const int gcol = 32 * gcb + r32;
#pragma unroll
              for (int r = 0; r < 16; ++r) { const int row = 32 * grb + (r & 3) + 8 * (r >> 2) + 4 * hi;
                  const bool keep = (gm == 2) ? (row <= gcol) : (gcol < row); float vl = keep ? gacc[r] : 0.f; if (gm == 1) vl = -vl; gacc[r] = vl; }
              stT((gm == 1) ? sAkN : sBbT, gacc, 32 * grb, 32 * gcb, r32, hi); }
            { LAS unsigned char* tp_ = sT + (16 * blk + 2 * jq) * SP + (16 * blk + cc) * 2;
              *(LAS bf16*)(tp_) = (bf16)f2bf(t0); *(LAS bf16*)(tp_ + SP) = (bf16)f2bf(t1); }
            if (F.tid < 64) { const v4u z = {0u, 0u, 0u, 0u}; LAS unsigned char* zp = sT + (32 + (F.tid >> 1)) * SP + (F.tid & 1) * 32; *(LAS v4u*)zp = z; *(LAS v4u*)(zp + 16) = z; }
            else if (F.tid < 96) { const v4u z = {0u, 0u, 0u, 0u}; const int q_ = (F.tid - 64) >> 4, r_ = (F.tid - 64) & 15; LAS unsigned char* zp = sT + (32 * q_ + 16 + r_) * SP + (32 * q_) * 2; *(LAS v4u*)zp = z; *(LAS v4u*)(zp + 16) = z; }
        }
        __syncthreads();
        ALOOP(7) {
        if (w < 2) {
            const int o = 32 * w;
            const LAS float* ap = AB + (o + r32) * 68 + o + 16 + 8 * hi; const f32x4 a0 = *(const LAS f32x4*)ap, a1 = *(const LAS f32x4*)(ap + 4);
            v4u aw; aw.x = pk2(a0[0], a0[1]); aw.y = pk2(a0[2], a0[3]); aw.z = pk2(a1[0], a1[1]); aw.w = pk2(a1[2], a1[3]);
            const int i16 = lane & 15, qd = i16 >> 2, pp = i16 & 3, c0 = lane & 16;
            const LAS unsigned char* tp = sT + (o + 16 + 8 * hi + qd) * SP + (o + 16 + c0 + 4 * pp) * 2;
            f32x16 x = {}; x = mfma32(__builtin_bit_cast(bf16x8, aw), cat4(tr_read(tp), tr_read(tp + 4 * SP)), x);
            stT(sXT, x, 0, o, r32, hi);
            f32x16 tr = {}; tr = mfma32(*(const LAS bf16x8*)(sT + (o + r32) * SP + (o + 8 * hi) * 2), *(const LAS bf16x8*)(sXT + (o + r32) * SP + (8 * hi) * 2), tr);
            if (r32 < 16) {
#pragma unroll
                for (int r = 0; r < 8; ++r) { const int i = (r & 3) + 8 * (r >> 2) + 4 * hi; *(LAS bf16*)(sT + (o + i) * SP + (o + 16 + r32) * 2) = (bf16)f2bf(-tr[r]); }
            }
        }
        __syncthreads();
        if (w == 0) {
            f32x16 x = {};
#pragma unroll
            for (int ks = 0; ks < 2; ++ks) { const LAS float* ap = AB + r32 * 68 + 32 + 16 * ks + 8 * hi; const f32x4 a0 = *(const LAS f32x4*)ap, a1 = *(const LAS f32x4*)(ap + 4);
                v4u aw; aw.x = pk2(a0[0], a0[1]); aw.y = pk2(a0[2], a0[3]); aw.z = pk2(a1[0], a1[1]); aw.w = pk2(a1[2], a1[3]);
                const int i16 = lane & 15, qd = i16 >> 2, pp = i16 & 3, c0 = lane & 16;
                const LAS unsigned char* tp = sT + (32 + 16 * ks + 8 * hi + qd) * SP + (32 + c0 + 4 * pp) * 2;
                x = mfma32(__builtin_bit_cast(bf16x8, aw), cat4(tr_read(tp), tr_read(tp + 4 * SP)), x); }
            stT(sXT, x, 0, 0, r32, hi);
            f32x16 tr = {};
#pragma unroll
            for (int ks = 0; ks < 2; ++ks) tr = mfma32(ldA(sT, 0, ks, r32, hi), ldA(sXT, 0, ks, r32, hi), tr);
#pragma unroll
            for (int r = 0; r < 16; ++r) { const int i = (r & 3) + 8 * (r >> 2) + 4 * hi; *(LAS bf16*)(sT + i * SP + (32 + r32) * 2) = (bf16)f2bf(-tr[r]); }
        }
        }
        __syncthreads();
        ALOOP(3) { const int which = w >> 2, rb = (w >> 1) & 1, cb = w & 1; f32x16 acc = {}; bf16x8 fa3[4], fb3[4];
#pragma unroll
          for (int ks = 0; ks < 4; ++ks) fa3[ks] = ldA(sT, 32 * rb, ks, r32, hi);
          if (which) {
#pragma unroll
              for (int ks = 0; ks < 4; ++ks) fb3[ks] = ldT(sBp, 32 * cb, ks, lane);
          } else {
#pragma unroll
              for (int ks = 0; ks < 4; ++ks) fb3[ks] = ldA(sBbT, 32 * cb, ks, r32, hi);
          }
          asm volatile("" :: "v"(fa3[0]), "v"(fa3[1]), "v"(fa3[2]), "v"(fa3[3]), "v"(fb3[0]), "v"(fb3[1]), "v"(fb3[2]), "v"(fb3[3]));
#pragma unroll
          for (int ks = 0; ks < 4; ++ks) acc = mfma32(fa3[ks], fb3[ks], acc);
          stT(which ? sHT : sFT, acc, 32 * rb, 32 * cb, r32, hi); }
        __syncthreads();
        if (ii + 1 < IPB) { CHA_STAGE(); if (ii + 2 < IPB) CHA_PREFETCH(c + 2); }
        const size_t ioff = (size_t)(c * 64 + chain) * 4096; const size_t qoff = (size_t)((c - 4) * 64 + chain) * 4096;
        ALOOP(4)
#pragma unroll 1
        for (int q = w; q < 16; q += 8) {
            const int kind = q >> 2, rb = (q >> 1) & 1, cb = q & 1; const int col = 32 * cb + r32;
            if (!latent && (kind == 1 || kind == 3)) continue;
            f32x16 acc = {}; bf16x8 fa4[4], fb4[4];
            if (kind == 3) {
#pragma unroll
                for (int ks = 0; ks < 4; ++ks) { fa4[ks] = ldA(sKh, 32 * rb, ks, r32, hi); fb4[ks] = ldA(sRt, 32 * cb, ks, r32, hi); }
#pragma unroll
                for (int ks = 0; ks < 4; ++ks) acc = mfma32(fa4[ks], fb4[ks], acc);
#pragma unroll
                for (int r = 0; r < 16; ++r) { const int row = 32 * rb + (r & 3) + 8 * (r >> 2) + 4 * hi; if (row > col) acc[r] = 0.f; }
            }
            if (kind < 2) {
#pragma unroll
                for (int ks = 0; ks < 4; ++ks) fa4[ks] = ldT(sKKt, 32 * rb, ks, lane);
            } else {
#pragma unroll
                for (int ks = 0; ks < 4; ++ks) fa4[ks] = ldA(sAkN, 32 * rb, ks, r32, hi);
            }
            { const LAS unsigned char* FB = (kind & 1) ? sFT : sHT;
#pragma unroll
              for (int ks = 0; ks < 4; ++ks) fb4[ks] = ldA(FB, 32 * cb, ks, r32, hi); }
            asm volatile("" :: "v"(fa4[0]), "v"(fa4[1]), "v"(fa4[2]), "v"(fa4[3]), "v"(fb4[0]), "v"(fb4[1]), "v"(fb4[2]), "v"(fb4[3]));
#pragma unroll
            for (int ks = 0; ks < 4; ++ks) acc = mfma32(fa4[ks], fb4[ks], acc);
            if (kind == 0) {
                const float pc = __expf(SEG[8 * 64 + col]); v2u pq[4];
#pragma unroll
                for (int q4 = 0; q4 < 4; ++q4) { const int r0 = 32 * rb + 8 * q4 + 4 * hi; float o[4];
#pragma unroll
                    for (int e = 0; e < 4; ++e) o[e] = ((r0 + e == col) ? pc : 0.f) - acc[4 * q4 + e];
                    pq[q4] = pk4(o[0], o[1], o[2], o[3]); }
                bf16* dp = MTg + ioff + (size_t)col * 64 + rb * 32;
                *(v4u*)(dp + hi * 8) = (v4u){pq[0].x, pq[0].y, pq[2].x, pq[2].y}; *(v4u*)(dp + (2 + hi) * 8) = (v4u){pq[1].x, pq[1].y, pq[3].x, pq[3].y};
            } else if (kind == 1) {
                v2u pq[4];
#pragma unroll
                for (int q4 = 0; q4 < 4; ++q4) { const int r0 = 32 * rb + 8 * q4 + 4 * hi; const v2u rv = *(const LAS v2u*)(sRt + col * SP + r0 * 2);
                    pq[q4] = pk4(bf_lo(rv.x) - acc[4 * q4], bf_hi(rv.x) - acc[4 * q4 + 1], bf_lo(rv.y) - acc[4 * q4 + 2], bf_hi(rv.y) - acc[4 * q4 + 3]); }
                { const int qrow = d ? 63 - col : col;
                  bf16* dp = QTg + qoff;
                  *(v4u*)(dp + frag_pos(qrow, 4 * rb + hi)) = (v4u){pq[0].x, pq[0].y, pq[2].x, pq[2].y}; *(v4u*)(dp + frag_pos(qrow, 4 * rb + 2 + hi)) = (v4u){pq[1].x, pq[1].y, pq[3].x, pq[3].y}; }
            } else if (kind == 2) {
#pragma unroll
                for (int r = 0; r < 16; ++r) { const int row = 32 * rb + (r & 3) + 8 * (r >> 2) + 4 * hi; acc[r] += bf1(*(const LAS bf16*)(sKp + row * SP + col * 2)); }
                stT(sZT, acc, 32 * rb, 32 * cb, r32, hi);
            } else stT(sWyT, acc, 32 * rb, 32 * cb, r32, hi);
        }
        __syncthreads();
        ALOOP(5) { const int which = w >> 2, rb = (w >> 1) & 1, cb = w & 1; const int col = 32 * cb + r32;
          if (which == 0 || latent) {
            f32x16 acc = {}; bf16x8 fa5[4], fb5[4];
#pragma unroll
            for (int ks = 0; ks < 4; ++ks) {
                if (which) { fa5[ks] = ldT(sVm, 32 * rb, ks, lane); fb5[ks] = ldA(sWyT, 32 * cb, ks, r32, hi); }
                else { fa5[ks] = ldA(sZT, 32 * rb, ks, r32, hi); fb5[ks] = ldT(sVm, 32 * cb, ks, lane); } }
            asm volatile("" :: "v"(fa5[0]), "v"(fa5[1]), "v"(fa5[2]), "v"(fa5[3]), "v"(fb5[0]), "v"(fb5[1]), "v"(fb5[2]), "v"(fb5[3]));
#pragma unroll
            for (int ks = 0; ks < 4; ++ks) acc = mfma32(fa5[ks], fb5[ks], acc);
            const v2u q0 = pk4(acc[0], acc[1], acc[2], acc[3]), q1 = pk4(acc[4], acc[5], acc[6], acc[7]), q2 = pk4(acc[8], acc[9], acc[10], acc[11]), q3 = pk4(acc[12], acc[13], acc[14], acc[15]);
            if (which) store_rows16(Yg + ((size_t)d * ML + ROWOF(64 * c + col)) * 512 + h * 64 + 32 * rb, q0, q1, q2, q3, hi);
            else { bf16* dp = NNg + ioff + (size_t)col * 64 + 8 * rb;
                *(v4u*)(dp + hi * 16) = (v4u){q0.x, q0.y, q2.x, q2.y}; *(v4u*)(dp + (2 + hi) * 16) = (v4u){q1.x, q1.y, q3.x, q3.y}; }
          } }
    }
}

typedef float f32x4_t __attribute__((ext_vector_type(4)));
__device__ __forceinline__ f32x4_t mfma16(bf16x8 a, bf16x8 b, f32x4_t c) { return __builtin_amdgcn_mfma_f32_16x16x32_bf16(a, b, c, 0, 0, 0); }
__device__ __forceinline__ bf16* ss_ptr(Frame& F, int cl, int chain) { return ((cl < 64) ? (bf16*)(F.ws + WS_SS) : (bf16*)((unsigned char*)F.out + DO_SS)) + (size_t)((cl & 63) * 64 + chain) * 4096; }
__device__ __forceinline__ void st16_asm(void* p, v4u v) { asm volatile("global_store_dwordx4 %0, %1, off\n\ts_nop 1" :: "v"(p), "v"(v) : "memory"); }
struct ChunkOps { v4u m[8]; v4u n[2]; };
__device__ __forceinline__ void chB_load(ChunkOps& o, const bf16* mt, const bf16* nn) {
#pragma unroll
    for (int tn = 0; tn < 4; ++tn) { o.m[2 * tn] = *(const v4u*)(mt + tn * 1024); o.m[2 * tn + 1] = *(const v4u*)(mt + tn * 1024 + 32); }
    o.n[0] = *(const v4u*)nn; o.n[1] = *(const v4u*)(nn + 8);
}
__device__ __forceinline__ void rwkv_chunkB_phase(Frame& F, const Args& A_, int mode = 0) {
    if ((F.vcu & 31) >= 8) return;
    const int chain = (F.vcu >> 5) * 8 + (F.vcu & 31), vb = F.wave & 3; const bool comp = F.wave < 4;
    const int l15 = F.lane & 15, g = F.lane >> 4;
    const int lt = F.tid & 255;
    const bf16* mtg = (const bf16*)(F.ws + WS_MT) + (size_t)chain * 4096 + lt * 8;
    const bf16* nng = (const bf16*)(F.ws + WS_NN) + (size_t)chain * 4096 + lt * 8;
    const int ssoff = frag_pos(16 * vb + l15, g), ssoff1 = frag_pos(16 * vb + l15, 4 + g);
    const int wr = lt >> 3, wp = lt & 7; const int woff = wr * 128 + ((wp ^ (wr & 7)) << 4);
    LAS unsigned char* img = F.lds;
    bf16x8 S0 = {}, S1 = {};
    struct R4 { v4u a, b, c, d; };
    R4 r0, r1, r2, r3, r4, r5;
#define B_LD(r, cc) do { r.a = __builtin_nontemporal_load((const v4u*)(mtg + (size_t)(cc) * 262144)); r.b = __builtin_nontemporal_load((const v4u*)(mtg + (size_t)(cc) * 262144 + 2048)); r.c = __builtin_nontemporal_load((const v4u*)(nng + (size_t)(cc) * 262144)); r.d = __builtin_nontemporal_load((const v4u*)(nng + (size_t)(cc) * 262144 + 2048)); } while (0)
#define B_ST(r, cc) do { LAS unsigned char* d_ = img + ((cc) & 1) * 16384 + woff; *(LAS v4u*)d_ = r.a; *(LAS v4u*)(d_ + 4096) = r.b; *(LAS v4u*)(d_ + 8192) = r.c; *(LAS v4u*)(d_ + 12288) = r.d; } while (0)
#define B_BAR() asm volatile("s_waitcnt lgkmcnt(0)\n\ts_barrier" ::: "memory")
#define B_CL(cc) (((cc) < NCHUNK) ? (cc) : (NCHUNK - 1))
    __syncthreads();
    if (!comp) {
        B_LD(r0, 0); B_LD(r1, 1); B_LD(r2, 2); B_LD(r3, 3); B_LD(r4, 4); B_LD(r5, 5);
        B_BAR();
        B_ST(r0, 0); B_LD(r0, 6);
        B_BAR();
#define B_LITER(Rn, cc) do { B_ST(Rn, (cc) + 1); B_LD(Rn, B_CL((cc) + 7)); B_BAR(); } while (0)
#pragma unroll 1
        for (int c = 0; c < NCHUNK; c += 6) { B_LITER(r1, c); B_LITER(r2, c + 1); B_LITER(r3, c + 2); B_LITER(r4, c + 3); B_LITER(r5, c + 4); B_LITER(r0, c + 5); }
#undef B_LITER
    } else {
        B_BAR();
        B_BAR();
        const int vr_ = 16 * vb + l15;
#define B_CITER(cc) do { \
            const LAS unsigned char* si_ = img + ((cc) & 1) * 16384; \
            if ((cc) >= 4) { bf16* sp_ = ss_ptr(F, (cc) - 4, chain); *(v4u*)(sp_ + ssoff) = __builtin_bit_cast(v4u, S0); *(v4u*)(sp_ + ssoff1) = __builtin_bit_cast(v4u, S1); } \
            const v4u n0_ = *(const LAS v4u*)(si_ + 8192 + vr_ * 128 + (((2 * g) ^ (vr_ & 7)) << 4)), n1_ = *(const LAS v4u*)(si_ + 8192 + vr_ * 128 + (((2 * g + 1) ^ (vr_ & 7)) << 4)); \
            f32x4_t dn_[4]; \
            _Pragma("unroll") for (int tn = 0; tn < 4; ++tn) { const int nr_ = 16 * tn + l15; \
                const bf16x8 a0_ = *(const LAS bf16x8*)(si_ + nr_ * 128 + ((g ^ (nr_ & 7)) << 4)), a1_ = *(const LAS bf16x8*)(si_ + nr_ * 128 + (((4 + g) ^ (nr_ & 7)) << 4)); \
                const v4u nq_ = (tn >> 1) ? n1_ : n0_; const unsigned nx_ = (tn & 1) ? nq_.z : nq_.x, ny_ = (tn & 1) ? nq_.w : nq_.y; \
                const f32x4_t ci_ = {bf_lo(nx_), bf_hi(nx_), bf_lo(ny_), bf_hi(ny_)}; \
                dn_[tn] = mfma16(a0_, S0, ci_); dn_[tn] = mfma16(a1_, S1, dn_[tn]); } \
            v4u w0_, w1_; w0_.x = cvtpk(dn_[0][0], dn_[0][1]); w0_.y = cvtpk(dn_[0][2], dn_[0][3]); w0_.z = cvtpk(dn_[1][0], dn_[1][1]); w0_.w = cvtpk(dn_[1][2], dn_[1][3]); \
            w1_.x = cvtpk(dn_[2][0], dn_[2][1]); w1_.y = cvtpk(dn_[2][2], dn_[2][3]); w1_.z = cvtpk(dn_[3][0], dn_[3][1]); w1_.w = cvtpk(dn_[3][2], dn_[3][3]); \
            S0 = __builtin_bit_cast(bf16x8, w0_); S1 = __builtin_bit_cast(bf16x8, w1_); \
            B_BAR(); } while (0)
#pragma unroll 1
        for (int c = 0; c < NCHUNK; c += 2) { B_CITER(c); B_CITER(c + 1); }
#undef B_CITER
    }
    __syncthreads();
#undef B_BAR
#undef B_CL
#undef B_LD
#undef B_ST
}
__device__ __forceinline__ void rwkv_chunkC_phase(Frame& F, const Args& A_, bool do_store) {
    const bf16* QTg = (const bf16*)(F.ws + WS_QT); bf16* Yg = (bf16*)((unsigned char*)F.out + DO_Y);
    const int lane = F.lane, r32 = lane & 31, hi = lane >> 5;
    const int gw = F.vcu * NWAVES + F.wave, NGW = F.G * NWAVES;
#pragma unroll 1
    for (int q = gw; q < 64 * (NCHUNK - 4); q += NGW) {
        const int cl = q >> 6, chain = q & 63, c = cl + 4, b = chain >> 4, h = (chain >> 1) & 7, d = chain & 1;
        const bf16* sp = ss_ptr(F, cl, chain); const bf16* qp = QTg + (size_t)q * 4096;
        bf16x8 af[2][4], bq[2][4];
#pragma unroll
        for (int t = 0; t < 2; ++t)
#pragma unroll
            for (int ks = 0; ks < 4; ++ks) { af[t][ks] = *(const bf16x8*)(sp + (size_t)(32 * t + r32) * 64 + 16 * ks + 8 * hi); bq[t][ks] = *(const bf16x8*)(qp + (size_t)(32 * t + r32) * 64 + 16 * ks + 8 * hi); }
        v4u yw[2][2][2];
#pragma unroll
        for (int ct = 0; ct < 2; ++ct) {
            const bf16* yrow = Yg + ((size_t)d * ML + ROWOF(64 * c + 32 * ct + r32)) * 512 + h * 64;
#pragma unroll
            for (int rt = 0; rt < 2; ++rt) { yw[ct][rt][0] = *(const v4u*)(yrow + 32 * rt + (hi ? 8 : 0)); yw[ct][rt][1] = *(const v4u*)(yrow + 32 * rt + 16 + (hi ? 8 : 0)); }
        }
#pragma unroll
        for (int ct = 0; ct < 2; ++ct) {
            bf16* yrow = Yg + ((size_t)d * ML + ROWOF(64 * c + 32 * ct + r32)) * 512 + h * 64;
#pragma unroll
            for (int rt = 0; rt < 2; ++rt) {
                f32x16 acc;
                { const v4u w0 = yw[ct][rt][0], w1 = yw[ct][rt][1];
                  const v4u u0 = widen2((v2u){w0.x, w0.y}, (v2u){w0.z, w0.w}), u1 = widen2((v2u){w1.x, w1.y}, (v2u){w1.z, w1.w});
                  acc[0] = bf_lo(u0.x); acc[1] = bf_hi(u0.x); acc[2] = bf_lo(u0.y); acc[3] = bf_hi(u0.y); acc[4] = bf_lo(u0.z); acc[5] = bf_hi(u0.z); acc[6] = bf_lo(u0.w); acc[7] = bf_hi(u0.w);
                  acc[8] = bf_lo(u1.x); acc[9] = bf_hi(u1.x); acc[10] = bf_lo(u1.y); acc[11] = bf_hi(u1.y); acc[12] = bf_lo(u1.z); acc[13] = bf_hi(u1.z); acc[14] = bf_lo(u1.w); acc[15] = bf_hi(u1.w); }
#pragma unroll
                for (int ks = 0; ks < 4; ++ks) acc = mfma32(af[rt][ks], bq[ct][ks], acc);
                if (do_store) store_rows16(yrow + 32 * rt, pk4(acc[0], acc[1], acc[2], acc[3]), pk4(acc[4], acc[5], acc[6], acc[7]), pk4(acc[8], acc[9], acc[10], acc[11]), pk4(acc[12], acc[13], acc[14], acc[15]), hi);
                else asm volatile("" :: "v"(acc));
            }
        }
    }
}

__device__ __forceinline__ float half_pair_sum(float s) { auto rr = __builtin_amdgcn_permlane32_swap(__float_as_uint(s), __float_as_uint(s), false, false); return __uint_as_float(rr[0]) + __uint_as_float(rr[1]); }
__device__ __forceinline__ void rwkv_cout_phase(Frame& F, const Args& A_) {
    const bf16* QTg = (const bf16*)(F.ws + WS_QT); const bf16* Yg = (const bf16*)((unsigned char*)F.out + DO_Y);
    const bf16* ZS = (const bf16*)(F.ws + WS_ZS); const bf16* SGL = (const bf16*)((unsigned char*)F.out + DO_G); bf16* O = (bf16*)(F.ws + WS_ATTRW);
    const bf16* G2T = (const bf16*)(F.ws + WS_LG2);
    const int lane = F.lane, r32 = lane & 31, hi = lane >> 5;
    const int gw = F.vcu * NWAVES + F.wave, NGW = F.G * NWAVES;
    LAS float* TAB = (LAS float*)F.lds;
    constexpr int G2P = 272; LAS unsigned char* G2L = F.lds + 8192;
    __syncthreads();
    { v4u t_[16];
#pragma unroll
      for (int i = 0; i < 16; ++i) { const int it = F.tid + 512 * i; t_[i] = *(const v4u*)(G2T + (size_t)(it >> 4) * 128 + (it & 15) * 8); }
#pragma unroll
      for (int i = 0; i < 16; ++i) { const int it = F.tid + 512 * i; *(LAS v4u*)(G2L + (it >> 4) * G2P + (it & 15) * 16) = t_[i]; } }
    for (int i = F.tid; i < 512; i += 512) { TAB[i] = A_.in[I_RK][i]; TAB[512 + i] = A_.in[I_LNG][i]; TAB[1024 + i] = A_.in[I_LNB][i]; }
    __syncthreads();
#define CO_RAW(w_, p_) do { w_[0] = *(const v4u*)((p_) + (hi ? 8 : 0)); w_[1] = *(const v4u*)((p_) + 16 + (hi ? 8 : 0)); } while (0)
#define CO_CVT(o_, w_) do { const v4u u0_ = widen2((v2u){w_[0].x, w_[0].y}, (v2u){w_[0].z, w_[0].w}), u1_ = widen2((v2u){w_[1].x, w_[1].y}, (v2u){w_[1].z, w_[1].w}); \
        o_[0] = bf_lo(u0_.x); o_[1] = bf_hi(u0_.x); o_[2] = bf_lo(u0_.y); o_[3] = bf_hi(u0_.y); o_[4] = bf_lo(u0_.z); o_[5] = bf_hi(u0_.z); o_[6] = bf_lo(u0_.w); o_[7] = bf_hi(u0_.w); \
        o_[8] = bf_lo(u1_.x); o_[9] = bf_hi(u1_.x); o_[10] = bf_lo(u1_.y); o_[11] = bf_hi(u1_.y); o_[12] = bf_lo(u1_.z); o_[13] = bf_hi(u1_.z); o_[14] = bf_lo(u1_.w); o_[15] = bf_hi(u1_.w); } while (0)
#pragma unroll 1
    for (int q = gw; q < BATCH * 8 * (NCHUNK - 4); q += NGW) {
        const int h = q & 7, cp = (q >> 3) & 127, b = q >> 10;
        const int chain0 = b * 16 + h * 2, chain1 = chain0 + 1, cl1 = 127 - cp;
        const bf16* sp0 = ss_ptr(F, cp, chain0); const bf16* sp1 = ss_ptr(F, cl1, chain1);
        const bf16* qp0 = QTg + (size_t)(cp * 64 + chain0) * 4096; const bf16* qp1 = QTg + (size_t)(cl1 * 64 + chain1) * 4096;
#pragma unroll 1
        for (int ct = 0; ct < 2; ++ct) {
            const int tj = 32 * ct + r32; const size_t tokrow = (size_t)b * SEQ + 64 * cp + tj;
            v4u wy0[2][2], wy1[2][2];
#pragma unroll
            for (int rt = 0; rt < 2; ++rt) { CO_RAW(wy0[rt], Yg + tokrow * 512 + h * 64 + 32 * rt); CO_RAW(wy1[rt], Yg + ((size_t)ML + tokrow) * 512 + h * 64 + 32 * rt); }
            f32x16 acc[2];
            {
                bf16x8 af[2][4], bq[4];
#pragma unroll
                for (int ks = 0; ks < 4; ++ks) bq[ks] = __builtin_nontemporal_load((const bf16x8*)(qp0 + ((ct * 4 + ks) * 64 + lane) * 8));
#pragma unroll
                for (int t = 0; t < 2; ++t)
#pragma unroll
                    for (int ks = 0; ks < 4; ++ks) af[t][ks] = __builtin_nontemporal_load((const bf16x8*)(sp0 + ((t * 4 + ks) * 64 + lane) * 8));
#pragma unroll
                for (int rt = 0; rt < 2; ++rt) { float t0[16], t1[16]; CO_CVT(t0, wy0[rt]); CO_CVT(t1, wy1[rt]);
#pragma unroll
                    for (int r = 0; r < 16; ++r) acc[rt][r] = t0[r] + t1[r]; }
#pragma unroll
                for (int rt = 0; rt < 2; ++rt)
#pragma unroll
                    for (int ks = 0; ks < 4; ++ks) acc[rt] = mfma32(af[rt][ks], bq[ks], acc[rt]);
            }
            asm volatile("" ::: "memory");
            {
                bf16x8 af[2][4], bq[4];
#pragma unroll
                for (int ks = 0; ks < 4; ++ks) bq[ks] = __builtin_nontemporal_load((const bf16x8*)(qp1 + ((ct * 4 + ks) * 64 + lane) * 8));
#pragma unroll
                for (int t = 0; t < 2; ++t)
#pragma unroll
                    for (int ks = 0; ks < 4; ++ks) af[t][ks] = __builtin_nontemporal_load((const bf16x8*)(sp1 + ((t * 4 + ks) * 64 + lane) * 8));
#pragma unroll
                for (int rt = 0; rt < 2; ++rt)
#pragma unroll
                    for (int ks = 0; ks < 4; ++ks) acc[rt] = mfma32(af[rt][ks], bq[ks], acc[rt]);
            }
            asm volatile("" ::: "memory");
            const float bs = ((const float*)(F.ws + WS_BS))[tokrow * 8 + h];
            v4u wv[2][2]; bf16x8 sg[8];
#pragma unroll
            for (int rt = 0; rt < 2; ++rt) CO_RAW(wv[rt], ZS + tokrow * 1536 + 1024 + h * 64 + 32 * rt);
#pragma unroll
            for (int ks = 0; ks < 8; ++ks) sg[ks] = *(const bf16x8*)(SGL + ((size_t)(((size_t)b * SEQ + 64 * cp + 32 * ct) >> 5) * 8 + ks) * 512 + lane * 8);
            float y[2][16], s = 0.f;
#pragma unroll
            for (int rt = 0; rt < 2; ++rt)
#pragma unroll
                for (int r = 0; r < 16; ++r) { y[rt][r] = acc[rt][r]; s += y[rt][r]; }
            const float mean = half_pair_sum(s) * (1.f / 64.f);
            float qv = 0.f;
#pragma unroll
            for (int rt = 0; rt < 2; ++rt)
#pragma unroll
                for (int r = 0; r < 16; ++r) { y[rt][r] -= mean; qv += y[rt][r] * y[rt][r]; }
            const float rstd = 1.f / sqrtf(half_pair_sum(qv) * (1.f / 64.f) + GN_EPS);
#pragma unroll
            for (int rt = 0; rt < 2; ++rt) {
                float vv[16], o[16]; CO_CVT(vv, wv[rt]);
                f32x16 gg = {};
#pragma unroll
                for (int ks = 0; ks < 8; ++ks) gg = mfma32(*(const LAS bf16x8*)(G2L + (h * 64 + 32 * rt + r32) * G2P + (16 * ks + 8 * hi) * 2), sg[ks], gg);
#pragma unroll
                for (int q4 = 0; q4 < 4; ++q4) { const f32x4 lg4 = *(const LAS f32x4*)(TAB + 512 + h * 64 + 32 * rt + 8 * q4 + 4 * hi), lb4 = *(const LAS f32x4*)(TAB + 1024 + h * 64 + 32 * rt + 8 * q4 + 4 * hi);
#pragma unroll
                    for (int e = 0; e < 4; ++e) { const int r = 4 * q4 + e; o[r] = (y[rt][r] * rstd * lg4[e] + lb4[e] + bs * vv[r]) * gg[r]; } }
                store_rows16(O + tokrow * 1024 + 512 + h * 64 + 32 * rt, pk4(o[0], o[1], o[2], o[3]), pk4(o[4], o[5], o[6], o[7]), pk4(o[8], o[9], o[10], o[11]), pk4(o[12], o[13], o[14], o[15]), hi);
            }
        }
    }
#undef CO_RAW
#undef CO_CVT
}

__device__ __forceinline__ void rwkv_readout_phase(Frame& F, const Args& A_) {
    const bf16* ZS = (const bf16*)(F.ws + WS_ZS); const bf16* Y0 = (const bf16*)((unsigned char*)F.out + DO_Y); const bf16* Y1 = Y0 + (size_t)ML * 512;
    const bf16* GG = (const bf16*)((unsigned char*)F.out + DO_G); bf16* O = (bf16*)(F.ws + WS_ATTRW);
    const int gw = F.vcu * NWAVES + F.wave, NGW = F.G * NWAVES, ch = F.lane * 8;
    float rk[8], lg[8], lb[8];
#pragma unroll
    for (int e = 0; e < 8; ++e) { rk[e] = A_.in[I_RK][ch + e]; lg[e] = A_.in[I_LNG][ch + e]; lb[e] = A_.in[I_LNB][ch + e]; }
    for (int row = gw; row < ML; row += NGW) {
        const v4u y0 = *(const v4u*)(Y0 + (size_t)row * 512 + ch), y1 = *(const v4u*)(Y1 + (size_t)row * 512 + ch);
        const v4u rr = *(const v4u*)(ZS + (size_t)row * 1536 + ch), kk = *(const v4u*)(ZS + (size_t)row * 1536 + 512 + ch), vv = *(const v4u*)(ZS + (size_t)row * 1536 + 1024 + ch);
        const v4u gg = *(const v4u*)(GG + (size_t)row * 512 + ch);
        float y[8], s = 0.f, bs = 0.f;
#pragma unroll
        for (int e = 0; e < 4; ++e) { y[2 * e] = bf_lo(y0[e]) + bf_lo(y1[e]); y[2 * e + 1] = bf_hi(y0[e]) + bf_hi(y1[e]); s += y[2 * e] + y[2 * e + 1];
            bs += bf_lo(rr[e]) * bf_lo(kk[e]) * rk[2 * e] + bf_hi(rr[e]) * bf_hi(kk[e]) * rk[2 * e + 1]; }
        const float mean = sum8(s) * (1.f / 64.f); bs = sum8(bs);
        float q = 0.f;
#pragma unroll
        for (int e = 0; e < 8; ++e) { y[e] -= mean; q += y[e] * y[e]; }
        const float rstd = 1.f / sqrtf(sum8(q) * (1.f / 64.f) + GN_EPS);
        float o[8];
#pragma unroll
        for (int e = 0; e < 4; ++e) {
            o[2 * e] = (y[2 * e] * rstd * lg[2 * e] + lb[2 * e] + bs * bf_lo(vv[e])) * bf_lo(gg[e]);
            o[2 * e + 1] = (y[2 * e + 1] * rstd * lg[2 * e + 1] + lb[2 * e + 1] + bs * bf_hi(vv[e])) * bf_hi(gg[e]);
        }
        v4u w; w.x = pk2(o[0], o[1]); w.y = pk2(o[2], o[3]); w.z = pk2(o[4], o[5]); w.w = pk2(o[6], o[7]);
        *(v4u*)(O + (size_t)row * 1024 + 512 + ch) = w;
    }
}
#ifndef FFT_ABL
#define FFT_ABL 0
#endif
template <bool PASS_A> __device__ __forceinline__ void fft_col_phase(Frame& F, bool real_run = true) {
    const int abl = real_run ? 0 : FFT_ABL;
    constexpr int KC = PASS_A ? 64 : 128, K2 = 2 * KC, NU = 2048;
    constexpr int TCOLS = PASS_A ? 512 : 256, FP = TCOLS * 2 + 16, WP = K2 * 2 + 16, NT = PASS_A ? 4 : 2;
    const bf16* In = (const bf16*)(F.ws + (PASS_A ? WS_G1 : WS_Y1)); bf16* Out = (bf16*)(F.ws + (PASS_A ? WS_Y1 : WS_F1));
    const bf16* W = (const bf16*)(F.ws + (PASS_A ? WS_W2A : WS_W2B)); const float* tw = (const float*)(F.ws + WS_TW);
    LAS unsigned char* T = F.lds; LAS unsigned char* WL = F.lds + KC * FP;
    const int lane = F.lane, r32 = lane & 31, hi = lane >> 5, i16 = lane & 15, qd = i16 >> 2, pp = i16 & 3, c0 = lane & 16;
#ifndef WLDS
#define WLDS 2
#endif
    constexpr bool USE_WL = (WLDS >> (PASS_A ? 0 : 1)) & 1;
    __syncthreads();
    if (USE_WL) for (int it = F.tid; it < 128 * (K2 / 8); it += 512) { const int r = it / (K2 / 8), ch = it % (K2 / 8); *(LAS v4u*)(WL + r * WP + ch * 16) = *(const v4u*)(W + (size_t)r * K2 + ch * 8); }
    const int cw = PASS_A ? 32 * F.wave : 32 * (F.wave & 3), t0 = PASS_A ? 0 : 2 * (F.wave >> 2);
#ifndef FFT_PF
#define FFT_PF 3
#endif
    constexpr bool PF = (FFT_PF >> (PASS_A ? 0 : 1)) & 1;
    v4u pf[8];
#define FFT_DEC(u_, b, g, fix, half) do { b = (u_) >> 9; g = ((u_) >> 7) & 3; if (PASS_A) { fix = (u_) & 127; half = 0; } else { fix = ((u_) >> 1) & 63; half = (u_) & 1; } } while (0)
#define FFT_LD(u_) do { int b_, g_, f_, h_; FFT_DEC(u_, b_, g_, f_, h_); \
        _Pragma("unroll") for (int i = 0; i < 8; ++i) { const int it = F.tid + 512 * i; \
            if (PASS_A) { const int k = it >> 6, c16 = it & 63; pf[i] = *(const v4u*)(In + ((size_t)((b_ * 128 + f_) * 4 + g_) * 64 + k) * 512 + c16 * 8); } \
            else { const int k = it >> 5, c16 = it & 31, part = c16 >> 4, cc = c16 & 15; pf[i] = *(const v4u*)(In + ((size_t)((b_ * 64 + f_) * 4 + g_) * 128 + k) * 512 + part * 256 + h_ * 128 + cc * 8); } } } while (0)
#define FFT_ST() do { _Pragma("unroll") for (int i = 0; i < 8; ++i) { const int it = F.tid + 512 * i; const int k = PASS_A ? (it >> 6) : (it >> 5), c16 = PASS_A ? (it & 63) : (it & 31); *(LAS v4u*)(T + k * FP + c16 * 16) = pf[i]; } } while (0)
    if (F.vcu < NU) { FFT_LD(F.vcu); FFT_ST(); }
    for (int unit = F.vcu; unit < NU; unit += F.G) {
        int b, g, fix, half; FFT_DEC(unit, b, g, fix, half);
        const bool more = unit + F.G < NU;
        __syncthreads();
        if (PF && more && abl != 2) FFT_LD(unit + F.G);
        f32x16 acc[NT] = {};
        if (abl == 1) {} else if (!USE_WL) {
#pragma unroll 1
            for (int t = 0; t < NT; ++t) {
                bf16x8 wfr[K2 / 16];
#pragma unroll
                for (int ks = 0; ks < K2 / 16; ++ks) wfr[ks] = *(const bf16x8*)(W + (size_t)(32 * (t0 + t) + r32) * K2 + 16 * ks + 8 * hi);
                f32x16 a = {};
#pragma unroll
                for (int ks = 0; ks < K2 / 16; ++ks) {
                    const int part = (16 * ks) / KC, kb = (16 * ks) % KC;
                    const LAS unsigned char* tb = T + (kb + 8 * hi + qd) * FP + (part * (TCOLS / 2) + cw + c0 + 4 * pp) * 2;
                    a = mfma32(cat4(tr_read(tb), tr_read(tb + 4 * FP)), wfr[ks], a);
                }
                if (t == 0) acc[0] = a; else if (t == 1) acc[1] = a; else if (t == 2) acc[NT > 2 ? 2 : 0] = a; else acc[NT > 3 ? 3 : 0] = a;
            }
        } else {
#pragma unroll 8
        for (int ks = 0; ks < K2 / 16; ++ks) {
            const int part = (16 * ks) / KC, kb = (16 * ks) % KC;
            const LAS unsigned char* tb = T + (kb + 8 * hi + qd) * FP + (part * (TCOLS / 2) + cw + c0 + 4 * pp) * 2;
            const bf16x8 af = cat4(tr_read(tb), tr_read(tb + 4 * FP));
#pragma unroll
            for (int t = 0; t < NT; ++t) { const bf16x8 wf = *(const LAS bf16x8*)(WL + (32 * (t0 + t) + r32) * WP + (16 * ks + 8 * hi) * 2); acc[t] = mfma32(af, wf, acc[t]); }
        }
        }
        __syncthreads();
        constexpr int OP = PASS_A ? 1040 : 272;
        if (PASS_A) {
#pragma unroll
            for (int t = 0; t < 2; ++t) { const int l1p = 32 * t + r32; const int ti = (fix * l1p) & 8191; const float cs = tw[2 * ti], sn = tw[2 * ti + 1];
                LAS unsigned char* op = T + l1p * OP + cw * 2;
#pragma unroll
                for (int q4 = 0; q4 < 4; ++q4) { float re[4], im[4];
#pragma unroll
                    for (int e = 0; e < 4; ++e) { const float a = acc[t][4 * q4 + e], bq = acc[(t + 2) % NT][4 * q4 + e]; re[e] = a * cs + bq * sn; im[e] = bq * cs - a * sn; }
                    *(LAS v2u*)(op + (8 * q4 + 4 * hi) * 2) = pk4(re[0], re[1], re[2], re[3]); *(LAS v2u*)(op + 512 + (8 * q4 + 4 * hi) * 2) = pk4(im[0], im[1], im[2], im[3]); } }
        } else {
#pragma unroll
            for (int t = 0; t < 2; ++t) { LAS unsigned char* op = T + (32 * (t0 + t) + r32) * OP + cw * 2;
#pragma unroll
                for (int q4 = 0; q4 < 4; ++q4) *(LAS v2u*)(op + (8 * q4 + 4 * hi) * 2) = pk4(acc[t][4 * q4], acc[t][4 * q4 + 1], acc[t][4 * q4 + 2], acc[t][4 * q4 + 3]); }
        }
        __syncthreads();
        if (abl != 3) {
            if (PASS_A) {
#pragma unroll
                for (int i = 0; i < 8; ++i) { const int it = F.tid + 512 * i; const int row = it >> 6, c16 = it & 63;
                    *(v4u*)(Out + ((size_t)((b * 64 + row) * 4 + g) * 128 + fix) * 512 + c16 * 8) = *(const LAS v4u*)(T + row * OP + c16 * 16); }
            } else {
#pragma unroll
                for (int i = 0; i < 4; ++i) { const int it = F.tid + 512 * i; const int row = it >> 4, c16 = it & 15;
                    *(v4u*)(Out + ((size_t)((b * 64 + fix) * 128 + row) * 4 + g) * 256 + half * 128 + c16 * 8) = *(const LAS v4u*)(T + row * OP + c16 * 16); }
            }
        }
        __syncthreads();
        if (more) { if (!PF && abl != 2) FFT_LD(unit + F.G); FFT_ST(); }
    }
#undef FFT_DEC
#undef FFT_LD
#undef FFT_ST
}

__device__ __forceinline__ void fft_passB_sym_phase(Frame& F) {
    constexpr int KC = 128, K2 = 256, FP = 528, WP = 528, OP = 272, NU = 1024;
    const bf16* In = (const bf16*)(F.ws + WS_Y1); bf16* Out = (bf16*)(F.ws + WS_F1); const bf16* W = (const bf16*)(F.ws + WS_W2B); const float* tw = (const float*)(F.ws + WS_TW);
    const float* S128 = (const float*)(F.ws + WS_S128);
    LAS unsigned char* T = F.lds; LAS unsigned char* WL = F.lds + KC * FP;
    LAS float* PX = (LAS float*)(F.lds + 2 * KC * FP);
    LAS float* PY = PX + 4 * 128 * 2;
    LAS float* TWL = PY + 128 * 2;
    const int lane = F.lane, r32 = lane & 31, hi = lane >> 5, i16 = lane & 15, qd = i16 >> 2, pp = i16 & 3, c0 = lane & 16;
    __syncthreads();
    for (int it = F.tid; it < 128 * (K2 / 8); it += 512) { const int r = it / (K2 / 8), ch = it % (K2 / 8); *(LAS v4u*)(WL + r * WP + ch * 16) = *(const v4u*)(W + (size_t)r * K2 + ch * 8); }
    if (F.tid < 128) { TWL[2 * F.tid] = tw[2 * 64 * F.tid]; TWL[2 * F.tid + 1] = tw[2 * 64 * F.tid + 1]; }
    const int cw = 32 * (F.wave & 3), t0 = 2 * (F.wave >> 2);
    const int x = F.tid & 127, part = F.wave >> 1;
    v4u pf[8];
#define FB_LD(u_) do { const int b_ = (u_) >> 8, g_ = ((u_) >> 6) & 3, f_ = (u_) & 63; \
        _Pragma("unroll") for (int i = 0; i < 8; ++i) { const int it = F.tid + 512 * i; const int k = it >> 5, c16 = it & 31; \
            pf[i] = __builtin_nontemporal_load((const v4u*)(In + ((size_t)((b_ * 64 + f_) * 4 + g_) * 128 + k) * 256 + c16 * 8)); } } while (0)
#define FB_ST() do { _Pragma("unroll") for (int i = 0; i < 8; ++i) { const int it = F.tid + 512 * i; const int k = it >> 5, c16 = it & 31; *(LAS v4u*)(T + k * FP + c16 * 16) = pf[i]; } } while (0)
    float sv[16] = {}, cs2 = 0.f, sn2 = 0.f;
#define FB_SV(u_, sv_, cs_, sn_) do { const int b_ = (u_) >> 8, g_ = ((u_) >> 6) & 3, f_ = (u_) & 63; const float* s_ = S128 + (size_t)(b_ * 4 + g_) * SEQ + 128 * 16 * part + x; \
        _Pragma("unroll") for (int i = 0; i < 16; ++i) sv_[i] = s_[128 * i]; \
        const int ti_ = (x * f_) & 8191; cs_ = tw[2 * ti_]; sn_ = tw[2 * ti_ + 1]; } while (0)
    if (F.vcu < NU) { FB_SV(F.vcu, sv, cs2, sn2); FB_LD(F.vcu); FB_ST(); }
    for (int unit = F.vcu; unit < NU; unit += F.G) {
        const int b = unit >> 8, g = (unit >> 6) & 3, fix = unit & 63; const bool more = unit + F.G < NU;
        __syncthreads();
        float svn[16] = {}, cs2n = 0.f, sn2n = 0.f;
        if (more) { FB_SV(unit + F.G, svn, cs2n, sn2n); FB_LD(unit + F.G); }
        f32x16 acc[2] = {};
#pragma unroll 8
        for (int ks = 0; ks < K2 / 16; ++ks) {
            const int part_ = ks >> 3, kb = (16 * ks) & 127;
            const LAS unsigned char* tb = T + (kb + 8 * hi + qd) * FP + (part_ * 128 + cw + c0 + 4 * pp) * 2;
            const bf16x8 af = cat4(tr_read(tb), tr_read(tb + 4 * FP));
#pragma unroll
            for (int t = 0; t < 2; ++t) acc[t] = mfma32(af, *(const LAS bf16x8*)(WL + (32 * (t0 + t) + r32) * WP + (16 * ks + 8 * hi) * 2), acc[t]);
        }
        {
            float pr = 0.f, pi = 0.f;
#pragma unroll
            for (int i = 0; i < 16; ++i) { const int l1 = 16 * part + i; const int ti = 2 * ((l1 * fix) & 63); const f32x2c cs = *(const LAS f32x2c*)(TWL + 2 * ti); pr += sv[i] * cs.x; pi -= sv[i] * cs.y; }
            *(LAS f32x2c*)(PX + (part * 128 + x) * 2) = f32x2c{pr, pi};
            __syncthreads();
            if (F.tid < 128) { float a = 0.f, bq = 0.f;
#pragma unroll
                for (int p = 0; p < 4; ++p) { const f32x2c v = *(const LAS f32x2c*)(PX + (p * 128 + x) * 2); a += v.x; bq += v.y; }
                *(LAS f32x2c*)(PY + 2 * x) = f32x2c{a * cs2 + bq * sn2, bq * cs2 - a * sn2}; }
            __syncthreads();
            float ac = 0.f;
#pragma unroll 8
            for (int i = 0; i < 32; ++i) { const int l2 = 32 * part + i; const int ti = (l2 * x) & 127; const f32x2c y = *(const LAS f32x2c*)(PY + 2 * l2), cs = *(const LAS f32x2c*)(TWL + 2 * ti); ac += y.x * cs.x + y.y * cs.y; }
            PX[part * 128 + x] = ac;
        }
#pragma unroll
        for (int t = 0; t < 2; ++t) { LAS unsigned char* op = T + (32 * (t0 + t) + r32) * OP + cw * 2;
#pragma unroll
            for (int q4 = 0; q4 < 4; ++q4) *(LAS v2u*)(op + (8 * q4 + 4 * hi) * 2) = pk4(acc[t][4 * q4], acc[t][4 * q4 + 1], acc[t][4 * q4 + 2], acc[t][4 * q4 + 3]); }
        __syncthreads();
        const int l1m = (64 - fix) & 63;
#pragma unroll
        for (int i = 0; i < 4; ++i) { const int it = F.tid + 512 * i; const int row = it >> 4, c16 = it & 15;
            *(v4u*)(Out + ((size_t)((b * 64 + fix) * 128 + row) * 4 + g) * 256 + c16 * 8) = *(const LAS v4u*)(T + row * OP + c16 * 16); }
#pragma unroll
        for (int i = 0; i < 4; ++i) { const int it = F.tid + 512 * i; const int row = it >> 4, q = it & 15;
            const int l2m = fix ? (127 - row) : ((128 - row) & 127);
            bf16* dst = Out + ((size_t)((b * 64 + l1m) * 128 + l2m) * 4 + g) * 256 + 248 - 8 * q;
            const v4u s1 = *(const LAS v4u*)(T + row * OP + q * 16);
            unsigned lo;
            if (q < 15) lo = *(const LAS unsigned*)(T + row * OP + (q + 1) * 16) & 0xffffu;
            else lo = (unsigned)f2bf((PX[row] + PX[128 + row] + PX[256 + row] + PX[384 + row]) * 0.011048543456039806f);
            v4u d; d.x = lo | (s1.w & 0xffff0000u); d.y = (s1.w & 0xffffu) | (s1.z & 0xffff0000u); d.z = (s1.z & 0xffffu) | (s1.y & 0xffff0000u); d.w = (s1.y & 0xffffu) | (s1.x & 0xffff0000u);
            *(v4u*)dst = d; }
        __syncthreads();
        if (more) { FB_ST();
#pragma unroll
            for (int i = 0; i < 16; ++i) sv[i] = svn[i];
            cs2 = cs2n; sn2 = sn2n; }
    }
#undef FB_LD
#undef FB_ST
#undef FB_SV
}

__device__ __forceinline__ void fft_passA_fused_phase(Frame& F, const float* ng, const float* modl) {
    constexpr int XP = 528, TP = 528, WP = 272, XO = 0, TO = 64 * XP, WO = TO + 64 * TP, NU = 2048;
    const bf16* XN = (const bf16*)(F.ws + WS_XR); bf16* Out = (bf16*)(F.ws + WS_Y1); const unsigned long long* SSQ = (const unsigned long long*)(F.ws + WS_SSQ);
    const bf16* DFTC = (const bf16*)(F.ws + WS_DFTC); const bf16* W = (const bf16*)(F.ws + WS_W2A); const float* tw = (const float*)(F.ws + WS_TW);
    LAS unsigned char* X = F.lds + XO; LAS unsigned char* T = F.lds + TO; LAS unsigned char* WL = F.lds + WO;
    const int lane = F.lane, r32 = lane & 31, hi = lane >> 5, i16 = lane & 15, qd = i16 >> 2, pp = i16 & 3, c0 = lane & 16, w = F.wave;
    __syncthreads();
    for (int it = F.tid; it < 128 * 16; it += 512) { const int r = it >> 4, ch = it & 15; *(LAS v4u*)(WL + r * WP + ch * 16) = *(const v4u*)(W + (size_t)r * 128 + ch * 8); }
    bf16x8 dfr[16];
    { const int jp = 32 * w + r32; const int jrow = (jp < 128) ? jp : ((jp == 128) ? 128 : 128 + jp);
#pragma unroll
      for (int ks = 0; ks < 16; ++ks) dfr[ks] = *(const bf16x8*)(DFTC + (size_t)jrow * 256 + 16 * ks + 8 * hi); }
    v4u px[4]; unsigned long long pq[4]; f32x4 pg[2], ps[2], pb[2];
#define FA_LD(u_) do { const int b_ = (u_) >> 9, g_ = ((u_) >> 7) & 3, f_ = (u_) & 127; \
        _Pragma("unroll") for (int i = 0; i < 4; ++i) { const int it = F.tid + 512 * i; const int k = it >> 5, c16 = it & 31; px[i] = __builtin_nontemporal_load((const v4u*)(XN + (size_t)(b_ * SEQ + k * 128 + f_) * 1024 + g_ * 256 + c16 * 8)); \
            pq[i] = SSQ[b_ * SEQ + k * 128 + f_]; } \
        { const int ch_ = g_ * 256 + (F.tid & 31) * 8; const float* sh_ = modl + (size_t)b_ * 6144 + ch_; \
          _Pragma("unroll") for (int e = 0; e < 2; ++e) { pg[e] = *(const f32x4*)(ng + ch_ + 4 * e); ps[e] = *(const f32x4*)(sh_ + 1024 + 4 * e); pb[e] = *(const f32x4*)(sh_ + 4 * e); } } } while (0)
#define FA_ST() do { const f32x4 pa[2] = {pg[0] * (ps[0] + 1.f), pg[1] * (ps[1] + 1.f)}; _Pragma("unroll") for (int i = 0; i < 4; ++i) { const int it = F.tid + 512 * i; const int k = it >> 5, c16 = it & 31; \
            const float rstd_ = 1.f / sqrtf((float)pq[i] * (1.f / (1048576.f * DM)) + NORM_EPS); const v4u w_ = px[i]; \
            const f32x4 x0_ = {bf_lo(w_.x), bf_hi(w_.x), bf_lo(w_.y), bf_hi(w_.y)}, x1_ = {bf_lo(w_.z), bf_hi(w_.z), bf_lo(w_.w), bf_hi(w_.w)}; \
            const f32x4 o0_ = (x0_ * rstd_) * pa[0] + pb[0], o1_ = (x1_ * rstd_) * pa[1] + pb[1]; \
            v4u o_; o_.x = pk2(o0_.x, o0_.y); o_.y = pk2(o0_.z, o0_.w); o_.z = pk2(o1_.x, o1_.y); o_.w = pk2(o1_.z, o1_.w); \
            *(LAS v4u*)(X + k * XP + c16 * 16) = o_; } } while (0)
    if (F.vcu < NU) { FA_LD(F.vcu); FA_ST(); }
#pragma unroll
    for (int ks = 0; ks < 16; ks += 4) asm volatile("" :: "v"(dfr[ks]), "v"(dfr[ks + 1]), "v"(dfr[ks + 2]), "v"(dfr[ks + 3]));
    const int cb = w & 3, ot = w >> 2, cw = 32 * cb;
    for (int unit = F.vcu; unit < NU; unit += F.G) {
        const int b = unit >> 9, g = (unit >> 7) & 3, fix = unit & 127; const bool more = unit + F.G < NU;
        __syncthreads();
        const int l1p = 32 * ot + r32; f32x2c tcs;
        { const int ti = (fix * l1p) & 8191; tcs = *(const f32x2c*)(tw + 2 * ti); }
        if (more) FA_LD(unit + F.G);
        {
            f32x16 a2[2] = {};
#pragma unroll
            for (int ks = 0; ks < 16; ++ks) {
                const bf16x8 x0 = *(const LAS bf16x8*)(X + r32 * XP + (16 * ks + 8 * hi) * 2), x1 = *(const LAS bf16x8*)(X + (32 + r32) * XP + (16 * ks + 8 * hi) * 2);
                a2[0] = mfma32(dfr[ks], x0, a2[0]); a2[1] = mfma32(dfr[ks], x1, a2[1]);
            }
            if (w == 4 && hi == 0) {
                float* s128 = (float*)(F.ws + WS_S128) + (size_t)(b * 4 + g) * SEQ + fix;
                s128[(size_t)128 * r32] = a2[0][0]; s128[(size_t)128 * (32 + r32)] = a2[1][0]; a2[0][0] = 0.f; a2[1][0] = 0.f;
            }
#pragma unroll
            for (int ct = 0; ct < 2; ++ct) { LAS unsigned char* tp = T + (32 * ct + r32) * TP + (32 * w) * 2;
#pragma unroll
                for (int q4 = 0; q4 < 4; ++q4) *(LAS v2u*)(tp + (8 * q4 + 4 * hi) * 2) = pk4(a2[ct][4 * q4], a2[ct][4 * q4 + 1], a2[ct][4 * q4 + 2], a2[ct][4 * q4 + 3]); }
        }
        __syncthreads();
        f32x16 acc[2] = {};
#pragma unroll 2
        for (int ks = 0; ks < 8; ++ks) {
            const int part = ks >> 2, kb = (16 * ks) & 63;
            const LAS unsigned char* tb = T + (kb + 8 * hi + qd) * TP + (part * 128 + cw + c0 + 4 * pp) * 2;
            const bf16x8 af = cat4(tr_read(tb), tr_read(tb + 4 * TP));
            acc[0] = mfma32(af, *(const LAS bf16x8*)(WL + (32 * ot + r32) * WP + (16 * ks + 8 * hi) * 2), acc[0]);
            acc[1] = mfma32(af, *(const LAS bf16x8*)(WL + (64 + 32 * ot + r32) * WP + (16 * ks + 8 * hi) * 2), acc[1]);
        }
        __syncthreads();
        { const float cs = tcs.x, sn = tcs.y;
          LAS unsigned char* op = T + l1p * TP + cw * 2;
#pragma unroll
          for (int q4 = 0; q4 < 4; ++q4) { float re[4], im[4];
#pragma unroll
              for (int e = 0; e < 4; ++e) { const float a = acc[0][4 * q4 + e], bq = acc[1][4 * q4 + e]; re[e] = a * cs + bq * sn; im[e] = bq * cs - a * sn; }
              *(LAS v2u*)(op + (8 * q4 + 4 * hi) * 2) = pk4(re[0], re[1], re[2], re[3]); *(LAS v2u*)(op + 256 + (8 * q4 + 4 * hi) * 2) = pk4(im[0], im[1], im[2], im[3]); } }
        __syncthreads();
#pragma unroll
        for (int i = 0; i < 4; ++i) { const int it = F.tid + 512 * i; const int row = it >> 5, c16 = it & 31;
            *(v4u*)(Out + ((size_t)((b * 64 + row) * 4 + g) * 128 + fix) * 256 + c16 * 8) = *(const LAS v4u*)(T + row * TP + c16 * 16); }
        if (more) FA_ST();
    }
#undef FA_LD
#undef FA_ST
}

__global__ void __launch_bounds__(NWAVES * 64, 2) skel_fwd(Args A_) {
    extern __shared__ __attribute__((aligned(16))) unsigned char lds[];
    Frame F;
    F.lds = (LAS unsigned char*)lds;
    F.tid = threadIdx.x; F.lane = F.tid & 63; F.wave = __builtin_amdgcn_readfirstlane(F.tid >> 6);
    F.G = gridDim.x; { const int bx = blockIdx.x; F.vcu = (F.G % 8 == 0) ? (bx % 8) * (F.G / 8) + bx / 8 : bx; }
    F.ws = A_.ws; F.out = A_.out;
    cg::grid_group grid = cg::this_grid();
    const bool hier_bar = (F.G % 8 == 0);
    { volatile LAS unsigned* misc = (volatile LAS unsigned*)(F.lds + MISC_OFF); if (F.tid < 16) misc[F.tid] = 0u; }
    __syncthreads();
    XcdBarrier bar = xcd_barrier_post((unsigned*)(F.ws + WS_BAR), (volatile LAS unsigned*)(F.lds + MISC_OFF));
#ifndef USE_CG
#define GSYNC() (hier_bar ? xcd_barrier(bar) : grid.sync())
#else
#define GSYNC() grid.sync()
#endif
    const int lo = A_.ph_lo, hi = A_.ph_hi;
#ifndef PHMASK
#define PHMASK 0x7ffff
#endif
#define IN(k) (((PHMASK >> (k)) & 1) && lo <= (k) && (k) < hi)
#define SEAM(k) do { if (IN(k) && IN((k) + 1)) GSYNC(); } while (0)
#ifndef REPMASK
#define REPMASK 0
#endif
#ifndef REPS
#define REPS 2
#endif
#define NREP(k) (((REPMASK >> (k)) & 1) ? REPS : 1)
#define PH(k) if (IN(k)) for (int rep_ = 0; rep_ < NREP(k); ++rep_, (rep_ < NREP(k) ? GSYNC() : (void)0))
#define LASTREP(k) (rep_ == NREP(k) - 1)
    const float* zero_gate = (const float*)(F.ws + WS_ZERO);
    const float* mod0 = (const float*)(F.ws + WS_MOD); const float* mod1 = mod0 + 5 * 6144;
    bf16* XN = (bf16*)(F.ws + WS_XN); bf16* XR = (bf16*)(F.ws + WS_XR);

    PH(0) { p0_prologue(F, A_); } SEAM(0);
    PH(1) { norm_phase(F, A_.in[I_X], A_.in[I_CTX], MALL, A_.in[I_N1G], mod0, 0, XN); } SEAM(1);
    PH(2) {
        pg8::Gemm g{XN, (const bf16*)(F.ws + WS_WIN), MALL, INCOLS, DM}; pg8::StaticOrder S; S.init(MALL, INCOLS, F.G, (int)blockIdx.x);
        pg8::EpiInProj E{(bf16*)(F.ws + WS_QKV), (bf16*)(F.ws + WS_ZR), (const float*)(F.ws + WS_ROPE)};
        pg8::gemm_phase<pg8::EpiInProj, pg8::StaticOrder, true, true>(F.lds, g, S, E);
    } SEAM(2);
    PH(3) { rwkv_prep_phase(F, A_); } SEAM(3);
    PH(4) { rwkv_chunkA_phase(F, A_); } if (IN(4)) GSYNC();
#ifndef TM
#define TM 0
#endif
#if TM == 3
    for (int i_ = 0; i_ < 20; ++i_) GSYNC();
#endif
#if TM == 4
    if (IN(4)) { if ((F.vcu & 31) >= 8) attn_phase(F, A_, (F.vcu >> 5) * 24 + (F.vcu & 31) - 8, (F.G >> 5) * 24); GSYNC(); }
#endif
#if TM == 6 || TM == 7
    if (IN(4)) { if ((F.vcu & 31) < 8) rwkv_chunkB_phase(F, A_, TM - 5); GSYNC(); }
#endif
#if TM == 5
    if (IN(4)) { if ((F.vcu & 31) < 8) rwkv_chunkB_phase(F, A_); GSYNC(); }
#endif
#if TM == 1
    if (IN(4)) { if ((F.vcu & 31) < 8) rwkv_chunkB_phase(F, A_); else attn_phase(F, A_, (F.vcu >> 5) * 24 + (F.vcu & 31) - 8, (F.G >> 5) * 24); GSYNC(); }
#endif
    if (IN(4)) {
        const int nb = (F.G >> 5) * 8, usplit = 1024 - nb;
        if ((F.vcu & 31) < 8) { rwkv_chunkB_phase(F, A_); attn_phase(F, A_, usplit + (F.vcu >> 5) * 8 + (F.vcu & 31), nb); }
        else attn_phase(F, A_, (F.vcu >> 5) * 24 + (F.vcu & 31) - 8, (F.G >> 5) * 24, usplit);
        GSYNC(); }
#if TM == 2
    if (IN(4)) { rwkv_chunkC_phase(F, A_, A_.ph_lo == 12345); GSYNC(); }
#endif
    PH(5) { rwkv_cout_phase(F, A_); } SEAM(5);
    PH(6) {
        pg8::Gemm g{(const bf16*)(F.ws + WS_ATTRW), (const bf16*)(F.ws + WS_WOUT), ML, DM, DM}; pg8::StaticOrder S; S.init(ML, DM, F.G, (int)blockIdx.x);
        pg8::EpiResidualT<false, false, true> E{A_.in[I_X], XR, mod0 + 2048, 6144};
        pg8::gemm_phase<pg8::EpiResidualT<false, false, true>, pg8::StaticOrder, true, true>(F.lds, g, S, E);
    } SEAM(6);
    PH(7) { norm_bf16_phase(F, XR, A_.in[I_N2G], mod0, 3072, XN); } SEAM(7);
    PH(8) {
        pg8::Gemm g{XN, (const bf16*)(F.ws + WS_W1), ML, FF, DM}; pg8::StaticOrder S; S.init(ML, FF, F.G, (int)blockIdx.x);
        pg8::EpiStore<2> E{(bf16*)(F.ws + WS_H), FF, LASTREP(8)};
        pg8::gemm_phase<pg8::EpiStore<2>, pg8::StaticOrder, true, true>(F.lds, g, S, E);
    } SEAM(8);
    PH(9) {
        pg8::Gemm g{(const bf16*)(F.ws + WS_H), (const bf16*)(F.ws + WS_W2), ML, DM, FF}; pg8::StaticOrder S; S.init(ML, DM, F.G, (int)blockIdx.x); S.rev = true;
        pg8::EpiResidualT<false, true, true> E{XR, XR, LASTREP(9) ? mod0 + 5120 : zero_gate, LASTREP(9) ? 6144 : 0, (unsigned long long*)(F.ws + WS_SSQ)};
        pg8::gemm_phase<pg8::EpiResidualT<false, true, true>, pg8::StaticOrder, true, true>(F.lds, g, S, E);
    } SEAM(9);
    PH(12) { fft_passA_fused_phase(F, A_.in[I_N1G] + DM, mod1); } SEAM(12);
    PH(13) { fft_passB_sym_phase(F); } SEAM(13);
    PH(14) {
        pg8::Gemm g{(const bf16*)(F.ws + WS_F1), (const bf16*)(F.ws + WS_WF), ML, DM, DM}; pg8::StaticOrder S; S.init(ML, DM, F.G, (int)blockIdx.x);
        pg8::EpiResidualT<true, true, true> E{XR, XR, LASTREP(14) ? mod1 + 2048 : zero_gate, LASTREP(14) ? 6144 : 0};
        pg8::gemm_phase<pg8::EpiResidualT<true, true, true>, pg8::StaticOrder, true, true>(F.lds, g, S, E);
    } SEAM(14);
    PH(15) { norm_bf16_phase(F, XR, A_.in[I_N2G] + DM, mod1, 3072, XN); } SEAM(15);
    PH(16) {
        pg8::Gemm g{XN, (const bf16*)(F.ws + WS_W1) + (size_t)DM * FF, ML, FF, DM}; pg8::StaticOrder S; S.init(ML, FF, F.G, (int)blockIdx.x);
        pg8::EpiStore<2> E{(bf16*)(F.ws + WS_H), FF};
        pg8::gemm_phase<pg8::EpiStore<2>, pg8::StaticOrder, true, true>(F.lds, g, S, E);
    } SEAM(16);
    PH(17) {
        pg8::Gemm g{(const bf16*)(F.ws + WS_H), (const bf16*)(F.ws + WS_W2) + (size_t)DM * FF, ML, DM, FF}; pg8::StaticOrder S; S.init(ML, DM, F.G, (int)blockIdx.x); S.rev = true;
        pg8::EpiResidualT<false, true, true> E{XR, XR, LASTREP(17) ? mod1 + 5120 : zero_gate, LASTREP(17) ? 6144 : 0};
        pg8::gemm_phase<pg8::EpiResidualT<false, true, true>, pg8::StaticOrder, true, true>(F.lds, g, S, E);
    } SEAM(17);
    PH(18) { final_norm_bf16_phase(F, XR, F.out, A_.in[I_FING]); }
#undef IN
#undef SEAM
}

extern "C" void kernel_launch(void* const* d_in, const int* in_sizes, int n_in, void* d_out, int out_size, void* d_ws, size_t ws_size, hipStream_t stream) {
    static int grid = 0;
    if (grid == 0) {
        if (n_in != 27 || out_size != ML * DM || ws_size < WS_END) { fprintf(stderr, "kernel_launch: unexpected shapes: n_in %d out %d ws %zu\n", n_in, out_size, ws_size); grid = -1; return; }
        int dev = 0, cus = 0, per_cu = 0;
        (void)hipGetDevice(&dev); (void)hipDeviceGetAttribute(&cus, hipDeviceAttributeMultiprocessorCount, dev);
        (void)hipFuncSetAttribute((const void*)skel_fwd, hipFuncAttributeMaxDynamicSharedMemorySize, LDS_BYTES);
        (void)hipOccupancyMaxActiveBlocksPerMultiprocessor(&per_cu, (const void*)skel_fwd, NWAVES * 64, LDS_BYTES);
        (void)hipGetLastError();
        if (per_cu < 1) { fprintf(stderr, "kernel_launch: occupancy query reports %d\n", per_cu); }
        grid = cus;
    }
    if (grid < 0) return;
    if (hipMemsetAsync((char*)d_ws + WS_BAR, 0, WS_ZERO_BYTES, stream) != hipSuccess) { fprintf(stderr, "kernel_launch: memset failed\n"); return; }
    Args a{};
    for (int i = 0; i < 27; ++i) a.in[i] = (const float*)d_in[i];
    a.out = (float*)d_out; a.ws = (unsigned char*)d_ws;
    if (MK_N_LAUNCHES == 1) {
        a.ph_lo = 0; a.ph_hi = N_PHASES;
        void* kargs[] = {&a};
        hipError_t e = hipLaunchCooperativeKernel((const void*)skel_fwd, dim3(grid), dim3(NWAVES * 64), kargs, LDS_BYTES, stream);
        if (e != hipSuccess) fprintf(stderr, "cooperative launch failed: %s (grid %d)\n", hipGetErrorString(e), grid);
    } else {
        for (int p = 0; p < N_PHASES; ++p) { a.ph_lo = p; a.ph_hi = p + 1; hipLaunchKernelGGL(skel_fwd, dim3(grid), dim3(NWAVES * 64), LDS_BYTES, stream, a); }
    }
}
```
